# Optimizing an MI355X kernel written in HIP

```python
import math
import jax, jax.numpy as jnp
from jax import lax
import numpy as np

D_MODEL = 1024
BATCH = 8
SEQ = 8192
DEPTH = 2

GRID_W = 64
MEM_TOKENS = 256
HEAD_DIM = 64
D_MIX = D_MODEL
NA_DIM = D_MIX // 4
NA_HEADS = NA_DIM // HEAD_DIM
NA_WIN_ROWS = 8
NA_WIN_COLS = 16
SSD_DIM = D_MIX // 2
SSD_HEADS = SSD_DIM // HEAD_DIM
SSD_GROUPS = 2
SSD_STATE = 64
SSD_CONV = 5
SSD_CHUNK = 128
SSD_CONV_DIM = SSD_DIM + 2 * SSD_GROUPS * SSD_STATE
S5_DIM = D_MIX - NA_DIM - SSD_DIM
S5_GROUP_CH = 16
S5_GROUPS = S5_DIM // S5_GROUP_CH
S5_STATE = 64
XA_HEADS = 4
XA_HEAD_DIM = D_MODEL // XA_HEADS
D_FF = 4 * D_MODEL
IN_SIZES = (NA_DIM, NA_DIM, NA_DIM, SSD_DIM, SSD_CONV_DIM, 2 * SSD_HEADS, S5_DIM)
D_IN_PROJ = sum(IN_SIZES)
LN_EPS = 1e-5
NEG_BIG = -1e30
DEEPNORM_ALPHA = (2 * DEPTH) ** 0.25
DEEPNORM_BETA = (8 * DEPTH) ** -0.25

kernel_name = 'hybrid_na_ssd_s5_encoder'


def _split_cols(t, sizes):
    offs, acc = [], 0
    for s in sizes[:-1]:
        acc += s
        offs.append(acc)
    return jnp.split(t, offs, axis=-1)


def layernorm(x, g, b):
    xf = x.astype(jnp.float32)
    mu = jnp.mean(xf, axis=-1, keepdims=True)
    var = jnp.mean(jnp.square(xf - mu), axis=-1, keepdims=True)
    y = (xf - mu) * lax.rsqrt(var + LN_EPS) * g.astype(jnp.float32) + b.astype(jnp.float32)
    return y.astype(x.dtype)


def neighbourhood_attention(q, k, v, rpb):
    bsz, t, nh, dh = q.shape
    rows = t // GRID_W
    wr = min(NA_WIN_ROWS, rows)
    q = q.reshape(bsz, rows, GRID_W, nh, dh)
    k = k.reshape(bsz, rows, GRID_W, nh, dh)
    v = v.reshape(bsz, rows, GRID_W, nh, dh)
    r = jnp.arange(rows)
    r0 = jnp.clip(r - wr // 2, 0, rows - wr)
    row_idx = r0[:, None] + jnp.arange(wr)[None, :]
    kg = jnp.take(k, row_idx, axis=1)
    vg = jnp.take(v, row_idx, axis=1)
    c = jnp.arange(GRID_W)
    c0 = jnp.clip(c - NA_WIN_COLS // 2, 0, GRID_W - NA_WIN_COLS)
    col_mask = (c[None, :] >= c0[:, None]) & (c[None, :] < c0[:, None] + NA_WIN_COLS)
    ri = row_idx - r[:, None] + (NA_WIN_ROWS - 1)
    ci = jnp.clip(c[None, :] - c[:, None], -(NA_WIN_COLS - 1), NA_WIN_COLS - 1) + (NA_WIN_COLS - 1)
    bias = rpb.astype(jnp.float32)[:, ri[:, None, :, None], ci[None, :, None, :]]
    s = jnp.einsum('brqhd,brjkhd->bhrqjk', q, kg).astype(jnp.float32) * (dh ** -0.5) + bias
    s = jnp.where(col_mask[:, None, :], s, NEG_BIG)
    p = jax.nn.softmax(s.reshape(bsz, nh, rows, GRID_W, wr * GRID_W), axis=-1)
    p = p.reshape(bsz, nh, rows, GRID_W, wr, GRID_W).astype(v.dtype)
    o = jnp.einsum('bhrqjk,brjkhd->brqhd', p, vg)
    return o.reshape(bsz, t, nh * dh)


def ssd_scan(x, dt, a, bm, cm):
    bsz, t, nh, hp = x.shape
    nc = t // SSD_CHUNK
    qc = SSD_CHUNK
    rep = nh // SSD_GROUPS
    xdt = (x * dt[..., None]).reshape(bsz, nc, qc, nh, hp)
    bg = bm.reshape(bsz, nc, qc, SSD_GROUPS, SSD_STATE)
    cg = cm.reshape(bsz, nc, qc, SSD_GROUPS, SSD_STATE)
    acs = jnp.cumsum((dt * a).reshape(bsz, nc, qc, nh), axis=2)
    acs_h = acs.transpose(0, 3, 1, 2)
    seg = acs_h[..., :, None] - acs_h[..., None, :]
    tril = jnp.tril(jnp.ones((qc, qc), dtype=bool))
    decay_ls = jnp.exp(jnp.where(tril, seg, -jnp.inf))
    cb = jnp.repeat(jnp.einsum('bclgn,bcsgn->bgcls', cg, bg), rep, axis=1)
    y_diag = jnp.einsum('bhcls,bcshp->bclhp', cb * decay_ls, xdt)
    bh = jnp.repeat(bg, rep, axis=3)
    ch = jnp.repeat(cg, rep, axis=3)
    decay_to_end = jnp.exp(acs[:, :, -1:, :] - acs)
    states = jnp.einsum('bcshn,bcshp->bchpn', bh * decay_to_end[..., None], xdt)
    chunk_decay = jnp.exp(acs[:, :, -1, :])

    def step(h, inp):
        s_c, d_c = inp
        return h * d_c[:, :, None, None] + s_c, h

    h0 = jnp.zeros((bsz, nh, hp, SSD_STATE), jnp.float32)
    _, prev = lax.scan(step, h0, (states.transpose(1, 0, 2, 3, 4), chunk_decay.transpose(1, 0, 2)))
    prev = prev.transpose(1, 0, 2, 3, 4)
    y_off = jnp.einsum('bclhn,bchpn->bclhp', ch * jnp.exp(acs)[..., None], prev)
    return (y_diag + y_off).reshape(bsz, t, nh, hp)


def ssd_mixer(z, xbc, dt_raw, conv_w, conv_b, dt_bias, a_log, d_skip, norm_w):
    bsz, t, _ = z.shape
    xbc = lax.conv_general_dilated(
        xbc, conv_w[:, None, :].astype(xbc.dtype), window_strides=(1,),
        padding=[(SSD_CONV // 2, SSD_CONV // 2)], dimension_numbers=('NWC', 'WIO', 'NWC'),
        feature_group_count=SSD_CONV_DIM)
    xbc = jax.nn.silu((xbc + conv_b).astype(jnp.float32))
    xs, bm, cm = jnp.split(xbc, [SSD_DIM, SSD_DIM + SSD_GROUPS * SSD_STATE], axis=-1)
    xs = xs.reshape(bsz, t, SSD_HEADS, HEAD_DIM)
    bm = bm.reshape(bsz, t, SSD_GROUPS, SSD_STATE)
    cm = cm.reshape(bsz, t, SSD_GROUPS, SSD_STATE)
    dt = jax.nn.softplus(dt_raw.astype(jnp.float32).reshape(bsz, t, 2, SSD_HEADS) + dt_bias.astype(jnp.float32))
    a = -jnp.exp(a_log.astype(jnp.float32))
    flip = lambda u: jnp.flip(u, axis=1)
    y_fwd = ssd_scan(xs, dt[:, :, 0], a[0], bm, cm)
    y_bwd = flip(ssd_scan(flip(xs), flip(dt[:, :, 1]), a[1], flip(bm), flip(cm)))
    y = y_fwd + y_bwd + d_skip.astype(jnp.float32)[:, None] * xs
    y = y.reshape(bsz, t, SSD_DIM) * jax.nn.silu(z.astype(jnp.float32))
    y = y * lax.rsqrt(jnp.mean(jnp.square(y), axis=-1, keepdims=True) + LN_EPS) * norm_w.astype(jnp.float32)
    return y.astype(z.dtype)


def _cmul_scan_op(e1, e2):
    a1r, a1i, b1r, b1i = e1
    a2r, a2i, b2r, b2i = e2
    return (a2r * a1r - a2i * a1i,
            a2r * a1i + a2i * a1r,
            a2r * b1r - a2i * b1i + b2r,
            a2r * b1i + a2i * b1r + b2i)


def s5_mixer(u, lam_re, lam_im, log_dt, b_re, b_im, c_re, c_im, d_skip, glu_w, glu_b):
    bsz, t, _ = u.shape
    uf = u.astype(jnp.float32)
    ug = uf.reshape(bsz, t, S5_GROUPS, S5_GROUP_CH).transpose(1, 0, 2, 3)
    y = d_skip.astype(jnp.float32) * uf
    for direction in range(2):
        dt = jnp.exp(log_dt[direction].astype(jnp.float32))[:, None]
        lr = lam_re[direction].astype(jnp.float32)
        li = lam_im[direction].astype(jnp.float32)
        mag = jnp.exp(lr * dt)
        ar, ai = mag * jnp.cos(li * dt), mag * jnp.sin(li * dt)
        den = lr * lr + li * li
        fr = ((ar - 1.0) * lr + ai * li) / den
        fi = (ai * lr - (ar - 1.0) * li) / den
        br, bi = b_re[direction].astype(jnp.float32), b_im[direction].astype(jnp.float32)
        bbr = fr[..., None] * br - fi[..., None] * bi
        bbi = fr[..., None] * bi + fi[..., None] * br
        bu_re = jnp.einsum('gph,tbgh->tbgp', bbr, ug)
        bu_im = jnp.einsum('gph,tbgh->tbgp', bbi, ug)
        a_re = jnp.broadcast_to(ar, (t, 1, S5_GROUPS, S5_STATE))
        a_im = jnp.broadcast_to(ai, (t, 1, S5_GROUPS, S5_STATE))
        _, _, xr, xi = lax.associative_scan(_cmul_scan_op, (a_re, a_im, bu_re, bu_im),
                                            axis=0, reverse=(direction == 1))
        yd = (jnp.einsum('ghp,tbgp->btgh', c_re[direction].astype(jnp.float32), xr)
              - jnp.einsum('ghp,tbgp->btgh', c_im[direction].astype(jnp.float32), xi))
        y = y + yd.reshape(bsz, t, S5_DIM)
    g = jax.nn.gelu(y)
    out = g * jax.nn.sigmoid(g @ glu_w.astype(jnp.float32) + glu_b.astype(jnp.float32))
    return out.astype(u.dtype)


def hybrid_mixer(h, w_in, rpb, conv_w, conv_b, dt_bias, a_log, d_ssd, ssd_norm_w,
                 lam_re, lam_im, log_dt, b_re, b_im, c_re, c_im, d_s5, glu_w, glu_b, w_out):
    bsz, t, _ = h.shape
    proj = h @ w_in
    q, k, v, z, xbc, dt_raw, u = _split_cols(proj, IN_SIZES)
    heads = lambda a: a.reshape(bsz, t, NA_HEADS, HEAD_DIM)
    o_na = neighbourhood_attention(heads(q), heads(k), heads(v), rpb).astype(h.dtype)
    o_ssd = ssd_mixer(z, xbc, dt_raw, conv_w, conv_b, dt_bias, a_log, d_ssd, ssd_norm_w)
    o_s5 = s5_mixer(u, lam_re, lam_im, log_dt, b_re, b_im, c_re, c_im, d_s5, glu_w, glu_b)
    mixed = jnp.concatenate([o_na, o_ssd, o_s5], axis=-1)
    return mixed @ w_out


def cross_attention(h, mem, wq, wk, wv, wo):
    bsz, t, _ = h.shape
    m = mem.shape[1]
    q = (h @ wq).reshape(bsz, t, XA_HEADS, XA_HEAD_DIM)
    k = (mem @ wk).reshape(bsz, m, XA_HEADS, XA_HEAD_DIM)
    v = (mem @ wv).reshape(bsz, m, XA_HEADS, XA_HEAD_DIM)
    s = jnp.einsum('bthd,bmhd->bhtm', q, k).astype(jnp.float32) * (XA_HEAD_DIM ** -0.5)
    p = jax.nn.softmax(s, axis=-1).astype(v.dtype)
    o = jnp.einsum('bhtm,bmhd->bthd', p, v).reshape(bsz, t, XA_HEADS * XA_HEAD_DIM)
    return o @ wo


def squared_relu_mlp(h, w1, w2):
    return jnp.square(jax.nn.relu(h @ w1)) @ w2


def setup_inputs(seed: int = 0) -> dict:
    key = jax.random.key(seed)
    ks = jax.random.split(key, 48)
    f32 = jnp.float32
    L = DEPTH

    def normal(k, shape, scale):
        return scale * jax.random.normal(k, shape, f32)

    def uniform(k, shape, lo, hi):
        return jax.random.uniform(k, shape, f32, minval=lo, maxval=hi)

    x = normal(ks[0], (BATCH, SEQ, D_MODEL), 1.0)
    mem = normal(ks[1], (BATCH, MEM_TOKENS, D_MODEL), 1.0)
    ln_in_g = 1.0 + normal(ks[2], (D_MODEL,), 0.02)
    ln_in_b = normal(ks[3], (D_MODEL,), 0.02)
    w_in = normal(ks[4], (L, D_MODEL, D_IN_PROJ), D_MODEL ** -0.5)
    na_rpb = normal(ks[5], (L, NA_HEADS, 2 * NA_WIN_ROWS - 1, 2 * NA_WIN_COLS - 1), 0.02)
    ssd_conv_w = normal(ks[6], (L, SSD_CONV, SSD_CONV_DIM), SSD_CONV ** -0.5)
    ssd_conv_b = normal(ks[7], (L, SSD_CONV_DIM), 0.02)
    dt0 = jnp.exp(uniform(ks[8], (L, 2, SSD_HEADS), math.log(1e-3), math.log(1e-1)))
    ssd_dt_bias = dt0 + jnp.log(-jnp.expm1(-dt0))
    ssd_a_log = jnp.log(uniform(ks[9], (L, 2, SSD_HEADS), 1.0, 16.0))
    ssd_d = 1.0 + normal(ks[10], (L, SSD_HEADS), 0.02)
    ssd_norm_w = 1.0 + normal(ks[11], (L, SSD_DIM), 0.02)
    s5_lam_re = -0.5 + normal(ks[12], (L, 2, S5_GROUPS, S5_STATE), 0.01)
    s5_lam_im = math.pi * jnp.arange(S5_STATE, dtype=f32) + normal(ks[13], (L, 2, S5_GROUPS, S5_STATE), 0.01)
    s5_log_dt = uniform(ks[14], (L, 2, S5_GROUPS), math.log(1e-3), math.log(1e-1))
    s5_b_re = normal(ks[15], (L, 2, S5_GROUPS, S5_STATE, S5_GROUP_CH), (2 * S5_GROUP_CH) ** -0.5)
    s5_b_im = normal(ks[16], (L, 2, S5_GROUPS, S5_STATE, S5_GROUP_CH), (2 * S5_GROUP_CH) ** -0.5)
    s5_c_re = normal(ks[17], (L, 2, S5_GROUPS, S5_GROUP_CH, S5_STATE), (2 * S5_STATE) ** -0.5)
    s5_c_im = normal(ks[18], (L, 2, S5_GROUPS, S5_GROUP_CH, S5_STATE), (2 * S5_STATE) ** -0.5)
    s5_d = normal(ks[19], (L, S5_DIM), 1.0)
    s5_glu_w = normal(ks[20], (L, S5_DIM, S5_DIM), S5_DIM ** -0.5)
    s5_glu_b = normal(ks[21], (L, S5_DIM), 0.02)
    w_mix_out = normal(ks[22], (L, D_MIX, D_MODEL), D_MIX ** -0.5 * DEEPNORM_BETA)
    ln_mix_g = 1.0 + normal(ks[23], (L, D_MODEL), 0.02)
    ln_mix_b = normal(ks[24], (L, D_MODEL), 0.02)
    xa_wq = normal(ks[25], (L, D_MODEL, XA_HEADS * XA_HEAD_DIM), D_MODEL ** -0.5)
    xa_wk = normal(ks[26], (L, D_MODEL, XA_HEADS * XA_HEAD_DIM), D_MODEL ** -0.5)
    xa_wv = normal(ks[27], (L, D_MODEL, XA_HEADS * XA_HEAD_DIM), D_MODEL ** -0.5 * DEEPNORM_BETA)
    xa_wo = normal(ks[28], (L, XA_HEADS * XA_HEAD_DIM, D_MODEL), D_MODEL ** -0.5 * DEEPNORM_BETA)
    ln_xa_g = 1.0 + normal(ks[29], (L, D_MODEL), 0.02)
    ln_xa_b = normal(ks[30], (L, D_MODEL), 0.02)
    mlp_w1 = normal(ks[31], (L, D_MODEL, D_FF), D_MODEL ** -0.5 * DEEPNORM_BETA)
    mlp_w2 = normal(ks[32], (L, D_FF, D_MODEL), D_FF ** -0.5 * DEEPNORM_BETA)
    ln_mlp_g = 1.0 + normal(ks[33], (L, D_MODEL), 0.02)
    ln_mlp_b = normal(ks[34], (L, D_MODEL), 0.02)
    return {
        'x': x, 'mem': mem, 'ln_in_g': ln_in_g, 'ln_in_b': ln_in_b, 'w_in': w_in, 'na_rpb': na_rpb,
        'ssd_conv_w': ssd_conv_w, 'ssd_conv_b': ssd_conv_b, 'ssd_dt_bias': ssd_dt_bias,
        'ssd_a_log': ssd_a_log, 'ssd_d': ssd_d, 'ssd_norm_w': ssd_norm_w,
        's5_lam_re': s5_lam_re, 's5_lam_im': s5_lam_im, 's5_log_dt': s5_log_dt,
        's5_b_re': s5_b_re, 's5_b_im': s5_b_im, 's5_c_re': s5_c_re, 's5_c_im': s5_c_im,
        's5_d': s5_d, 's5_glu_w': s5_glu_w, 's5_glu_b': s5_glu_b, 'w_mix_out': w_mix_out,
        'ln_mix_g': ln_mix_g, 'ln_mix_b': ln_mix_b, 'xa_wq': xa_wq, 'xa_wk': xa_wk,
        'xa_wv': xa_wv, 'xa_wo': xa_wo, 'ln_xa_g': ln_xa_g, 'ln_xa_b': ln_xa_b,
        'mlp_w1': mlp_w1, 'mlp_w2': mlp_w2, 'ln_mlp_g': ln_mlp_g, 'ln_mlp_b': ln_mlp_b,
    }


def reference(x, mem, ln_in_g, ln_in_b, w_in, na_rpb, ssd_conv_w, ssd_conv_b, ssd_dt_bias,
              ssd_a_log, ssd_d, ssd_norm_w, s5_lam_re, s5_lam_im, s5_log_dt, s5_b_re, s5_b_im,
              s5_c_re, s5_c_im, s5_d, s5_glu_w, s5_glu_b, w_mix_out, ln_mix_g, ln_mix_b,
              xa_wq, xa_wk, xa_wv, xa_wo, ln_xa_g, ln_xa_b, mlp_w1, mlp_w2, ln_mlp_g, ln_mlp_b):
    h = layernorm(x, ln_in_g, ln_in_b)
    for l in range(DEPTH):
        mix = hybrid_mixer(h, w_in[l], na_rpb[l], ssd_conv_w[l], ssd_conv_b[l], ssd_dt_bias[l],
                           ssd_a_log[l], ssd_d[l], ssd_norm_w[l], s5_lam_re[l], s5_lam_im[l],
                           s5_log_dt[l], s5_b_re[l], s5_b_im[l], s5_c_re[l], s5_c_im[l], s5_d[l],
                           s5_glu_w[l], s5_glu_b[l], w_mix_out[l])
        h = layernorm(DEEPNORM_ALPHA * h + mix, ln_mix_g[l], ln_mix_b[l])
        xa = cross_attention(h, mem, xa_wq[l], xa_wk[l], xa_wv[l], xa_wo[l])
        h = layernorm(DEEPNORM_ALPHA * h + xa, ln_xa_g[l], ln_xa_b[l])
        ff = squared_relu_mlp(h, mlp_w1[l], mlp_w2[l])
        h = layernorm(DEEPNORM_ALPHA * h + ff, ln_mlp_g[l], ln_mlp_b[l])
    return h
```

```cpp
#include <hip/hip_runtime.h>
#include <hip/hip_cooperative_groups.h>
#include <cstdio>
#include <cstdint>
namespace cg = cooperative_groups;

#define LAS __attribute__((address_space(3)))
typedef unsigned short bf16_t;
typedef short bf16x8 __attribute__((ext_vector_type(8)));
typedef float f32x4 __attribute__((ext_vector_type(4)));
typedef float f32x2 __attribute__((ext_vector_type(2)));
typedef unsigned u32x4 __attribute__((ext_vector_type(4)));
typedef unsigned u32x2 __attribute__((ext_vector_type(2)));

constexpr int B_ = 8, T_ = 8192, D_ = 1024, M_ = B_ * T_, NP = 2320, NPP = 2560, FF_ = 4096, MEMT = 256;
constexpr float LN_EPS = 1e-5f;
constexpr float ALPHA = 1.41421356237f;
constexpr int PQ = 0, PK = 256, PV = 512, PZ = 768, PX = 1280, PDT = 2048, PU = 2064;

constexpr size_t MiB = 1u << 20;
constexpr size_t WS_W = 1 * MiB, LWB = 32 * MiB;
constexpr size_t OW_IN = 0, OW_OUT = 5 * MiB, OW_Q = 7 * MiB, OW_K = 9 * MiB, OW_V = 11 * MiB, OW_O = 13 * MiB, OW_1 = 15 * MiB, OW_2 = 23 * MiB, OW_GLU = 31 * MiB;
constexpr size_t WS_MEMB = 65 * MiB, WS_KM = 69 * MiB, WS_VMT = 77 * MiB, WS_TM = 85 * MiB, WS_SM = 93 * MiB, WS_MISC = 97 * MiB;
constexpr size_t WS_HB = 100 * MiB, WS_PROJ = 228 * MiB, WS_MIXED = 518 * MiB, WS_CONV = 646 * MiB, WS_HID = 228 * MiB;
constexpr size_t WS_S = 228 * MiB, WS_QB = 484 * MiB, WS_OB = 612 * MiB, WS_ST = 744 * MiB, WS_UX = 872 * MiB, WS_S5S = 936 * MiB, WS_SL = 1000 * MiB, WS_END = 1004 * MiB;
constexpr size_t MISC_CS = 262144;
constexpr int LDS_BYTES = 157696 + 64;

__device__ __forceinline__ float bf2f(unsigned u) { return __uint_as_float(u << 16); }
__device__ __forceinline__ float bflo(unsigned u) { return __uint_as_float(u << 16); }
__device__ __forceinline__ float bfhi(unsigned u) { return __uint_as_float(u & 0xffff0000u); }
__device__ __forceinline__ unsigned f2bf(float f) { unsigned u = __float_as_uint(f); return (u + 0x7fffu + ((u >> 16) & 1u)) >> 16; }
__device__ __forceinline__ unsigned pk2(float lo, float hi) { return f2bf(lo) | (f2bf(hi) << 16); }
__device__ __forceinline__ unsigned pk2hw(float lo, float hi) { unsigned r; asm volatile("v_cvt_pk_bf16_f32 %0, %1, %2" : "=v"(r) : "v"(lo), "v"(hi)); return r; }
__device__ __forceinline__ float wave_sum(float v) {
#pragma unroll
    for (int o = 1; o < 64; o <<= 1) v += __shfl_xor(v, o);
    return v;
}
__device__ __forceinline__ float wave_max(float v) {
#pragma unroll
    for (int o = 1; o < 64; o <<= 1) v = fmaxf(v, __shfl_xor(v, o));
    return v;
}
__device__ __forceinline__ float silu_f(float x) { return x * __builtin_amdgcn_rcpf(1.f + __expf(-x)); }
__device__ __forceinline__ float gelu_tanh(float x) { const float y = 0.7978845608f * (x + 0.044715f * x * x * x); const float t = 1.f - 2.f * __builtin_amdgcn_rcpf(1.f + __expf(2.f * y)); return 0.5f * x * (1.f + t); }
__device__ __forceinline__ int ltid() { int t = threadIdx.x; asm volatile("" : "+v"(t)); return t; }
__device__ __forceinline__ int lbid() { int t = blockIdx.x; asm volatile("" : "+s"(t)); return t; }
#define GAS __attribute__((address_space(1)))
__device__ __forceinline__ size_t zopq() { size_t z = 0; asm volatile("" : "+s"(z)); return z; }
template <class P> __device__ __forceinline__ P* gp(P* p) { return (P*)((char*)p + zopq()); }
template <class P> __device__ __forceinline__ P* lptr(P* p) { return (P*)((char*)p + zopq()); }
#define LDS_WAIT() asm volatile("s_waitcnt lgkmcnt(0)" ::: "memory")

namespace pg8 {
constexpr int BM = 256, BK = 64, HALF = 128, HTB = HALF * BK * 2, STAGE_BYTES = 8 * HTB;
__host__ __device__ __forceinline__ int lds_byte(int r, int c) { const int st = (r >> 4) * 2 + (c >> 5), rr = r & 15, cc = c & 31, ob = rr * 64 + cc * 2; return st * 1024 + (ob ^ (((ob >> 9) & 1) << 5)); }
__host__ __device__ __forceinline__ void stage_rc(int b, int& R, int& C) { const int st = b / 1024, sb = b % 1024, swz = sb ^ (((sb >> 9) & 1) << 5); R = (st >> 1) * 16 + swz / 64; C = (st & 1) * 32 + (swz % 64) / 2; }
__host__ __device__ __forceinline__ int perm32(int rho) { const int n = rho >> 4, i = rho & 15; return 8 * (i >> 2) + 4 * n + (i & 3); }

struct Unit { int pm, pn, b1, b2; };
struct Gemm { const bf16_t* A; const bf16_t* Bt; int lda, ldb, K; size_t aS1, aS2, bS1, bS2; };

struct Sched {
    int nM, nN, nB2, total, G, c;
    __device__ __forceinline__ void init(int nM_, int nN_, int nB1_, int nB2_, int G_, int c_) { nM = nM_; nN = nN_; nB2 = nB2_; total = nM_ * nN_ * nB1_ * nB2_; G = G_; c = c_; }
    __device__ __forceinline__ bool next(int i, Unit& u) const {
        const long L = (long)i * G + c; if (L >= total) return false;
        int w = (int)L;
        { const int q = total / 8, r = total % 8, xcd = w % 8, off = w / 8; w = (xcd < r ? xcd * (q + 1) : r * (q + 1) + (xcd - r) * q) + off; }
        const int per = nM * nN; const int bt = w / per; w -= bt * per;
        const int nig = 8 * nN, gid = w / nig, fm = gid * 8, gsz = (nM - fm) < 8 ? (nM - fm) : 8;
        u.pm = fm + ((w % nig) % gsz); u.pn = (w % nig) / gsz; u.b1 = bt / nB2; u.b2 = bt % nB2; return true;
    }
};

typedef f32x4 Acc[2][2][4][2];

template <int ACT> struct EpiStore {
    static constexpr bool PERM = true;
    bf16_t* C; int ldc; size_t cS1, cS2; int ncols; float scale;
    __device__ __forceinline__ void operator()(const Acc& acc, const Unit& u, int wr, int wc, int fr, int fq) const {
        asm volatile("" : "+v"(fr), "+v"(fq));
        bf16_t* base = C + u.b1 * cS1 + u.b2 * cS2;
        const int row0 = u.pm * BM + wr * 64 + fr, col0 = u.pn * BM + wc * 32 + 8 * fq;
#pragma unroll
        for (int ai = 0; ai < 2; ++ai)
#pragma unroll
            for (int m = 0; m < 4; ++m) { bf16_t* rowp = base + (size_t)(row0 + ai * HALF + m * 16) * ldc + col0;
#pragma unroll
                for (int bj = 0; bj < 2; ++bj) { f32x4 v0 = acc[ai][bj][m][0], v1 = acc[ai][bj][m][1];
                    if (ACT == 1) {
#pragma unroll
                        for (int e = 0; e < 4; ++e) { float a0 = fmaxf(v0[e], 0.f), a1 = fmaxf(v1[e], 0.f); v0[e] = a0 * a0; v1[e] = a1 * a1; } }
                    v0 = v0 * scale; v1 = v1 * scale;
                    u32x4 w; w.x = pk2(v0[0], v0[1]); w.y = pk2(v0[2], v0[3]); w.z = pk2(v1[0], v1[1]); w.w = pk2(v1[2], v1[3]);
                    if (col0 + bj * HALF < ncols) *(u32x4*)(rowp + bj * HALF) = w; }
                asm volatile("" ::: "memory"); }
    }
};
struct EpiF32 {
    static constexpr bool PERM = false;
    float* C; int ldc; size_t cS1, cS2;
    __device__ __forceinline__ void operator()(const Acc& acc, const Unit& u, int wr, int wc, int fr, int fq) const {
        asm volatile("" : "+v"(fr), "+v"(fq));
        float* base = C + u.b1 * cS1 + u.b2 * cS2;
        const int row0 = u.pm * BM + wr * 64 + fr, col0 = u.pn * BM + wc * 32 + 4 * fq;
#pragma unroll
        for (int ai = 0; ai < 2; ++ai)
#pragma unroll
            for (int m = 0; m < 4; ++m) { float* rowp = base + (size_t)(row0 + ai * HALF + m * 16) * ldc + col0;
#pragma unroll
                for (int bj = 0; bj < 2; ++bj)
#pragma unroll
                    for (int n = 0; n < 2; ++n) *(f32x4*)(rowp + bj * HALF + n * 16) = acc[ai][bj][m][n];
                asm volatile("" ::: "memory"); }
    }
};
struct EpiResid {
    static constexpr bool PERM = false;
    float* H; float alpha;
    __device__ __forceinline__ void operator()(const Acc& acc, const Unit& u, int wr, int wc, int fr, int fq) const {
        asm volatile("" : "+v"(fr), "+v"(fq));
        const int row0 = u.pm * BM + wr * 64 + fr, col0 = u.pn * BM + wc * 32 + 4 * fq;
#pragma unroll
        for (int ai = 0; ai < 2; ++ai)
#pragma unroll
            for (int m = 0; m < 4; ++m) { float* rowp = H + (size_t)(row0 + ai * HALF + m * 16) * D_ + col0;
#pragma unroll
                for (int bj = 0; bj < 2; ++bj)
#pragma unroll
                    for (int n = 0; n < 2; ++n) { f32x4* p = (f32x4*)(rowp + bj * HALF + n * 16); const f32x4 h = *p; *p = h * alpha + acc[ai][bj][m][n]; }
                asm volatile("" ::: "memory"); }
    }
};
struct EpiS5Y {
    static constexpr bool PERM = true;
    bf16_t* MIXED;
    __device__ __forceinline__ void operator()(const Acc& acc, const Unit& u, int wr, int wc, int fr, int fq) const {
        asm volatile("" : "+v"(fr), "+v"(fq));
        const int row0 = u.pm * BM + wr * 64 + fr, col0 = wc * 32 + 8 * fq;
#pragma unroll
        for (int ai = 0; ai < 2; ++ai)
#pragma unroll
            for (int m = 0; m < 4; ++m) { const int row = row0 + ai * HALF + m * 16;
#pragma unroll
                for (int bj = 0; bj < 2; ++bj) { const int col = col0 + bj * HALF, j = col >> 4, ho = col & 15;
                    const f32x4 v0 = acc[ai][bj][m][0], v1 = acc[ai][bj][m][1];
                    u32x4 w; w.x = pk2(gelu_tanh(v0[0]), gelu_tanh(v0[1])); w.y = pk2(gelu_tanh(v0[2]), gelu_tanh(v0[3])); w.z = pk2(gelu_tanh(v1[0]), gelu_tanh(v1[1])); w.w = pk2(gelu_tanh(v1[2]), gelu_tanh(v1[3]));
                    *(u32x4*)(MIXED + ((size_t)row * 16 + j) * D_ + 768 + u.b1 * 16 + ho) = w; asm volatile("" ::: "memory"); } }
    }
};
struct EpiGLU {
    static constexpr bool PERM = true;
    bf16_t* MIXED; const float* bias;
    __device__ __forceinline__ void operator()(const Acc& acc, const Unit& u, int wr, int wc, int fr, int fq) const {
        asm volatile("" : "+v"(fr), "+v"(fq));
        const int row0 = u.pm * BM + wr * 64 + fr, col0 = wc * 32 + 8 * fq;
#pragma unroll
        for (int ai = 0; ai < 2; ++ai)
#pragma unroll
            for (int m = 0; m < 4; ++m) { const int row = row0 + ai * HALF + m * 16;
#pragma unroll
                for (int bj = 0; bj < 2; ++bj) { const int col = col0 + bj * HALF;
                    u32x4* gp = (u32x4*)(MIXED + (size_t)row * D_ + 768 + col); const u32x4 gv = *gp;
                    const f32x4 b0 = *(const f32x4*)(bias + col), b1 = *(const f32x4*)(bias + col + 4);
                    const f32x4 v0 = acc[ai][bj][m][0] + b0, v1 = acc[ai][bj][m][1] + b1;
                    float o[8]; const unsigned gw[4] = {gv.x, gv.y, gv.z, gv.w};
#pragma unroll
                    for (int e = 0; e < 4; ++e) { const float a = e < 2 ? v0[2 * e] : v1[2 * e - 4], b = e < 2 ? v0[2 * e + 1] : v1[2 * e - 3];
                        o[2 * e] = bflo(gw[e]) * __builtin_amdgcn_rcpf(1.f + __expf(-a)); o[2 * e + 1] = bfhi(gw[e]) * __builtin_amdgcn_rcpf(1.f + __expf(-b)); }
                    u32x4 w; w.x = pk2(o[0], o[1]); w.y = pk2(o[2], o[3]); w.z = pk2(o[4], o[5]); w.w = pk2(o[6], o[7]);
                    *gp = w; asm volatile("" ::: "memory"); } }
    }
};

struct EpiSoftmax {
    static constexpr bool PERM = true;
    bf16_t* C; int ldc; size_t cS1, cS2; LAS float* red;
    __device__ __forceinline__ void operator()(const Acc& acc, const Unit& u, int wr, int wc, int fr, int fq) const {
        asm volatile("" : "+v"(fr), "+v"(fq));
        LAS float* red2 = red + 1024;
        float mx[2][4];
#pragma unroll
        for (int ai = 0; ai < 2; ++ai)
#pragma unroll
            for (int m = 0; m < 4; ++m) { float v = -1e30f;
#pragma unroll
                for (int bj = 0; bj < 2; ++bj)
#pragma unroll
                    for (int n = 0; n < 2; ++n) { const f32x4 x = acc[ai][bj][m][n]; v = fmaxf(v, fmaxf(fmaxf(x[0], x[1]), fmaxf(x[2], x[3]))); }
                v = fmaxf(v, __shfl_xor(v, 16)); v = fmaxf(v, __shfl_xor(v, 32));
                if (fq == 0) red[(ai * HALF + wr * 64 + m * 16 + fr) * 4 + wc] = v; }
        asm volatile("s_waitcnt lgkmcnt(0)" ::: "memory"); __builtin_amdgcn_s_barrier(); asm volatile("" ::: "memory");
        float sm[2][4];
#pragma unroll
        for (int ai = 0; ai < 2; ++ai)
#pragma unroll
            for (int m = 0; m < 4; ++m) { const f32x4 r4 = *(const LAS f32x4*)(red + (ai * HALF + wr * 64 + m * 16 + fr) * 4);
                const float M = fmaxf(fmaxf(r4[0], r4[1]), fmaxf(r4[2], r4[3])); mx[ai][m] = M; float s = 0.f;
#pragma unroll
                for (int bj = 0; bj < 2; ++bj)
#pragma unroll
                    for (int n = 0; n < 2; ++n) { const f32x4 x = acc[ai][bj][m][n]; s += (__expf(x[0] - M) + __expf(x[1] - M)) + (__expf(x[2] - M) + __expf(x[3] - M)); }
                s += __shfl_xor(s, 16); s += __shfl_xor(s, 32);
                if (fq == 0) red2[(ai * HALF + wr * 64 + m * 16 + fr) * 4 + wc] = s; }
        asm volatile("s_waitcnt lgkmcnt(0)" ::: "memory"); __builtin_amdgcn_s_barrier(); asm volatile("" ::: "memory");
        bf16_t* base = C + u.b1 * cS1 + u.b2 * cS2;
        const int row0 = u.pm * BM + wr * 64 + fr, col0 = wc * 32 + 8 * fq;
#pragma unroll
        for (int ai = 0; ai < 2; ++ai)
#pragma unroll
            for (int m = 0; m < 4; ++m) { const f32x4 r4 = *(const LAS f32x4*)(red2 + (ai * HALF + wr * 64 + m * 16 + fr) * 4);
                const float inv = 1.f / ((r4[0] + r4[1]) + (r4[2] + r4[3])), M = mx[ai][m];
                bf16_t* rowp = base + (size_t)(row0 + ai * HALF + m * 16) * ldc + col0;
#pragma unroll
                for (int bj = 0; bj < 2; ++bj) { const f32x4 v0 = acc[ai][bj][m][0], v1 = acc[ai][bj][m][1];
                    u32x4 w; w.x = pk2(__expf(v0[0] - M) * inv, __expf(v0[1] - M) * inv); w.y = pk2(__expf(v0[2] - M) * inv, __expf(v0[3] - M) * inv);
                    w.z = pk2(__expf(v1[0] - M) * inv, __expf(v1[1] - M) * inv); w.w = pk2(__expf(v1[2] - M) * inv, __expf(v1[3] - M) * inv);
                    *(u32x4*)(rowp + bj * HALF) = w; }
                asm volatile("" ::: "memory"); }
    }
};


__device__ __forceinline__ void row_stats(const float* SL, size_t row, float& mu, float& rs) {
    const f32x4 a = *(const f32x4*)(SL + row * 8), b = *(const f32x4*)(SL + row * 8 + 4);
    const float S = (a[0] + a[2]) + (b[0] + b[2]), Q = (a[1] + a[3]) + (b[1] + b[3]);
    mu = S * (1.f / D_); rs = rsqrtf(fmaxf(Q * (1.f / D_) - mu * mu, 0.f) + LN_EPS);
}
template <bool FIRST> struct EpiResidLN {
    static constexpr bool PERM = false;
    float* H; bf16_t* HB; const float* SLr; float* SLw; const LAS float* gl; const float* unused_; LAS float* red; float alpha;
    __device__ __forceinline__ void operator()(const Acc& acc, const Unit& u, int wr, int wc, int fr, int fq) const {
        asm volatile("" : "+v"(fr), "+v"(fq));
        const int col0 = u.pn * BM + wc * 32 + 4 * fq;
        const size_t rowb = (size_t)u.pm * BM + wr * 64 + fr;
        f32x4 hA[4], hB[4], sna = (f32x4){0.f, 0.f, 0.f, 0.f}, snb = (f32x4){0.f, 0.f, 0.f, 0.f};
        if (!FIRST) { sna = *(const f32x4*)(SLr + rowb * 8); snb = *(const f32x4*)(SLr + rowb * 8 + 4); }
#pragma unroll
        for (int q = 0; q < 4; ++q) { hA[q] = *(const f32x4*)(H + rowb * D_ + col0 + (q >> 1) * HALF + (q & 1) * 16); hB[q] = *(const f32x4*)(H + (rowb + 16) * D_ + col0 + (q >> 1) * HALF + (q & 1) * 16); }
#pragma unroll
        for (int i = 0; i < 8; ++i) { const int ai = i >> 2, m = i & 3; const int rl = ai * HALF + wr * 64 + m * 16 + fr; const size_t row = (size_t)u.pm * BM + rl;
                float mu = 0.f, rs = 1.f;
                if (!FIRST) { const float S = (sna[0] + sna[2]) + (snb[0] + snb[2]), Q = (sna[1] + sna[3]) + (snb[1] + snb[3]); mu = S * (1.f / D_); rs = rsqrtf(fmaxf(Q * (1.f / D_) - mu * mu, 0.f) + LN_EPS); }
                f32x4 hc[4];
#pragma unroll
                for (int q = 0; q < 4; ++q) { hc[q] = hA[q]; hA[q] = hB[q]; }
                if (i < 7) { const size_t rown = rowb + ((i + 1) >> 2) * HALF + ((i + 1) & 3) * 16;
                    if (!FIRST) { sna = *(const f32x4*)(SLr + rown * 8); snb = *(const f32x4*)(SLr + rown * 8 + 4); } }
                if (i < 6) { const size_t rown = rowb + ((i + 2) >> 2) * HALF + ((i + 2) & 3) * 16;
#pragma unroll
                    for (int q = 0; q < 4; ++q) hB[q] = *(const f32x4*)(H + rown * D_ + col0 + (q >> 1) * HALF + (q & 1) * 16); }
                float sm = 0.f, sq = 0.f; float* hp = H + row * D_ + col0; bf16_t* bp = HB + row * D_ + col0;
#pragma unroll
                for (int q = 0; q < 4; ++q) { const int bj = q >> 1, n = q & 1, co = bj * HALF + n * 16; f32x4 h = hc[q];
                        if (!FIRST) { const f32x4 g = *(const LAS f32x4*)(gl + col0 + co), b = *(const LAS f32x4*)(gl + D_ + col0 + co); h = (h - mu) * rs * g + b; }
                        const f32x4 pre = h * alpha + acc[ai][bj][m][n]; *(f32x4*)(hp + co) = pre;
                        if (HB) { u32x2 w; w.x = pk2(pre[0], pre[1]); w.y = pk2(pre[2], pre[3]); *(u32x2*)(bp + co) = w; }
                        sm += (pre[0] + pre[1]) + (pre[2] + pre[3]); sq += (pre[0] * pre[0] + pre[1] * pre[1]) + (pre[2] * pre[2] + pre[3] * pre[3]); }
                sm += __shfl_xor(sm, 16); sm += __shfl_xor(sm, 32); sq += __shfl_xor(sq, 16); sq += __shfl_xor(sq, 32);
                if (fq == 0) *(LAS f32x2*)(red + (rl * 4 + wc) * 2) = (f32x2){sm, sq};
                asm volatile("" ::: "memory"); }
        asm volatile("s_waitcnt lgkmcnt(0)" ::: "memory"); __builtin_amdgcn_s_barrier(); asm volatile("" ::: "memory");
        const int t = (wr * 4 + wc) * 64 + fq * 16 + fr;
        if (t < 256) { const f32x4 p0 = *(const LAS f32x4*)(red + t * 8), p1 = *(const LAS f32x4*)(red + t * 8 + 4);
            *(f32x2*)(SLw + ((size_t)u.pm * BM + t) * 8 + u.pn * 2) = (f32x2){(p0[0] + p0[2]) + (p1[0] + p1[2]), (p0[1] + p0[3]) + (p1[1] + p1[3])}; }
    }
};
template <int ACT> struct EpiStoreLN {
    static constexpr bool PERM = true;
    bf16_t* C; int ldc; int ncols; float scale; const float* SLr; const float* CS; const float* CB;
    __device__ __forceinline__ void operator()(const Acc& acc, const Unit& u, int wr, int wc, int fr, int fq) const {
        asm volatile("" : "+v"(fr), "+v"(fq));
        const int row0 = u.pm * BM + wr * 64 + fr, col0 = u.pn * BM + wc * 32 + 8 * fq;
        f32x4 cs[2][2], cbv[2][2];
#pragma unroll
        for (int bj = 0; bj < 2; ++bj) { const int c = col0 + bj * HALF; cs[bj][0] = *(const f32x4*)(CS + c); cs[bj][1] = *(const f32x4*)(CS + c + 4); cbv[bj][0] = *(const f32x4*)(CB + c); cbv[bj][1] = *(const f32x4*)(CB + c + 4); }
        f32x4 sna = *(const f32x4*)(SLr + (size_t)row0 * 8), snb = *(const f32x4*)(SLr + (size_t)row0 * 8 + 4);
#pragma unroll
        for (int i = 0; i < 8; ++i) { const int ai = i >> 2, m = i & 3; const size_t row = (size_t)(row0 + ai * HALF + m * 16);
            const float S = (sna[0] + sna[2]) + (snb[0] + snb[2]), Q = (sna[1] + sna[3]) + (snb[1] + snb[3]); const float mu = S * (1.f / D_), rs = rsqrtf(fmaxf(Q * (1.f / D_) - mu * mu, 0.f) + LN_EPS);
            if (i < 7) { const size_t rown = (size_t)(row0 + ((i + 1) >> 2) * HALF + ((i + 1) & 3) * 16); sna = *(const f32x4*)(SLr + rown * 8); snb = *(const f32x4*)(SLr + rown * 8 + 4); }
            bf16_t* rowp = C + row * ldc + col0;
#pragma unroll
            for (int bj = 0; bj < 2; ++bj) { const int c = col0 + bj * HALF;
                f32x4 v0 = (acc[ai][bj][m][0] - cs[bj][0] * mu) * rs + cbv[bj][0], v1 = (acc[ai][bj][m][1] - cs[bj][1] * mu) * rs + cbv[bj][1];
                if (ACT == 1) {
#pragma unroll
                    for (int e = 0; e < 4; ++e) { float a0 = fmaxf(v0[e], 0.f), a1 = fmaxf(v1[e], 0.f); v0[e] = a0 * a0; v1[e] = a1 * a1; } }
                v0 = v0 * scale; v1 = v1 * scale;
                u32x4 w; w.x = pk2(v0[0], v0[1]); w.y = pk2(v0[2], v0[3]); w.z = pk2(v1[0], v1[1]); w.w = pk2(v1[2], v1[3]);
                if (c < ncols) *(u32x4*)(rowp + bj * HALF) = w; }
            asm volatile("" ::: "memory"); }
    }
};

template <class Epi>
__device__ __forceinline__ void gemm_phase(LAS unsigned char* lds, const Gemm g, const Sched& S, const Epi& E) {
    constexpr bool ALIGN_EPI = true;
    const int tid = ltid(), wid = __builtin_amdgcn_readfirstlane(tid >> 6), lane = tid & 63, wr = wid >> 2, wc = wid & 3, fr = lane & 15, fq = lane >> 4;
    int K_ = g.K; asm volatile("" : "+s"(K_)); const int K = K_, nt = K / BK;
    unsigned voffA[2], voffB[2];
#pragma unroll
    for (int i = 0; i < 2; ++i) { int R, C; stage_rc(tid * 16 + i * 8192, R, C); const int Rb = Epi::PERM ? ((R & ~31) + perm32(R & 31)) : R;
        voffA[i] = (unsigned)(R * g.lda + C) * 2u; voffB[i] = (unsigned)(Rb * g.ldb + C) * 2u; }
    const size_t kstep = (size_t)(BK * 2);
    const size_t hstepA = (size_t)HALF * g.lda * 2, hstepB = (size_t)HALF * g.ldb * 2;
    const unsigned ldsw = (unsigned)wid * 1024u;
    const int aoff = lds_byte(wr * 64 + fr, fq * 8), boff = lds_byte(wc * 32 + fr, fq * 8);
#define PG8_UA(u) ((const char*)g.A + ((size_t)(u).b1 * g.aS1 + (size_t)(u).b2 * g.aS2 + (size_t)(u).pm * BM * g.lda) * 2)
#define PG8_UB(u) ((const char*)g.Bt + ((size_t)(u).b1 * g.bS1 + (size_t)(u).b2 * g.bS2 + (size_t)(u).pn * BM * g.ldb) * 2)
#define PG8_SA(b, h) (((b) * 2 + (h)) * HTB)
#define PG8_SB(b, h) ((4 + (b) * 2 + (h)) * HTB)
#define PG8_STAGE(bufoff, gbase, voff) do { _Pragma("unroll") for (int _i = 0; _i < 2; ++_i) \
        __builtin_amdgcn_global_load_lds((const unsigned*)((const char*)(gbase) + (voff)[_i]), (LAS unsigned*)(lds + (bufoff) + ldsw + _i * 8192), 16, 0, 0); } while (0)
#define PG8_LDA(dst, b, h) do { _Pragma("unroll") for (int m = 0; m < 4; ++m) _Pragma("unroll") for (int k = 0; k < 2; ++k) dst[m][k] = *(const LAS bf16x8*)(lds + PG8_SA(b, h) + aoff + m * 2048 + k * 1024); } while (0)
#define PG8_LDB(dst, b, h) do { _Pragma("unroll") for (int n = 0; n < 2; ++n) _Pragma("unroll") for (int k = 0; k < 2; ++k) dst[n][k] = *(const LAS bf16x8*)(lds + PG8_SB(b, h) + boff + n * 2048 + k * 1024); } while (0)
#define PG8_MMA(ai, bj, At, Bt) do { __builtin_amdgcn_s_setprio(1); _Pragma("unroll") for (int m = 0; m < 4; ++m) _Pragma("unroll") for (int n = 0; n < 2; ++n) _Pragma("unroll") for (int k = 0; k < 2; ++k) \
        acc[ai][bj][m][n] = __builtin_amdgcn_mfma_f32_16x16x32_bf16(Bt[n][k], At[m][k], acc[ai][bj][m][n], 0, 0, 0); __builtin_amdgcn_s_setprio(0); } while (0)
#define PG8_WAIT_V(n) asm volatile("s_waitcnt vmcnt(" #n ")" ::: "memory")
#define PG8_WAIT_L(n) asm volatile("s_waitcnt lgkmcnt(" #n ")" ::: "memory")
#define PG8_BAR __builtin_amdgcn_s_barrier()
#define PG8_SCHED __builtin_amdgcn_sched_barrier(0)
    Unit cur, nxt; int ui = 0;
    if (!S.next(0, cur)) return;
    Acc acc;
#pragma unroll
    for (int a = 0; a < 2; ++a)
#pragma unroll
        for (int b = 0; b < 2; ++b)
#pragma unroll
            for (int m = 0; m < 4; ++m)
#pragma unroll
                for (int n = 0; n < 2; ++n) acc[a][b][m][n] = (f32x4){0.f, 0.f, 0.f, 0.f};
    bf16x8 At[4][2], B0[2][2], B1[2][2];
    const char* cA = PG8_UA(cur); const char* cB = PG8_UB(cur);
    PG8_STAGE(PG8_SB(0, 0), cB, voffB); PG8_STAGE(PG8_SB(0, 1), cB + hstepB, voffB); PG8_STAGE(PG8_SA(0, 0), cA, voffA); PG8_STAGE(PG8_SA(0, 1), cA + hstepA, voffA);
    if (wr == 1) PG8_BAR;
    PG8_WAIT_V(2); PG8_BAR;
    PG8_STAGE(PG8_SB(1, 0), cB + kstep, voffB); PG8_STAGE(PG8_SA(1, 0), cA + kstep, voffA); PG8_STAGE(PG8_SB(1, 1), cB + hstepB + kstep, voffB);
    PG8_WAIT_V(6); PG8_BAR;
    for (;;) {
        const bool has_next = S.next(ui + 1, nxt);
        const char* nA = has_next ? PG8_UA(nxt) : cA; const char* nB = has_next ? PG8_UB(nxt) : cB;
        for (int t = 0; t < nt; t += 2) {
            const bool last = (t == nt - 2);
            const char* a1 = cA + (size_t)(t + 1) * kstep;
            const char* a2 = last ? nA : cA + (size_t)(t + 2) * kstep; const char* b2 = last ? nB : cB + (size_t)(t + 2) * kstep;
            const char* a3 = a2 + kstep; const char* b3 = b2 + kstep;
            PG8_LDB(B0, 0, 0); PG8_LDB(B1, 0, 1); PG8_SCHED; PG8_LDA(At, 0, 0); PG8_STAGE(PG8_SA(1, 1), a1 + hstepA, voffA);
            PG8_WAIT_V(8); PG8_WAIT_L(0); PG8_BAR; PG8_MMA(0, 0, At, B0); PG8_MMA(0, 1, At, B1); PG8_BAR; PG8_SCHED;
            PG8_LDA(At, 0, 1); PG8_STAGE(PG8_SB(0, 0), b2, voffB); PG8_STAGE(PG8_SB(0, 1), b2 + hstepB, voffB); PG8_STAGE(PG8_SA(0, 0), a2, voffA);
            PG8_WAIT_V(8); PG8_WAIT_L(0); PG8_BAR; PG8_MMA(1, 0, At, B0); PG8_MMA(1, 1, At, B1); PG8_BAR; PG8_SCHED;
            PG8_LDB(B0, 1, 0); PG8_LDB(B1, 1, 1); PG8_SCHED; PG8_LDA(At, 1, 0); PG8_STAGE(PG8_SA(0, 1), a2 + hstepA, voffA);
            PG8_WAIT_V(8); PG8_WAIT_L(0); PG8_BAR; PG8_MMA(0, 0, At, B0); PG8_MMA(0, 1, At, B1); PG8_BAR; PG8_SCHED;
            PG8_LDA(At, 1, 1); PG8_STAGE(PG8_SB(1, 0), b3, voffB); PG8_STAGE(PG8_SB(1, 1), b3 + hstepB, voffB); PG8_STAGE(PG8_SA(1, 0), a3, voffA);
            PG8_WAIT_V(8); PG8_WAIT_L(0); PG8_BAR; PG8_MMA(1, 0, At, B0); PG8_MMA(1, 1, At, B1); PG8_BAR; PG8_SCHED;
        }
        if constexpr (ALIGN_EPI) { if (wr == 0) PG8_BAR; }
        E(acc, cur, wr, wc, fr, fq);
        if (!has_next) break;
#pragma unroll
        for (int a = 0; a < 2; ++a)
#pragma unroll
            for (int b = 0; b < 2; ++b)
#pragma unroll
                for (int m = 0; m < 4; ++m)
#pragma unroll
                    for (int n = 0; n < 2; ++n) acc[a][b][m][n] = (f32x4){0.f, 0.f, 0.f, 0.f};
        cur = nxt; cA = nA; cB = nB; ++ui;
        if constexpr (ALIGN_EPI) { if (wr == 1) PG8_BAR; }
    }
    PG8_WAIT_V(0);
    if constexpr (!ALIGN_EPI) { if (wr == 0) PG8_BAR; }
    PG8_BAR;
#undef PG8_UA
#undef PG8_UB
#undef PG8_SA
#undef PG8_SB
#undef PG8_STAGE
#undef PG8_LDA
#undef PG8_LDB
#undef PG8_MMA
#undef PG8_WAIT_V
#undef PG8_WAIT_L
#undef PG8_BAR
#undef PG8_SCHED
}
}

struct Args { const float* in[35]; float* out; unsigned char* ws; int ph_lo, ph_hi, coop, pad; };
enum { I_X = 0, I_MEM, I_LNIN_G, I_LNIN_B, I_WIN, I_RPB, I_CONVW, I_CONVB, I_DTB, I_ALOG, I_SSDD, I_SSDNW, I_LRE, I_LIM, I_LOGDT, I_BRE, I_BIM, I_CRE, I_CIM, I_S5D, I_GLUW, I_GLUB,
       I_WOUT, I_LNMIX_G, I_LNMIX_B, I_WQ, I_WK, I_WV, I_WO, I_LNXA_G, I_LNXA_B, I_W1, I_W2, I_LNMLP_G, I_LNMLP_B };

__device__ __forceinline__ int opq(int i) { asm volatile("" : "+s"(i)); return i; }
__device__ __forceinline__ void transpose_item(const float* W, int K, int N, bf16_t* WT, LAS float* scr, int item, int nblk, int lane, const float* rs) {
    const int kb = item / nblk, nb = item % nblk, k0 = 64 * kb, n0 = 32 * nb;
    const int nn = n0 + (lane & 31);
#pragma unroll
    for (int i = 0; i < 32; ++i) { const int kk = 2 * i + (lane >> 5); scr[kk * 33 + (lane & 31)] = (nn < N) ? W[(size_t)(k0 + kk) * N + nn] * (rs ? rs[k0 + kk] : 1.f) : 0.f; }
    LDS_WAIT();
    const int c = lane & 7;
#pragma unroll
    for (int j = 0; j < 4; ++j) { const int n = (lane >> 3) + 8 * j; const LAS float* s = scr + (8 * c) * 33 + n;
        u32x4 o; o.x = pk2(s[0 * 33], s[1 * 33]); o.y = pk2(s[2 * 33], s[3 * 33]); o.z = pk2(s[4 * 33], s[5 * 33]); o.w = pk2(s[6 * 33], s[7 * 33]);
        *(u32x4*)(WT + (size_t)(n0 + n) * K + k0 + 8 * c) = o; }
    LDS_WAIT();
}
__device__ __forceinline__ void tr_matrix(const float* W, int K, int N, int nblk, bf16_t* WT, LAS float* scr, int gw, int NGW, int lane, const float* rs = nullptr) {
    const int nitems = (K / 64) * nblk;
    for (int it = gw; it < nitems; it += NGW) transpose_item(W, K, N, WT, scr, it, nblk, lane, rs);
}
__device__ __forceinline__ void ln_row(const float* xrow, float* hrow, bf16_t* brow, const float* gam, const float* bet, int lane) {
    const f32x4* xr = (const f32x4*)xrow + lane;
    f32x4 v[4]; float s = 0.f;
#pragma unroll
    for (int j = 0; j < 4; ++j) { v[j] = xr[64 * j]; s += (v[j].x + v[j].y) + (v[j].z + v[j].w); }
    const float mean = wave_sum(s) * (1.f / D_); float s2 = 0.f;
#pragma unroll
    for (int j = 0; j < 4; ++j) { v[j] = v[j] - mean; s2 += (v[j].x * v[j].x + v[j].y * v[j].y) + (v[j].z * v[j].z + v[j].w * v[j].w); }
    const float rstd = rsqrtf(wave_sum(s2) * (1.f / D_) + LN_EPS);
    f32x4* ho = (f32x4*)hrow + lane; u32x2* bo = (u32x2*)brow + lane;
#pragma unroll
    for (int j = 0; j < 4; ++j) { const f32x4 g = ((const f32x4*)gam)[lane + 64 * j], b = ((const f32x4*)bet)[lane + 64 * j];
        const f32x4 y = v[j] * rstd * g + b; ho[64 * j] = y; u32x2 w; w.x = pk2(y.x, y.y); w.y = pk2(y.z, y.w); bo[64 * j] = w; }
}

__device__ __forceinline__ void ln_row2(const float* x0, const float* x1, float* h0, float* h1, bf16_t* b0, bf16_t* b1, const float* gam, const float* bet, int lane) {
    const f32x4* xr0 = (const f32x4*)x0 + lane; const f32x4* xr1 = (const f32x4*)x1 + lane;
    f32x4 v[4], w[4]; float s = 0.f, t = 0.f;
#pragma unroll
    for (int j = 0; j < 4; ++j) { v[j] = xr0[64 * j]; w[j] = xr1[64 * j]; }
#pragma unroll
    for (int j = 0; j < 4; ++j) { s += (v[j].x + v[j].y) + (v[j].z + v[j].w); t += (w[j].x + w[j].y) + (w[j].z + w[j].w); }
#pragma unroll
    for (int o = 1; o < 64; o <<= 1) { s += __shfl_xor(s, o); t += __shfl_xor(t, o); }
    const float m0 = s * (1.f / D_), m1 = t * (1.f / D_); float s2 = 0.f, t2 = 0.f;
#pragma unroll
    for (int j = 0; j < 4; ++j) { v[j] = v[j] - m0; w[j] = w[j] - m1; s2 += (v[j].x * v[j].x + v[j].y * v[j].y) + (v[j].z * v[j].z + v[j].w * v[j].w); t2 += (w[j].x * w[j].x + w[j].y * w[j].y) + (w[j].z * w[j].z + w[j].w * w[j].w); }
#pragma unroll
    for (int o = 1; o < 64; o <<= 1) { s2 += __shfl_xor(s2, o); t2 += __shfl_xor(t2, o); }
    const float r0 = rsqrtf(s2 * (1.f / D_) + LN_EPS), r1 = rsqrtf(t2 * (1.f / D_) + LN_EPS);
    f32x4* ho0 = (f32x4*)h0 + lane; f32x4* ho1 = (f32x4*)h1 + lane; u32x2* bo0 = (u32x2*)b0 + lane; u32x2* bo1 = (u32x2*)b1 + lane;
#pragma unroll
    for (int j = 0; j < 4; ++j) { const f32x4 g = ((const f32x4*)gam)[lane + 64 * j], b = ((const f32x4*)bet)[lane + 64 * j];
        const f32x4 y0 = v[j] * r0 * g + b, y1 = w[j] * r1 * g + b; ho0[64 * j] = y0; ho1[64 * j] = y1;
        if (b0) { u32x2 p; p.x = pk2(y0.x, y0.y); p.y = pk2(y0.z, y0.w); bo0[64 * j] = p; p.x = pk2(y1.x, y1.y); p.y = pk2(y1.z, y1.w); bo1[64 * j] = p; } }
}
__device__ __forceinline__ void s5_item(const Args& a, LAS unsigned char* lds, int item, int tid) {
    const int j = item & 15, g = (item >> 4) & 15, l = item >> 8;
    LAS f32x2* Ap = (LAS f32x2*)(lds + 73728);
    LAS f32x2* Bb = (LAS f32x2*)(lds + 73728 + 17408);
    LAS f32x2* Cc = (LAS f32x2*)(lds + 73728 + 17408 + 16384);
    for (int e = tid; e < 2 * 17 * 64; e += 512) { const int p = e & 63, d = (e >> 6) % 17, dir = e / (17 * 64);
        const int gi = (l * 2 + dir) * 16 + g; const float dt = expf(gp(a.in[I_LOGDT])[gi]); const float lr = gp(a.in[I_LRE])[gi * 64 + p], li = gp(a.in[I_LIM])[gi * 64 + p];
        const float mag = expf((float)d * lr * dt); const float th = (float)d * (li * dt); Ap[e] = (f32x2){mag * cosf(th), mag * sinf(th)}; }
    for (int e = tid; e < 2 * 64 * 16; e += 512) { const int h = e & 15, p = (e >> 4) & 63, dir = e >> 10;
        const int gi = (l * 2 + dir) * 16 + g; const float dt = expf(gp(a.in[I_LOGDT])[gi]); const float lr = gp(a.in[I_LRE])[gi * 64 + p], li = gp(a.in[I_LIM])[gi * 64 + p];
        const float mag = expf(lr * dt); const float ar = mag * cosf(li * dt), ai = mag * sinf(li * dt); const float den = lr * lr + li * li;
        const float fr = ((ar - 1.f) * lr + ai * li) / den, fi = (ai * lr - (ar - 1.f) * li) / den;
        const float br = gp(a.in[I_BRE])[((size_t)gi * 64 + p) * 16 + h], bi = gp(a.in[I_BIM])[((size_t)gi * 64 + p) * 16 + h];
        Bb[e] = (f32x2){fr * br - fi * bi, fr * bi + fi * br}; }
    for (int e = tid; e < 2 * 16 * 64; e += 512) { const int p = e & 63, h = (e >> 6) & 15, dir = e >> 10;
        const int gi = (l * 2 + dir) * 16 + g; Cc[e] = (f32x2){gp(a.in[I_CRE])[((size_t)gi * 16 + h) * 64 + p], gp(a.in[I_CIM])[((size_t)gi * 16 + h) * 64 + p]}; }
    __syncthreads();
    bf16_t* TM = (bf16_t*)(lptr(a.ws) + WS_TM) + ((size_t)(l * 16 + g) * 256 + j * 16) * 512;
    for (int e = tid; e < 16 * 512; e += 512) { const int k = e & 511, ho = e >> 9; float v = 0.f;
        if (k < 256) { const int i = k >> 4, hi = k & 15;
            if (i <= j) { const int dd = j - i; float s = 0.f;
                for (int p = 0; p < 64; ++p) { const f32x2 c = Cc[(0 * 16 + ho) * 64 + p], ap = Ap[(0 * 17 + dd) * 64 + p], bb = Bb[(0 * 64 + p) * 16 + hi];
                    const float wr_ = c.x * ap.x - c.y * ap.y, wi_ = c.x * ap.y + c.y * ap.x; s += wr_ * bb.x - wi_ * bb.y; }
                v += s; }
            if (i >= j) { const int dd = i - j; float s = 0.f;
                for (int p = 0; p < 64; ++p) { const f32x2 c = Cc[(1 * 16 + ho) * 64 + p], ap = Ap[(1 * 17 + dd) * 64 + p], bb = Bb[(1 * 64 + p) * 16 + hi];
                    const float wr_ = c.x * ap.x - c.y * ap.y, wi_ = c.x * ap.y + c.y * ap.x; s += wr_ * bb.x - wi_ * bb.y; }
                v += s; }
            if (i == j && hi == ho) v += gp(a.in[I_S5D])[l * 256 + g * 16 + ho];
        } else { const int dir = (k >= 384), p = ((k - 256) & 127) >> 1, ri = k & 1; const int dd = dir ? 16 - j : j + 1;
            const f32x2 c = Cc[(dir * 16 + ho) * 64 + p], ap = Ap[(dir * 17 + dd) * 64 + p];
            v = ri ? -(c.x * ap.y + c.y * ap.x) : (c.x * ap.x - c.y * ap.y); }
        TM[(size_t)ho * 512 + k] = (bf16_t)f2bf(v); }
    bf16_t* SM = (bf16_t*)(lptr(a.ws) + WS_SM) + ((size_t)(l * 16 + g) * 256 + j * 16) * 256;
    for (int e = tid; e < 16 * 256; e += 512) { const int k = e & 255, nn = e >> 8, n = j * 16 + nn; const int dir = n >> 7, p = (n & 127) >> 1, ri = n & 1, i = k >> 4, hi = k & 15;
        const int dd = dir ? i : 15 - i; const f32x2 ap = Ap[(dir * 17 + dd) * 64 + p], bb = Bb[(dir * 64 + p) * 16 + hi];
        const float v = ri ? (ap.x * bb.y + ap.y * bb.x) : (ap.x * bb.x - ap.y * bb.y);
        SM[(size_t)nn * 256 + k] = (bf16_t)f2bf(v); }
    if (j == 0 && tid < 128) { const int dir = tid >> 6, p = tid & 63; ((f32x2*)(lptr(a.ws) + WS_MISC))[((l * 2 + dir) * 16 + g) * 64 + p] = Ap[(dir * 17 + 16) * 64 + p]; }
    __syncthreads();
}

__device__ __forceinline__ void prologue(const Args& a, LAS unsigned char* lds, int G) {
    const int tid = ltid(), lane = tid & 63, wave = tid >> 6;
    const int gw = lbid() * 8 + wave, NGW = G * 8;
    LAS float* scr = (LAS float*)(lds + wave * 8448);
    for (int l = 0; l < 2; ++l) {
        unsigned char* wb = lptr(a.ws) + WS_W + l * LWB;
        tr_matrix(gp(a.in[I_WIN]) + (size_t)l * D_ * NP, D_, NP, NPP / 32, (bf16_t*)(wb + OW_IN), scr, gw, NGW, lane, l == 1 ? gp(a.in[I_LNMLP_G]) : nullptr);
        tr_matrix(gp(a.in[I_WOUT]) + (size_t)l * D_ * D_, D_, D_, 32, (bf16_t*)(wb + OW_OUT), scr, gw, NGW, lane);
        tr_matrix(gp(a.in[I_WQ]) + (size_t)l * D_ * D_, D_, D_, 32, (bf16_t*)(wb + OW_Q), scr, gw, NGW, lane, gp(a.in[I_LNMIX_G]) + l * D_);
        tr_matrix(gp(a.in[I_WK]) + (size_t)l * D_ * D_, D_, D_, 32, (bf16_t*)(wb + OW_K), scr, gw, NGW, lane);
        tr_matrix(gp(a.in[I_WV]) + (size_t)l * D_ * D_, D_, D_, 32, (bf16_t*)(wb + OW_V), scr, gw, NGW, lane);
        tr_matrix(gp(a.in[I_WO]) + (size_t)l * D_ * D_, D_, D_, 32, (bf16_t*)(wb + OW_O), scr, gw, NGW, lane);
        tr_matrix(gp(a.in[I_W1]) + (size_t)l * D_ * FF_, D_, FF_, 128, (bf16_t*)(wb + OW_1), scr, gw, NGW, lane, gp(a.in[I_LNXA_G]) + l * D_);
        tr_matrix(gp(a.in[I_W2]) + (size_t)l * FF_ * D_, FF_, D_, 32, (bf16_t*)(wb + OW_2), scr, gw, NGW, lane);
        tr_matrix(gp(a.in[I_GLUW]) + (size_t)l * 256 * 256, 256, 256, 8, (bf16_t*)(wb + OW_GLU), scr, gw, NGW, lane);
    }
    { const int gt = lbid() * 512 + tid, NT = G * 512; const f32x4* src = (const f32x4*)gp(a.in[I_MEM]); u32x2* dst = (u32x2*)(lptr(a.ws) + WS_MEMB);
      for (int i = gt; i < B_ * MEMT * D_ / 4; i += NT) { const f32x4 v = src[i]; u32x2 w; w.x = pk2(v.x, v.y); w.y = pk2(v.z, v.w); dst[i] = w; } }
    __syncthreads();
    for (int it = lbid(); it < 512; it += G) s5_item(a, lds, it, tid);
    { const float* X = gp(a.in[I_X]); float* H = lptr(a.out); bf16_t* HBp = (bf16_t*)(lptr(a.ws) + WS_HB);
      for (int m = gw; m < M_ / 2; m += NGW) { const size_t r0 = (size_t)m * D_, r1 = (size_t)(m + M_ / 2) * D_;
          ln_row2(X + r0, X + r1, H + r0, H + r1, HBp + r0, HBp + r1, gp(a.in[I_LNIN_G]), gp(a.in[I_LNIN_B]), lane); } }
}


__device__ __forceinline__ float* cs_ptr(unsigned char* ws, int l, int set) {
    float* base = (float*)(ws + WS_MISC + MISC_CS) + (size_t)l * 16384;
    return base + (set == 0 ? 0 : set == 1 ? 2048 : 10240);
}
__device__ __forceinline__ void colsum_set(const bf16_t* WT, int N, const float* gam, const float* bet, float* CS, int gw, int NGW, int lane) {
    for (int n = gw; n < N; n += NGW) { const bf16_t* r = WT + (size_t)n * D_; float s = 0.f, c = 0.f;
#pragma unroll
        for (int j = 0; j < 2; ++j) { const int k = (lane + 64 * j) * 8; const u32x4 v = *(const u32x4*)(r + k);
            const f32x4 g0 = *(const f32x4*)(gam + k), g1 = *(const f32x4*)(gam + k + 4), b0 = *(const f32x4*)(bet + k), b1 = *(const f32x4*)(bet + k + 4);
            const float w[8] = {bflo(v.x), bfhi(v.x), bflo(v.y), bfhi(v.y), bflo(v.z), bfhi(v.z), bflo(v.w), bfhi(v.w)};
            s += ((w[0] + w[1]) + (w[2] + w[3])) + ((w[4] + w[5]) + (w[6] + w[7]));
            c += w[0] * (b0[0] / g0[0]) + w[1] * (b0[1] / g0[1]) + w[2] * (b0[2] / g0[2]) + w[3] * (b0[3] / g0[3]) + w[4] * (b1[0] / g1[0]) + w[5] * (b1[1] / g1[1]) + w[6] * (b1[2] / g1[2]) + w[7] * (b1[3] / g1[3]); }
        s = wave_sum(s); c = wave_sum(c);
        if (lane == 0) { CS[n] = s; CS[N + n] = c; } }
}
__device__ __forceinline__ void colsum_phase(const Args& a, int G) {
    const int tid = ltid(), lane = tid & 63, gw = lbid() * 8 + (tid >> 6), NGW = G * 8;
    unsigned char* ws = lptr(a.ws);
    for (int l = 0; l < 2; ++l) { unsigned char* wb = ws + WS_W + (size_t)l * LWB;
        colsum_set((const bf16_t*)(wb + OW_Q), D_, gp(a.in[I_LNMIX_G]) + l * D_, gp(a.in[I_LNMIX_B]) + l * D_, cs_ptr(ws, l, 0), gw, NGW, lane);
        colsum_set((const bf16_t*)(wb + OW_1), FF_, gp(a.in[I_LNXA_G]) + l * D_, gp(a.in[I_LNXA_B]) + l * D_, cs_ptr(ws, l, 1), gw, NGW, lane);
        if (l == 1) colsum_set((const bf16_t*)(wb + OW_IN), NPP, gp(a.in[I_LNMLP_G]), gp(a.in[I_LNMLP_B]), cs_ptr(ws, l, 2), gw, NGW, lane); }
}
__device__ __forceinline__ void na_phase(const bf16_t* PROJ, bf16_t* MIXED, const float* rpb, int G) {
    const int tid = ltid();
    for (int it = lbid(); it < 512; it += G) {
        const int h = it & 3, rg = (it >> 2) & 15, b = it >> 6;
        const int r = rg * 8 + (tid >> 6), c = tid & 63;
        const size_t row = (size_t)b * T_ + r * 64 + c;
        float q[64], o[64];
        { const u32x4* qp = (const u32x4*)(PROJ + row * NP + PQ + h * 64);
#pragma unroll
          for (int i = 0; i < 8; ++i) { const u32x4 v = qp[i]; q[8 * i + 0] = bflo(v.x) * 0.125f; q[8 * i + 1] = bfhi(v.x) * 0.125f; q[8 * i + 2] = bflo(v.y) * 0.125f; q[8 * i + 3] = bfhi(v.y) * 0.125f;
              q[8 * i + 4] = bflo(v.z) * 0.125f; q[8 * i + 5] = bfhi(v.z) * 0.125f; q[8 * i + 6] = bflo(v.w) * 0.125f; q[8 * i + 7] = bfhi(v.w) * 0.125f; } }
#pragma unroll
        for (int d = 0; d < 64; ++d) o[d] = 0.f;
        const int r0 = min(max(r - 4, 0), 120), c0 = min(max(c - 8, 0), 48);
        float mx = -1e30f, lsum = 0.f;
        const float* rp = rpb + h * 15 * 31;
#pragma unroll 1
        for (int kk = 0; kk < 128; ++kk) {
            const int kr = kk >> 4, kc = kk & 15;
            const int krow = r0 + kr;
            const bf16_t* kptr = PROJ + ((size_t)b * T_ + krow * 64 + c0 + kc) * NP + PK + h * 64;
            const u32x4* kp = (const u32x4*)kptr; float acc = 0.f;
#pragma unroll
            for (int i = 0; i < 8; ++i) { const u32x4 v = kp[i];
                acc += q[8 * i + 0] * bflo(v.x) + q[8 * i + 1] * bfhi(v.x) + q[8 * i + 2] * bflo(v.y) + q[8 * i + 3] * bfhi(v.y)
                     + q[8 * i + 4] * bflo(v.z) + q[8 * i + 5] * bfhi(v.z) + q[8 * i + 6] * bflo(v.w) + q[8 * i + 7] * bfhi(v.w); }
            int dc = c0 + kc - c; dc = min(max(dc, -15), 15);
            const float sc = acc + rp[(krow - r + 7) * 31 + dc + 15];
            if (sc > mx) { const float al = __expf(mx - sc); mx = sc; lsum *= al;
#pragma unroll
                for (int d = 0; d < 64; ++d) o[d] *= al; }
            const float p = __expf(sc - mx); lsum += p; const u32x4* vp = (const u32x4*)(kptr + (PV - PK));
#pragma unroll
            for (int i = 0; i < 8; ++i) { const u32x4 v = vp[i];
                o[8 * i + 0] += p * bflo(v.x); o[8 * i + 1] += p * bfhi(v.x); o[8 * i + 2] += p * bflo(v.y); o[8 * i + 3] += p * bfhi(v.y);
                o[8 * i + 4] += p * bflo(v.z); o[8 * i + 5] += p * bfhi(v.z); o[8 * i + 6] += p * bflo(v.w); o[8 * i + 7] += p * bfhi(v.w); }
        }
        const float inv = 1.f / lsum; u32x4* op = (u32x4*)(MIXED + row * D_ + h * 64);
#pragma unroll
        for (int i = 0; i < 8; ++i) { u32x4 w; w.x = pk2(o[8 * i] * inv, o[8 * i + 1] * inv); w.y = pk2(o[8 * i + 2] * inv, o[8 * i + 3] * inv); w.z = pk2(o[8 * i + 4] * inv, o[8 * i + 5] * inv); w.w = pk2(o[8 * i + 6] * inv, o[8 * i + 7] * inv); op[i] = w; }
    }
}

__device__ __forceinline__ void conv_phase(const bf16_t* PROJ, bf16_t* CONV, const float* cw, const float* cb, int G) {
    const int gt = lbid() * 512 + ltid(), NT = G * 512;
    for (int idx = gt; idx < (M_ / 8) * 96; idx += NT) { const int rb = idx / 96, ch = (idx - rb * 96) * 8, row0 = rb * 8, t0 = row0 & (T_ - 1);
        u32x4 x[12];
#pragma unroll
        for (int i = 0; i < 12; ++i) { const int tt = t0 + i - 2; x[i] = (tt >= 0 && tt < T_) ? *(const u32x4*)(PROJ + (size_t)(row0 + i - 2) * NP + PX + ch) : (u32x4){0u, 0u, 0u, 0u}; }
        float w[5][8], bias[8];
#pragma unroll
        for (int jj = 0; jj < 5; ++jj) { const f32x4 w0 = *(const f32x4*)(cw + jj * 768 + ch), w1 = *(const f32x4*)(cw + jj * 768 + ch + 4);
            w[jj][0] = w0[0]; w[jj][1] = w0[1]; w[jj][2] = w0[2]; w[jj][3] = w0[3]; w[jj][4] = w1[0]; w[jj][5] = w1[1]; w[jj][6] = w1[2]; w[jj][7] = w1[3]; }
        { const f32x4 b0 = *(const f32x4*)(cb + ch), b1 = *(const f32x4*)(cb + ch + 4); bias[0] = b0[0]; bias[1] = b0[1]; bias[2] = b0[2]; bias[3] = b0[3]; bias[4] = b1[0]; bias[5] = b1[1]; bias[6] = b1[2]; bias[7] = b1[3]; }
#pragma unroll
        for (int o = 0; o < 8; ++o) { float acc[8];
#pragma unroll
            for (int e = 0; e < 8; ++e) acc[e] = bias[e];
#pragma unroll
            for (int jj = 0; jj < 5; ++jj) { const u32x4 v = x[o + jj];
                acc[0] += w[jj][0] * bflo(v.x); acc[1] += w[jj][1] * bfhi(v.x); acc[2] += w[jj][2] * bflo(v.y); acc[3] += w[jj][3] * bfhi(v.y);
                acc[4] += w[jj][4] * bflo(v.z); acc[5] += w[jj][5] * bfhi(v.z); acc[6] += w[jj][6] * bflo(v.w); acc[7] += w[jj][7] * bfhi(v.w); }
            u32x4 r; r.x = pk2(silu_f(acc[0]), silu_f(acc[1])); r.y = pk2(silu_f(acc[2]), silu_f(acc[3])); r.z = pk2(silu_f(acc[4]), silu_f(acc[5])); r.w = pk2(silu_f(acc[6]), silu_f(acc[7]));
            *(u32x4*)(CONV + (size_t)(row0 + o) * 768 + ch) = r; } }
}
__device__ __forceinline__ void s5_gather_phase(const bf16_t* PROJ, bf16_t* UX, int G) {
    const int gt = lbid() * 512 + ltid(), NT = G * 512;
    for (int idx = gt; idx < M_ * 32; idx += NT) { const int row = idx >> 5, part = idx & 31, g = part >> 1, hf = part & 1, b = row >> 13, t = row & (T_ - 1), c = t >> 4, i = t & 15;
        const u32x4 v = *(const u32x4*)(PROJ + (size_t)row * NP + PU + g * 16 + hf * 8);
        *(u32x4*)(UX + ((size_t)g * 4096 + b * 512 + c) * 512 + i * 16 + hf * 8) = v; }
}

__device__ __forceinline__ float softplus_f(float x) { return x > 20.f ? x : log1pf(expf(x)); }

__device__ __forceinline__ void ssd_passA(const Args& a, int l, LAS unsigned char* lds, int G) {
    const bf16_t* PROJ = (const bf16_t*)(lptr(a.ws) + WS_PROJ); const bf16_t* CONV = (const bf16_t*)(lptr(a.ws) + WS_CONV);
    float* ST = (float*)(lptr(a.ws) + WS_ST); float* CD = (float*)(lptr(a.ws) + WS_MISC + 65536);
    const int tid = ltid(), sub = tid & 255, dir = tid >> 8, p = sub >> 2, nq = sub & 3;
    LAS float* dts = (LAS float*)lds; LAS float* dAs = dts + 256;
    for (int it = lbid(); it < 4096; it += G) {
        const int hd = it & 7, c = (it >> 3) & 63, b = it >> 9, g = hd >> 2;
        if (sub < 128) { const int s = sub; const size_t row = (size_t)b * T_ + c * 128 + s;
            const float raw = bf2f(PROJ[row * NP + PDT + dir * 8 + hd]); const float dt = softplus_f(raw + gp(a.in[I_DTB])[(l * 2 + dir) * 8 + hd]);
            const float av = -expf(gp(a.in[I_ALOG])[(l * 2 + dir) * 8 + hd]); dts[dir * 128 + s] = dt; dAs[dir * 128 + s] = expf(dt * av); }
        __syncthreads();
        float h[16];
#pragma unroll
        for (int j = 0; j < 16; ++j) h[j] = 0.f;
        float cdp = 1.f;
        for (int ss = 0; ss < 128; ++ss) { const int s = dir ? 127 - ss : ss; const size_t row = (size_t)b * T_ + c * 128 + s;
            const float dA = dAs[dir * 128 + s], dtv = dts[dir * 128 + s];
            const float xv = bf2f(CONV[row * 768 + hd * 64 + p]) * dtv;
            const u32x4* bp = (const u32x4*)(CONV + row * 768 + 512 + g * 64 + nq * 16); const u32x4 b0 = bp[0], b1 = bp[1];
            const unsigned bw[8] = {b0.x, b0.y, b0.z, b0.w, b1.x, b1.y, b1.z, b1.w};
#pragma unroll
            for (int j = 0; j < 8; ++j) { h[2 * j] = h[2 * j] * dA + xv * bflo(bw[j]); h[2 * j + 1] = h[2 * j + 1] * dA + xv * bfhi(bw[j]); }
            cdp *= dA; }
        float* sp = ST + ((((size_t)(b * 64 + c) * 8 + hd) * 2 + dir) * 64 + p) * 64 + nq * 16;
#pragma unroll
        for (int j = 0; j < 4; ++j) ((f32x4*)sp)[j] = (f32x4){h[4 * j], h[4 * j + 1], h[4 * j + 2], h[4 * j + 3]};
        if (sub == 0) CD[((b * 64 + c) * 8 + hd) * 2 + dir] = cdp;
        __syncthreads();
    }
}
__device__ __forceinline__ void ssd_scan(const Args& a, int G) {
    float* ST = (float*)(lptr(a.ws) + WS_ST); const float* CD = (const float*)(lptr(a.ws) + WS_MISC + 65536);
    const int gt = lbid() * 512 + ltid(), NT = G * 512;
    for (int e = gt; e < 8 * 8 * 2 * 4096; e += NT) { const int pn = e & 4095, dir = (e >> 12) & 1, hd = (e >> 13) & 7, b = e >> 16;
        float H = 0.f;
#pragma unroll 8
        for (int cc = 0; cc < 64; ++cc) { const int c = dir ? 63 - cc : cc; const size_t idx = (((size_t)(b * 64 + c) * 8 + hd) * 2 + dir);
            const float tmp = ST[idx * 4096 + pn]; ST[idx * 4096 + pn] = H; H = H * CD[idx] + tmp; } }
}
__device__ __forceinline__ void ssd_passC(const Args& a, int l, LAS unsigned char* lds, int G) {
    const bf16_t* PROJ = (const bf16_t*)(lptr(a.ws) + WS_PROJ); const bf16_t* CONV = (const bf16_t*)(lptr(a.ws) + WS_CONV); bf16_t* MIXED = (bf16_t*)(lptr(a.ws) + WS_MIXED);
    const float* ST = (const float*)(lptr(a.ws) + WS_ST);
    const int tid = ltid(), sub = tid & 255, half = tid >> 8, p = sub >> 2, nq = sub & 3;
    LAS float* dts = (LAS float*)lds + half * 512; LAS float* dAs = dts + 256;
    LAS float* yl = (LAS float*)(lds + 8192) + half * 8192;
    for (int it = lbid(); it < 2048; it += G) {
        const int hp = it & 3, c = (it >> 2) & 63, b = it >> 8, hd = hp * 2 + half, g = hd >> 2;
        { const int dir = sub >> 7, s = sub & 127; const size_t row = (size_t)b * T_ + c * 128 + s;
          const float raw = bf2f(PROJ[row * NP + PDT + dir * 8 + hd]); const float dt = softplus_f(raw + gp(a.in[I_DTB])[(l * 2 + dir) * 8 + hd]);
          const float av = -expf(gp(a.in[I_ALOG])[(l * 2 + dir) * 8 + hd]); dts[dir * 128 + s] = dt; dAs[dir * 128 + s] = expf(dt * av); }
        __syncthreads();
#pragma unroll 1
        for (int dir = 0; dir < 2; ++dir) {
            float h[16];
            const float* sp = ST + ((((size_t)(b * 64 + c) * 8 + hd) * 2 + dir) * 64 + p) * 64 + nq * 16;
#pragma unroll
            for (int j = 0; j < 4; ++j) { const f32x4 v = ((const f32x4*)sp)[j]; h[4 * j] = v.x; h[4 * j + 1] = v.y; h[4 * j + 2] = v.z; h[4 * j + 3] = v.w; }
#pragma unroll 2
            for (int ss = 0; ss < 128; ++ss) { const int s = dir ? 127 - ss : ss; const size_t row = (size_t)b * T_ + c * 128 + s;
                const float dA = dAs[dir * 128 + s], dtv = dts[dir * 128 + s];
                const float xv = bf2f(CONV[row * 768 + hd * 64 + p]) * dtv;
                const u32x4* bp = (const u32x4*)(CONV + row * 768 + 512 + g * 64 + nq * 16); const u32x4 b0 = bp[0], b1 = bp[1];
                const u32x4* cp = (const u32x4*)(CONV + row * 768 + 640 + g * 64 + nq * 16); const u32x4 c0 = cp[0], c1 = cp[1];
                const unsigned bw[8] = {b0.x, b0.y, b0.z, b0.w, b1.x, b1.y, b1.z, b1.w}; const unsigned cw[8] = {c0.x, c0.y, c0.z, c0.w, c1.x, c1.y, c1.z, c1.w};
                float y = 0.f;
#pragma unroll
                for (int j = 0; j < 8; ++j) { h[2 * j] = h[2 * j] * dA + xv * bflo(bw[j]); h[2 * j + 1] = h[2 * j + 1] * dA + xv * bfhi(bw[j]);
                    y += h[2 * j] * bflo(cw[j]) + h[2 * j + 1] * bfhi(cw[j]); }
                y += __shfl_xor(y, 1); y += __shfl_xor(y, 2);
                if (nq == 0) { if (dir == 0) yl[s * 64 + p] = y; else yl[s * 64 + p] += y; } }
        }
        __syncthreads();
        const float dsk = gp(a.in[I_SSDD])[l * 8 + hd];
        for (int e = sub; e < 128 * 64; e += 256) { const int s = e >> 6, pp = e & 63; const size_t row = (size_t)b * T_ + c * 128 + s;
            const float xs = bf2f(CONV[row * 768 + hd * 64 + pp]), z = bf2f(PROJ[row * NP + PZ + hd * 64 + pp]);
            const float yv = (yl[e] + dsk * xs) * silu_f(z);
            MIXED[row * D_ + 256 + hd * 64 + pp] = (bf16_t)f2bf(yv); }
        __syncthreads();
    }
}
__device__ __forceinline__ void ssd_norm(const Args& a, int l, int G) {
    bf16_t* MIXED = (bf16_t*)(lptr(a.ws) + WS_MIXED); const float* nw = gp(a.in[I_SSDNW]) + l * 512;
    const int tid = ltid(), lane = tid & 63, gw = lbid() * 8 + (tid >> 6), NGW = G * 8;
    for (int m = gw; m < M_; m += NGW) { u32x4* p = (u32x4*)(MIXED + (size_t)m * D_ + 256) + lane; const u32x4 v = *p;
        float x[8] = {bflo(v.x), bfhi(v.x), bflo(v.y), bfhi(v.y), bflo(v.z), bfhi(v.z), bflo(v.w), bfhi(v.w)}; float s = 0.f;
#pragma unroll
        for (int e = 0; e < 8; ++e) s += x[e] * x[e];
        const float r = rsqrtf(wave_sum(s) * (1.f / 512.f) + LN_EPS); const f32x4 w0 = ((const f32x4*)nw)[2 * lane], w1 = ((const f32x4*)nw)[2 * lane + 1];
        u32x4 o; o.x = pk2(x[0] * r * w0.x, x[1] * r * w0.y); o.y = pk2(x[2] * r * w0.z, x[3] * r * w0.w); o.z = pk2(x[4] * r * w1.x, x[5] * r * w1.y); o.w = pk2(x[6] * r * w1.z, x[7] * r * w1.w);
        *p = o; }
}
__device__ __forceinline__ void s5_scan(const Args& a, int l, int G) {
    const int tid = ltid(); if (tid >= 64) return;
    const int p = tid; const float* S5S = (const float*)(lptr(a.ws) + WS_S5S); bf16_t* UX = (bf16_t*)(lptr(a.ws) + WS_UX);
    for (int it = lbid(); it < 256; it += G) { const int g = it & 15, b = (it >> 4) & 7, dir = it >> 7;
        const f32x2 A16 = ((const f32x2*)(lptr(a.ws) + WS_MISC))[((l * 2 + dir) * 16 + g) * 64 + p];
        float xr = 0.f, xi = 0.f;
#pragma unroll 1
        for (int cb = 0; cb < 512; cb += 16) { f32x2 s[16];
#pragma unroll
            for (int k = 0; k < 16; ++k) { const int cc = cb + k, c = dir ? 511 - cc : cc; const size_t row = (size_t)g * 4096 + b * 512 + c; s[k] = *(const f32x2*)(S5S + row * 256 + dir * 128 + 2 * p); }
#pragma unroll
            for (int k = 0; k < 16; ++k) { const int cc = cb + k, c = dir ? 511 - cc : cc; const size_t row = (size_t)g * 4096 + b * 512 + c;
                *(unsigned*)(UX + row * 512 + 256 + dir * 128 + 2 * p) = pk2(xr, xi);
                const float nr = A16.x * xr - A16.y * xi + s[k].x, ni = A16.x * xi + A16.y * xr + s[k].y; xr = nr; xi = ni; } } }
}

#define MFMA16(A, B, C) __builtin_amdgcn_mfma_f32_16x16x32_bf16(A, B, C, 0, 0, 0)
constexpr int SSD_WAVE_LDS = 19456, SSD_XS = 66, SSD_MS = 72;
__device__ __forceinline__ bf16x8 ld_frag_strided(const LAS bf16_t* T, int LS, int s0, int x) {
    bf16x8 f;
#pragma unroll
    for (int j = 0; j < 8; ++j) f[j] = (short)T[(s0 + j) * LS + x];
    return f;
}
__device__ __forceinline__ void ssd_tables(const Args& a, int l, const bf16_t* PROJ, size_t row0, int hd, int dir, int lane, float& dt, float& cum, float& tot) {
    const float raw = bf2f(PROJ[(row0 + lane) * NP + PDT + dir * 8 + hd]);
    dt = softplus_f(raw + gp(a.in[I_DTB])[(l * 2 + dir) * 8 + hd]);
    const float av = -expf(gp(a.in[I_ALOG])[(l * 2 + dir) * 8 + hd]);
    const float e = dt * av; float ps = e;
#pragma unroll
    for (int o = 1; o < 64; o <<= 1) { const float t = __shfl_up(ps, o); if (lane >= o) ps += t; }
    tot = __shfl(ps, 63);
    cum = dir ? (tot - ps + e) : ps;
}
__device__ __forceinline__ void ssd_passA2(const Args& a, int l, LAS unsigned char* lds, int G) {
    const bf16_t* PROJ = (const bf16_t*)(lptr(a.ws) + WS_PROJ); const bf16_t* CONV = (const bf16_t*)(lptr(a.ws) + WS_CONV);
    bf16_t* ST = (bf16_t*)(lptr(a.ws) + WS_ST); float* CD = (float*)(lptr(a.ws) + WS_MISC + 65536);
    const int tid = ltid(), lane = tid & 63, wave = tid >> 6, fr = lane & 15, fq = lane >> 4, hd = wave, g4 = hd >> 2;
    LAS bf16_t* Xl = (LAS bf16_t*)(lds + wave * SSD_WAVE_LDS); LAS bf16_t* Bl = Xl + 64 * SSD_XS; LAS float* tab = (LAS float*)(lds + wave * SSD_WAVE_LDS + 17664);
    for (int it = lbid(); it < 8 * 128 * 2; it += G) { const int dir = it & 1, c = (it >> 1) & 127, b = it >> 8;
        const size_t row0 = (size_t)b * T_ + c * 64;
        u32x4 xv[8], bv[8];
#pragma unroll
        for (int i = 0; i < 8; ++i) { const int q = lane + 64 * i, s = q >> 3, pc = (q & 7) * 8;
            xv[i] = *(const u32x4*)(CONV + (row0 + s) * 768 + hd * 64 + pc); bv[i] = *(const u32x4*)(CONV + (row0 + s) * 768 + 512 + g4 * 64 + pc); }
        float dt, cum, tot; ssd_tables(a, l, PROJ, row0, hd, dir, lane, dt, cum, tot);
        tab[lane] = dt * __expf(tot - cum);
        LDS_WAIT();
#pragma unroll
        for (int i = 0; i < 8; ++i) { const int q = lane + 64 * i, s = q >> 3, pc = (q & 7) * 8; const float w = tab[s];
            const u32x4 v = xv[i]; LAS unsigned* d = (LAS unsigned*)(Xl + s * SSD_XS + pc);
            d[0] = pk2(bflo(v.x) * w, bfhi(v.x) * w); d[1] = pk2(bflo(v.y) * w, bfhi(v.y) * w); d[2] = pk2(bflo(v.z) * w, bfhi(v.z) * w); d[3] = pk2(bflo(v.w) * w, bfhi(v.w) * w);
            const u32x4 vb = bv[i]; LAS unsigned* db = (LAS unsigned*)(Bl + s * SSD_XS + pc);
            db[0] = vb.x; db[1] = vb.y; db[2] = vb.z; db[3] = vb.w; }
        LDS_WAIT();
        f32x4 acc[4][4];
#pragma unroll
        for (int mi = 0; mi < 4; ++mi)
#pragma unroll
            for (int nj = 0; nj < 4; ++nj) acc[mi][nj] = (f32x4){0.f, 0.f, 0.f, 0.f};
#pragma unroll
        for (int ks = 0; ks < 2; ++ks) { bf16x8 af[4], bg[4];
#pragma unroll
            for (int mi = 0; mi < 4; ++mi) af[mi] = ld_frag_strided(Bl, SSD_XS, 32 * ks + 8 * fq, 16 * mi + fr);
#pragma unroll
            for (int nj = 0; nj < 4; ++nj) bg[nj] = ld_frag_strided(Xl, SSD_XS, 32 * ks + 8 * fq, 16 * nj + fr);
#pragma unroll
            for (int mi = 0; mi < 4; ++mi)
#pragma unroll
                for (int nj = 0; nj < 4; ++nj) acc[mi][nj] = MFMA16(af[mi], bg[nj], acc[mi][nj]); }
        const size_t idx = ((size_t)(b * 128 + c) * 8 + hd) * 2 + dir; bf16_t* sp = ST + idx * 4096;
#pragma unroll
        for (int mi = 0; mi < 4; ++mi)
#pragma unroll
            for (int nj = 0; nj < 4; ++nj) { u32x2 w; w.x = pk2(acc[mi][nj][0], acc[mi][nj][1]); w.y = pk2(acc[mi][nj][2], acc[mi][nj][3]); *(u32x2*)(sp + (16 * nj + fr) * 64 + 16 * mi + 4 * fq) = w; }
        if (lane == 0) CD[idx] = __expf(tot);
        LDS_WAIT();
    }
}
__device__ __forceinline__ void ssd_scan2(const Args& a, int G) {
    unsigned* ST32 = (unsigned*)(lptr(a.ws) + WS_ST); const float* CD = (const float*)(lptr(a.ws) + WS_MISC + 65536);
    const int gt = lbid() * 512 + ltid(), NT = G * 512;
    for (int e = gt; e < 8 * 8 * 2 * 2048; e += NT) { const int pn2 = e & 2047, dir = (e >> 11) & 1, hd = (e >> 12) & 7, b = e >> 15;
        float H0 = 0.f, H1 = 0.f;
#pragma unroll 1
        for (int cb = 0; cb < 128; cb += 16) { unsigned v[16]; float cd[16];
#pragma unroll
            for (int k = 0; k < 16; ++k) { const int cc = cb + k, c = dir ? 127 - cc : cc; const size_t idx = ((size_t)(b * 128 + c) * 8 + hd) * 2 + dir; v[k] = ST32[idx * 2048 + pn2]; cd[k] = CD[idx]; }
#pragma unroll
            for (int k = 0; k < 16; ++k) { const int cc = cb + k, c = dir ? 127 - cc : cc; const size_t idx = ((size_t)(b * 128 + c) * 8 + hd) * 2 + dir;
                ST32[idx * 2048 + pn2] = pk2(H0, H1); H0 = H0 * cd[k] + bflo(v[k]); H1 = H1 * cd[k] + bfhi(v[k]); } } }
}
__device__ __forceinline__ void ssd_passC2(const Args& a, int l, LAS unsigned char* lds, int G) {
    const bf16_t* PROJ = (const bf16_t*)(lptr(a.ws) + WS_PROJ); const bf16_t* CONV = (const bf16_t*)(lptr(a.ws) + WS_CONV); bf16_t* MIXED = (bf16_t*)(lptr(a.ws) + WS_MIXED);
    const bf16_t* ST = (const bf16_t*)(lptr(a.ws) + WS_ST);
    const int tid = ltid(), lane = tid & 63, wave = tid >> 6, hd = wave, g4 = hd >> 2;
    LAS bf16_t* Xl = (LAS bf16_t*)(lds + wave * SSD_WAVE_LDS); LAS bf16_t* Ml = (LAS bf16_t*)(lds + wave * SSD_WAVE_LDS + 8448); LAS float* tab = (LAS float*)(lds + wave * SSD_WAVE_LDS + 17664);
    LAS float* ssq = (LAS float*)(lds + 8 * SSD_WAVE_LDS);
    const float dsk = gp(a.in[I_SSDD])[l * 8 + hd];
    for (int it = lbid(); it < 8 * 128; it += G) { const int c = it & 127, b = it >> 7;
        const size_t row0 = (size_t)b * T_ + c * 64;
        f32x4 Y[4][4];
#pragma unroll
        for (int mi = 0; mi < 4; ++mi)
#pragma unroll
            for (int nj = 0; nj < 4; ++nj) Y[mi][nj] = (f32x4){0.f, 0.f, 0.f, 0.f};
        bf16x8 cfr[4][2];
        { int ln_ = lane; asm volatile("" : "+v"(ln_)); const int fr = ln_ & 15, fq = ln_ >> 4;
          u32x4 xv[8]; bf16x8 h0[4][2], h1[4][2];
#pragma unroll
          for (int i = 0; i < 8; ++i) { const int q = ln_ + 64 * i, s = q >> 3, pc = (q & 7) * 8; xv[i] = *(const u32x4*)(CONV + (row0 + s) * 768 + hd * 64 + pc); }
          const bf16_t* hp = ST + (((size_t)(b * 128 + c) * 8 + hd) * 2) * 4096;
#pragma unroll
          for (int t4 = 0; t4 < 4; ++t4) { const bf16_t* cp = CONV + (row0 + 16 * t4 + fr) * 768 + 640 + g4 * 64 + 8 * fq; cfr[t4][0] = *(const bf16x8*)cp; cfr[t4][1] = *(const bf16x8*)(cp + 32);
              const bf16_t* ap = hp + (16 * t4 + fr) * 64 + 8 * fq; h0[t4][0] = *(const bf16x8*)ap; h0[t4][1] = *(const bf16x8*)(ap + 32); h1[t4][0] = *(const bf16x8*)(ap + 4096); h1[t4][1] = *(const bf16x8*)(ap + 4096 + 32); }
          { float dt, cum, tot; ssd_tables(a, l, PROJ, row0, hd, 0, lane, dt, cum, tot); tab[lane] = dt; tab[64 + lane] = cum;
            ssd_tables(a, l, PROJ, row0, hd, 1, lane, dt, cum, tot); tab[128 + lane] = dt; tab[192 + lane] = cum; }
#pragma unroll
          for (int i = 0; i < 8; ++i) { const int q = ln_ + 64 * i, s = q >> 3, pc = (q & 7) * 8; LAS unsigned* d = (LAS unsigned*)(Xl + s * SSD_XS + pc);
              d[0] = xv[i].x; d[1] = xv[i].y; d[2] = xv[i].z; d[3] = xv[i].w; }
          LDS_WAIT();
#pragma unroll
          for (int nj = 0; nj < 4; ++nj) { const float sc0 = __expf(tab[64 + 16 * nj + fr]), sc1 = __expf(tab[192 + 16 * nj + fr]);
#pragma unroll
              for (int mi = 0; mi < 4; ++mi) { f32x4 t = MFMA16(h0[mi][0], cfr[nj][0], ((f32x4){0.f, 0.f, 0.f, 0.f})); t = MFMA16(h0[mi][1], cfr[nj][1], t);
                  f32x4 u = MFMA16(h1[mi][0], cfr[nj][0], ((f32x4){0.f, 0.f, 0.f, 0.f})); u = MFMA16(h1[mi][1], cfr[nj][1], u);
                  Y[mi][nj] += t * sc0 + u * sc1; } } }
        f32x4 Gt[4][4];
#pragma unroll
        for (int mi = 0; mi < 4; ++mi)
#pragma unroll
            for (int nj = 0; nj < 4; ++nj) Gt[mi][nj] = (f32x4){0.f, 0.f, 0.f, 0.f};
        { int ln_ = lane; asm volatile("" : "+v"(ln_)); const int fr = ln_ & 15, fq = ln_ >> 4;
          bf16x8 bfr[4][2];
#pragma unroll
          for (int mi = 0; mi < 4; ++mi) { const bf16_t* bp = CONV + (row0 + 16 * mi + fr) * 768 + 512 + g4 * 64 + 8 * fq; bfr[mi][0] = *(const bf16x8*)bp; bfr[mi][1] = *(const bf16x8*)(bp + 32); }
#pragma unroll
          for (int ks = 0; ks < 2; ++ks)
#pragma unroll
            for (int mi = 0; mi < 4; ++mi)
#pragma unroll
                for (int nj = 0; nj < 4; ++nj) Gt[mi][nj] = MFMA16(bfr[mi][ks], cfr[nj][ks], Gt[mi][nj]); }
        u32x2 ez[4][4];
#pragma unroll
        for (int dir = 0; dir < 2; ++dir) { int ln_ = lane; asm volatile("" : "+v"(ln_)); const int fr = ln_ & 15, fq = ln_ >> 4;
            if (dir == 1) {
#pragma unroll
                for (int nj = 0; nj < 4; ++nj) { const size_t row = row0 + 16 * nj + fr;
#pragma unroll
                    for (int mi = 0; mi < 4; ++mi) { const int p0 = 16 * mi + 4 * fq; ez[mi][nj] = *(const u32x2*)(PROJ + row * NP + PZ + hd * 64 + p0); } } }
#pragma unroll
            for (int nj = 0; nj < 4; ++nj) { const int lq = 16 * nj + fr; const float cl = tab[dir * 128 + 64 + lq];
#pragma unroll
                for (int mi = 0; mi < 4; ++mi) { const f32x4 cs = *(const LAS f32x4*)(tab + dir * 128 + 64 + 16 * mi + 4 * fq), ds = *(const LAS f32x4*)(tab + dir * 128 + 16 * mi + 4 * fq);
                    float v[4];
#pragma unroll
                    for (int r = 0; r < 4; ++r) { const int s = 16 * mi + 4 * fq + r; const bool valid = dir ? (s >= lq) : (s <= lq);
                        v[r] = valid ? Gt[mi][nj][r] * __expf(cl - cs[r]) * ds[r] : 0.f; }
                    u32x2 w; w.x = pk2(v[0], v[1]); w.y = pk2(v[2], v[3]); *(LAS u32x2*)(Ml + lq * SSD_MS + 16 * mi + 4 * fq) = w; } }
            asm volatile("s_waitcnt lgkmcnt(0)" ::: );
#pragma unroll
            for (int ks = 0; ks < 2; ++ks) { bf16x8 af[4], bg[4];
#pragma unroll
                for (int mi = 0; mi < 4; ++mi) af[mi] = ld_frag_strided(Xl, SSD_XS, 32 * ks + 8 * fq, 16 * mi + fr);
#pragma unroll
                for (int nj = 0; nj < 4; ++nj) bg[nj] = *(const LAS bf16x8*)(Ml + (16 * nj + fr) * SSD_MS + 32 * ks + 8 * fq);
#pragma unroll
                for (int mi = 0; mi < 4; ++mi)
#pragma unroll
                    for (int nj = 0; nj < 4; ++nj) Y[mi][nj] = MFMA16(af[mi], bg[nj], Y[mi][nj]); }
            asm volatile("s_waitcnt lgkmcnt(0)" ::: );
        }
        float part[4];
        { int ln_ = lane; asm volatile("" : "+v"(ln_)); const int fr = ln_ & 15, fq = ln_ >> 4;
#pragma unroll
        for (int nj = 0; nj < 4; ++nj) { float ps = 0.f;
#pragma unroll
            for (int mi = 0; mi < 4; ++mi) { const LAS unsigned* xp = (const LAS unsigned*)(Xl + (16 * nj + fr) * SSD_XS + 16 * mi + 4 * fq); u32x2 xs; xs.x = xp[0]; xs.y = xp[1]; const u32x2 zz = ez[mi][nj];
                f32x4 y = Y[mi][nj];
                y[0] = (y[0] + dsk * bflo(xs.x)) * silu_f(bflo(zz.x)); y[1] = (y[1] + dsk * bfhi(xs.x)) * silu_f(bfhi(zz.x));
                y[2] = (y[2] + dsk * bflo(xs.y)) * silu_f(bflo(zz.y)); y[3] = (y[3] + dsk * bfhi(xs.y)) * silu_f(bfhi(zz.y));
                Y[mi][nj] = y; ps += (y[0] * y[0] + y[1] * y[1]) + (y[2] * y[2] + y[3] * y[3]); }
            ps += __shfl_xor(ps, 16); ps += __shfl_xor(ps, 32); part[nj] = ps; }
        if (fq == 0) {
#pragma unroll
            for (int nj = 0; nj < 4; ++nj) ssq[wave * 64 + 16 * nj + fr] = part[nj]; } }
        __syncthreads();
        const float* nw = gp(a.in[I_SSDNW]) + l * 512 + hd * 64;
        { int ln_ = lane; asm volatile("" : "+v"(ln_)); const int fr = ln_ & 15, fq = ln_ >> 4;
#pragma unroll
        for (int nj = 0; nj < 4; ++nj) { const int lq = 16 * nj + fr; float tot = 0.f;
#pragma unroll
            for (int w = 0; w < 8; ++w) tot += ssq[w * 64 + lq];
            const float rs = rsqrtf(tot * (1.f / 512.f) + LN_EPS); const size_t row = row0 + lq;
#pragma unroll
            for (int mi = 0; mi < 4; ++mi) { const int p0 = 16 * mi + 4 * fq; const f32x4 wv = *(const f32x4*)(nw + p0); const f32x4 y = Y[mi][nj];
                u32x2 w; w.x = pk2(y[0] * rs * wv[0], y[1] * rs * wv[1]); w.y = pk2(y[2] * rs * wv[2], y[3] * rs * wv[3]);
                *(u32x2*)(MIXED + row * D_ + 256 + hd * 64 + p0) = w; } } }
        __syncthreads();
    }
}

__device__ __forceinline__ void na_phase2(const bf16_t* PROJ, bf16_t* MIXED, const float* rpb, LAS unsigned char* lds, int G) {
    const int tid = ltid(), lane = tid & 63, wave = __builtin_amdgcn_readfirstlane(tid >> 6), j = wave & 3;
    LAS bf16_t* Vl = (LAS bf16_t*)(lds + wave * SSD_WAVE_LDS);
    LAS float* rpl = (LAS float*)(lds + wave * SSD_WAVE_LDS + 8448);
    const int t_lo = j < 2 ? 0 : j - 1, t_hi = j == 0 ? 1 : (j == 3 ? 3 : j + 1);
    const bool pr0 = t_lo <= 1, pr1 = t_hi >= 2;
    const int fr = lane & 15, fq = lane >> 4;
    int bix[4][4];
    { const int c = 16 * j + fr, c0 = min(max(c - 8, 0), 48);
#pragma unroll
      for (int kt = 0; kt < 4; ++kt)
#pragma unroll
          for (int e = 0; e < 4; ++e) { const int kc = 16 * kt + 4 * fq + e; bix[kt][e] = (kc >= c0 && kc < c0 + 16) ? min(max(kc - c, -15), 15) + 15 : -1; } }
    unsigned koff[4], voff[8];
#pragma unroll
    for (int kt = 0; kt < 4; ++kt) koff[kt] = (unsigned)((16 * kt + fr) * NP + PK + 8 * fq) * 2u;
#pragma unroll
    for (int i = 0; i < 8; ++i) { const int q = lane + 64 * i; voff[i] = (unsigned)((q >> 3) * NP + PV + (q & 7) * 8) * 2u; }
    constexpr float L2E = 1.44269504089f;
    const int per_ = (8 * 128 * 2 + G - 1) / G, it0_ = lbid() * per_, it1_ = min(it0_ + per_, 8 * 128 * 2);
    for (int it = it0_; it < it1_; ++it) {
        const int r = it & 127, hp = (it >> 7) & 1, b = it >> 8, h = hp * 2 + (wave >> 2);
        const int r0 = min(max(r - 4, 0), 120);
        const size_t rowq0 = (size_t)b * T_ + r * 64;
        { const float* rph = rpb + h * 15 * 31;
#pragma unroll
          for (int i = 0; i < 8; ++i) { const int e = lane + 64 * i; if (e < 465) rpl[e] = rph[e] * L2E; } }
        bf16x8 qf[2];
        { const bf16_t* qp = PROJ + (rowq0 + 16 * j + fr) * NP + PQ + h * 64 + 8 * fq; qf[0] = *(const bf16x8*)qp; qf[1] = *(const bf16x8*)(qp + 32); }
        f32x4 O[4];
#pragma unroll
        for (int mi = 0; mi < 4; ++mi) O[mi] = (f32x4){0.f, 0.f, 0.f, 0.f};
        float mx = -1e30f, lsum = 0.f;
        bf16x8 kn[4][2]; u32x4 vn[8];
        const char* kbase = (const char*)(PROJ + ((size_t)b * T_ + r0 * 64) * NP + h * 64);
#pragma unroll
        for (int kt = 0; kt < 4; ++kt) if (kt >= t_lo && kt <= t_hi) { kn[kt][0] = *(const bf16x8*)(kbase + koff[kt]); kn[kt][1] = *(const bf16x8*)(kbase + koff[kt] + 64); }
#pragma unroll
        for (int i = 0; i < 8; ++i) if (i < 4 ? pr0 : pr1) vn[i] = *(const u32x4*)(kbase + voff[i]);
#pragma unroll 1
        for (int kr = 0; kr < 8; ++kr) {
            const int krow = r0 + kr;
            int ln_ = lane; asm volatile("" : "+v"(ln_)); const int fr = ln_ & 15, fq = ln_ >> 4;
#pragma unroll
            for (int i = 0; i < 8; ++i) if (i < 4 ? pr0 : pr1) { const int q = ln_ + 64 * i, key = q >> 3, dc = (q & 7) * 8; LAS unsigned* d = (LAS unsigned*)(Vl + key * SSD_XS + dc);
                d[0] = vn[i].x; d[1] = vn[i].y; d[2] = vn[i].z; d[3] = vn[i].w; }
            f32x4 S[4];
            const LAS float* rpr = rpl + (krow - r + 7) * 31;
#pragma unroll
            for (int kt = 0; kt < 4; ++kt) if (kt >= t_lo && kt <= t_hi) { f32x4 t = MFMA16(kn[kt][0], qf[0], ((f32x4){0.f, 0.f, 0.f, 0.f})); S[kt] = MFMA16(kn[kt][1], qf[1], t); }
            kbase += (size_t)64 * NP * 2;
            if (kr < 7) {
#pragma unroll
                for (int kt = 0; kt < 4; ++kt) if (kt >= t_lo && kt <= t_hi) { kn[kt][0] = *(const bf16x8*)(kbase + koff[kt]); kn[kt][1] = *(const bf16x8*)(kbase + koff[kt] + 64); }
#pragma unroll
                for (int i = 0; i < 8; ++i) if (i < 4 ? pr0 : pr1) vn[i] = *(const u32x4*)(kbase + voff[i]); }
            float gm = -1e30f;
#pragma unroll
            for (int kt = 0; kt < 4; ++kt) {
                if (kt >= t_lo && kt <= t_hi) { f32x4 t = S[kt];
#pragma unroll
                    for (int e = 0; e < 4; ++e) { const int bi = bix[kt][e]; const float s = bi >= 0 ? t[e] * (0.125f * L2E) + rpr[bi] : -1e30f; t[e] = s; gm = fmaxf(gm, s); }
                    S[kt] = t; }
                else S[kt] = (f32x4){-1e30f, -1e30f, -1e30f, -1e30f}; }
            gm = fmaxf(gm, __shfl_xor(gm, 16)); gm = fmaxf(gm, __shfl_xor(gm, 32));
            const float mnew = fmaxf(mx, gm), al = __builtin_amdgcn_exp2f(mx - mnew); mx = mnew; lsum *= al;
#pragma unroll
            for (int mi = 0; mi < 4; ++mi) O[mi] = O[mi] * al;
#pragma unroll
            for (int kt = 0; kt < 4; ++kt) {
                if (kt >= t_lo && kt <= t_hi) {
#pragma unroll
                    for (int e = 0; e < 4; ++e) { const float p = __builtin_amdgcn_exp2f(S[kt][e] - mnew); S[kt][e] = p; lsum += p; } }
                else S[kt] = (f32x4){0.f, 0.f, 0.f, 0.f}; }
#pragma unroll
            for (int pr = 0; pr < 2; ++pr) if (pr == 0 ? pr0 : pr1) {
                const unsigned w0 = pk2hw(S[2 * pr][0], S[2 * pr][1]), w1 = pk2hw(S[2 * pr][2], S[2 * pr][3]), w2 = pk2hw(S[2 * pr + 1][0], S[2 * pr + 1][1]), w3 = pk2hw(S[2 * pr + 1][2], S[2 * pr + 1][3]);
                const u32x4 w = {w0, w1, w2, w3}; const bf16x8 pf = __builtin_bit_cast(bf16x8, w);
#pragma unroll
                for (int mi = 0; mi < 4; ++mi) { bf16x8 af;
#pragma unroll
                    for (int jj = 0; jj < 4; ++jj) { af[jj] = (short)Vl[(32 * pr + 4 * fq + jj) * SSD_XS + 16 * mi + fr]; af[4 + jj] = (short)Vl[(32 * pr + 16 + 4 * fq + jj) * SSD_XS + 16 * mi + fr]; }
                    O[mi] = MFMA16(af, pf, O[mi]); } }
        }
        { lsum += __shfl_xor(lsum, 16); lsum += __shfl_xor(lsum, 32); const float inv = 1.f / lsum;
          bf16_t* op = MIXED + (rowq0 + 16 * j + fr) * D_ + h * 64 + 4 * fq;
#pragma unroll
          for (int mi = 0; mi < 4; ++mi) { u32x2 w; w.x = pk2hw(O[mi][0] * inv, O[mi][1] * inv); w.y = pk2hw(O[mi][2] * inv, O[mi][3] * inv); *(u32x2*)(op + 16 * mi) = w; } }
    }
}
__device__ __forceinline__ void ln_phase(const Args& a, const float* gam, const float* bet, int G) {
    const int tid = ltid(), lane = tid & 63, gw = lbid() * 8 + (tid >> 6), NGW = G * 8;
    float* H = lptr(a.out); bf16_t* HB = (bf16_t*)(lptr(a.ws) + WS_HB);
    for (int m = gw; m < M_ / 2; m += NGW) { const size_t r0 = (size_t)m * D_, r1 = (size_t)(m + M_ / 2) * D_;
        ln_row2(H + r0, H + r1, H + r0, H + r1, (bf16_t*)nullptr, (bf16_t*)nullptr, gam, bet, lane); }
}
__device__ __forceinline__ void xsoftmax_phase(const Args& a, int G) {
    const float* S = (const float*)(lptr(a.ws) + WS_S); bf16_t* P = (bf16_t*)(lptr(a.ws) + WS_QB);
    const int tid = ltid(), lane = tid & 63, gw = lbid() * 8 + (tid >> 6), NGW = G * 8;
    for (int m = gw; m < M_; m += NGW) {
#pragma unroll
        for (int j = 0; j < 4; ++j) { const f32x4 v = ((const f32x4*)(S + (size_t)m * D_ + j * 256))[lane];
            const float mx = wave_max(fmaxf(fmaxf(v.x, v.y), fmaxf(v.z, v.w)));
            const float e0 = __expf(v.x - mx), e1 = __expf(v.y - mx), e2 = __expf(v.z - mx), e3 = __expf(v.w - mx);
            const float inv = 1.f / wave_sum((e0 + e1) + (e2 + e3));
            u32x2 w; w.x = pk2(e0 * inv, e1 * inv); w.y = pk2(e2 * inv, e3 * inv); ((u32x2*)(P + (size_t)m * D_ + j * 256))[lane] = w; } }
}

#define XB_TMO      128
#define XB_XCNT(j)  (256  + 64 * (j))
#define XB_XSUB(j)  (1280 + 64 * (j))
#define XB_XGEN(j)  (2304 + 64 * (j))
#define XB_TOP      3328
#define XB_TOPGEN   3392
#define XCD_BAR_WORDS 3456
#define XB_SPIN_CAP (1u << 18)

__device__ __forceinline__ unsigned xb_ld(unsigned* p)              { return __hip_atomic_load(p, __ATOMIC_RELAXED, __HIP_MEMORY_SCOPE_AGENT); }
__device__ __forceinline__ unsigned xb_add(unsigned* p, unsigned v) { return __hip_atomic_fetch_add(p, v, __ATOMIC_RELAXED, __HIP_MEMORY_SCOPE_AGENT); }
__device__ __forceinline__ unsigned xb_xcc_id() { return (unsigned)__builtin_amdgcn_s_getreg((3 << 11) | 20) & 0xFu; }
#define XB_SPIN(cond, bar) do { unsigned _sp = 0; while (cond) { __builtin_amdgcn_s_sleep(1); \
    if ((++_sp & 255u) == 0u) { if (xb_ld(&(bar)[XB_TMO])) break; if (_sp > XB_SPIN_CAP) { atomicAdd(&(bar)[XB_TMO], 1u); break; } } } } while (0)

struct XcdBarrier {
    unsigned* bar; unsigned x;
    volatile LAS unsigned* st;
};

__device__ __forceinline__ XcdBarrier xcd_barrier_post(unsigned* bar, volatile LAS unsigned* st) {
    XcdBarrier b; b.bar = bar; b.x = xb_xcc_id(); b.st = st;
    if (threadIdx.x == 0) (void)xb_add(&bar[XB_XCNT(b.x)], 1u);
    return b;
}
__device__ __forceinline__ void xcd_barrier_complete(unsigned* bar, unsigned x, unsigned& nloc, unsigned& nx) {
    const unsigned G = gridDim.x * gridDim.y * gridDim.z;
    unsigned sum, cnt, mine, sp = 0u;
    for (;;) {
        sum = 0u; cnt = 0u; mine = 0u;
#pragma unroll
        for (unsigned j = 0; j < 16; ++j) { const unsigned c = xb_ld(&bar[XB_XCNT(j)]); sum += c; cnt += (c > 0u) ? 1u : 0u; mine = (j == x) ? c : mine; }
        if (sum == G) break;
        __builtin_amdgcn_s_sleep(1);
        if ((++sp & 255u) == 0u) { if (xb_ld(&bar[XB_TMO])) break; if (sp > XB_SPIN_CAP) { atomicAdd(&bar[XB_TMO], 1u); break; } }
    }
    nloc = mine > 0u ? mine : 1u; nx = cnt > 0u ? cnt : 1u;
}

__device__ __forceinline__ void xcd_barrier(const XcdBarrier& b) {
    asm volatile("s_waitcnt vmcnt(0)" ::: "memory");
    __syncthreads();
    if (threadIdx.x == 0) {
        unsigned* bar = b.bar;
        __builtin_amdgcn_s_waitcnt(0);
        unsigned nloc = b.st[0], nx = b.st[1];
        if (nloc == 0u) { xcd_barrier_complete(bar, b.x, nloc, nx); b.st[0] = nloc; b.st[1] = nx; }
        const unsigned old = xb_add(&bar[XB_XSUB(b.x)], 1u);
        const unsigned gen = old / nloc;
        if (old + 1u == (gen + 1u) * nloc) {
            __builtin_amdgcn_fence(__ATOMIC_RELEASE, "agent");
            asm volatile("s_waitcnt vmcnt(0)" ::: "memory");
            const unsigned og = xb_add(&bar[XB_TOP], 1u);
            const unsigned tg = og / nx;
            if (og + 1u == (tg + 1u) * nx) xb_add(&bar[XB_TOPGEN], 1u);
            else XB_SPIN(xb_ld(&bar[XB_TOPGEN]) == tg, bar);
            __builtin_amdgcn_fence(__ATOMIC_ACQUIRE, "agent");
            xb_add(&bar[XB_XGEN(b.x)], 1u);
            asm volatile("s_waitcnt vmcnt(0)" ::: "memory");
        } else {
            XB_SPIN(xb_ld(&bar[XB_XGEN(b.x)]) == gen, bar);
            __builtin_amdgcn_fence(__ATOMIC_ACQUIRE, "agent");
            asm volatile("s_waitcnt vmcnt(0)" ::: "memory");
        }
    }
    __syncthreads();
}

__device__ __forceinline__ const LAS float* stage_gb(LAS unsigned char* lds, const float* gam, const float* bet) {
    LAS float* gl = (LAS float*)(lds + 139264); const int t = ltid();
    *(LAS f32x4*)(gl + 4 * t) = (t < 256) ? ((const f32x4*)gam)[t] : ((const f32x4*)bet)[t - 256];
    __syncthreads(); return gl;
}
#ifndef ONLY_S
#define ONLY_S -1
#endif
#define PHX(x) (ONLY_S == -1 || ONLY_S == (x))
__global__ void __launch_bounds__(512, 2) fwd(Args a) {
    extern __shared__ __attribute__((aligned(16))) unsigned char lds_raw[];
    LAS unsigned char* lds = (LAS unsigned char*)lds_raw;
    volatile LAS unsigned* bst = (volatile LAS unsigned*)(lds + 157696);
    if (threadIdx.x < 16) bst[threadIdx.x] = 0u;
    __syncthreads();
    XcdBarrier xbar; xbar.bar = (unsigned*)(a.ws + 4096); xbar.x = 0; xbar.st = bst;
    if (a.coop) xbar = xcd_barrier_post((unsigned*)(a.ws + 4096), bst);
    for (int ph = a.ph_lo; ph < a.ph_hi; ++ph) {
    int G = gridDim.x; asm volatile("" : "+s"(G)); const int bx = lbid();
    bf16_t* HB = (bf16_t*)(lptr(a.ws) + WS_HB); bf16_t* PROJ = (bf16_t*)(lptr(a.ws) + WS_PROJ); bf16_t* MIXED = (bf16_t*)(lptr(a.ws) + WS_MIXED); bf16_t* CONV = (bf16_t*)(lptr(a.ws) + WS_CONV);
    bf16_t* UX = (bf16_t*)(lptr(a.ws) + WS_UX); bf16_t* MEMB = (bf16_t*)(lptr(a.ws) + WS_MEMB); bf16_t* KM = (bf16_t*)(lptr(a.ws) + WS_KM); bf16_t* VMT = (bf16_t*)(lptr(a.ws) + WS_VMT);
    bf16_t* QB = (bf16_t*)(lptr(a.ws) + WS_QB); bf16_t* OB = (bf16_t*)(lptr(a.ws) + WS_OB); bf16_t* HID = (bf16_t*)(lptr(a.ws) + WS_HID);
    float* SL0 = (float*)(lptr(a.ws) + WS_SL); float* SL1 = SL0 + (size_t)M_ * 8;
        if (ph == 0) { if (PHX(100)) prologue(a, lds, G); }
        else {
            const int l = (ph - 1) / 17, s = (ph - 1) % 17;
            unsigned char* wb = lptr(a.ws) + WS_W + (size_t)l * LWB;
            pg8::Sched S;
            if (s == 0 && PHX(0)) {
                if (l == 0) {
                    { pg8::Gemm g{MEMB, (const bf16_t*)(lptr(a.ws) + WS_W + OW_K), D_, D_, D_, 0, 0, LWB / 2, 0}; S.init(8, 4, 2, 1, G, bx);
                      pg8::EpiStore<0> E{KM, D_, (size_t)B_ * MEMT * D_, 0, 1 << 30, 1.f}; pg8::gemm_phase(lds, g, S, E); }
                    { pg8::Gemm g{(const bf16_t*)(lptr(a.ws) + WS_W + OW_V), MEMB, D_, D_, D_, LWB / 2, 0, 0, (size_t)MEMT * D_}; S.init(4, 1, 2, 8, G, bx);
                      pg8::EpiStore<0> E{VMT, MEMT, (size_t)B_ * D_ * MEMT, (size_t)D_ * MEMT, 1 << 30, 1.f}; pg8::gemm_phase(lds, g, S, E); }
                }
                pg8::Gemm g{HB, (const bf16_t*)(wb + OW_IN), D_, D_, D_, 0, 0, 0, 0}; S.init(M_ / 256, NPP / 256, 1, 1, G, bx);
                if (l == 0) { pg8::EpiStore<0> E{PROJ, NP, 0, 0, NP, 1.f}; pg8::gemm_phase(lds, g, S, E); }
                else { float* cs = cs_ptr(lptr(a.ws), 1, 2); pg8::EpiStoreLN<0> E{PROJ, NP, NP, 1.f, SL0  , cs, cs + NPP}; pg8::gemm_phase(lds, g, S, E); }
            } else if (s == 1 && PHX(1)) {
                if (l == 0) colsum_phase(a, G);
                na_phase2(PROJ, MIXED, gp(a.in[I_RPB]) + l * 4 * 15 * 31, lds, G);
#ifndef NO_CONV
                conv_phase(PROJ, CONV, gp(a.in[I_CONVW]) + l * 5 * 768, gp(a.in[I_CONVB]) + l * 768, G);
#endif
                s5_gather_phase(PROJ, UX, G);
            } else if (s == 2 && PHX(2)) {
                ssd_passA2(a, l, lds, G);
                __syncthreads();
                pg8::Gemm g{UX, (const bf16_t*)(lptr(a.ws) + WS_SM) + (size_t)l * 16 * 256 * 256, 512, 256, 256, (size_t)4096 * 512, 0, (size_t)256 * 256, 0}; S.init(16, 1, 16, 1, G, bx);
                pg8::EpiF32 E{(float*)(lptr(a.ws) + WS_S5S), 256, (size_t)4096 * 256, 0}; pg8::gemm_phase(lds, g, S, E);
            } else if (s == 3 && PHX(3)) {
                ssd_scan2(a, G);
                s5_scan(a, l, G);
            } else if (s == 4 && PHX(4)) {
#ifndef NO_PC
                ssd_passC2(a, l, lds, G);
#endif
                pg8::Gemm g{UX, (const bf16_t*)(lptr(a.ws) + WS_TM) + (size_t)l * 16 * 256 * 512, 512, 512, 512, (size_t)4096 * 512, 0, (size_t)256 * 512, 0}; S.init(16, 1, 16, 1, G, bx);
#ifndef NO_G4
                pg8::EpiS5Y E{MIXED}; pg8::gemm_phase(lds, g, S, E);
#endif
            } else if (s == 5 && PHX(5)) {
                pg8::Gemm g{MIXED + 768, (const bf16_t*)(wb + OW_GLU), D_, 256, 256, 0, 0, 0, 0}; S.init(M_ / 256, 1, 1, 1, G, bx);
                pg8::EpiGLU E{MIXED, gp(a.in[I_GLUB]) + l * 256}; pg8::gemm_phase(lds, g, S, E);
            } else if (s == 6 && PHX(6)) {
                pg8::Gemm g{MIXED, (const bf16_t*)(wb + OW_OUT), D_, D_, D_, 0, 0, 0, 0}; S.init(M_ / 256, 4, 1, 1, G, bx);
                if (l == 0) { pg8::EpiResidLN<true> E{lptr(a.out), HB, SL1, SL0, nullptr, nullptr, (LAS float*)(lds + 131072), ALPHA}; pg8::gemm_phase(lds, g, S, E); }
                else { const LAS float* gl = stage_gb(lds, gp(a.in[I_LNMLP_G]), gp(a.in[I_LNMLP_B])); pg8::EpiResidLN<false> E{lptr(a.out), HB, SL0, SL1, gl, nullptr, (LAS float*)(lds + 131072), ALPHA}; pg8::gemm_phase(lds, g, S, E); }
            } else if (s == 7 && PHX(7)) {
            } else if (s == 8 && PHX(8)) {
                pg8::Gemm g{HB, (const bf16_t*)(wb + OW_Q), D_, D_, D_, 0, 0, 0, 0}; S.init(M_ / 256, 4, 1, 1, G, bx);
                float* cs = cs_ptr(lptr(a.ws), l, 0); pg8::EpiStoreLN<0> E{QB, D_, 1 << 30, 0.0625f, l == 0 ? SL0 : SL1, cs, cs + D_}; pg8::gemm_phase(lds, g, S, E);
            } else if (s == 9 && PHX(9)) {
                pg8::Gemm g{QB, KM + (size_t)l * B_ * MEMT * D_, D_, D_, 256, (size_t)T_ * D_, 256, (size_t)MEMT * D_, 256}; S.init(T_ / 256, 1, 8, 4, G, bx);
                pg8::EpiSoftmax E{(bf16_t*)(lptr(a.ws) + WS_S), D_, (size_t)T_ * D_, 256, (LAS float*)(lds + 131072)}; pg8::gemm_phase(lds, g, S, E);
            } else if (s == 10 && PHX(10)) {
            } else if (s == 11 && PHX(11)) {
                pg8::Gemm g{(const bf16_t*)(lptr(a.ws) + WS_S), VMT + (size_t)l * B_ * D_ * MEMT, D_, MEMT, 256, (size_t)T_ * D_, 256, (size_t)D_ * MEMT, (size_t)256 * MEMT}; S.init(T_ / 256, 1, 8, 4, G, bx);
                pg8::EpiStore<0> E{OB, D_, (size_t)T_ * D_, 256, 1 << 30, 1.f}; pg8::gemm_phase(lds, g, S, E);
            } else if (s == 12 && PHX(12)) {
                pg8::Gemm g{OB, (const bf16_t*)(wb + OW_O), D_, D_, D_, 0, 0, 0, 0}; S.init(M_ / 256, 4, 1, 1, G, bx);
                const LAS float* gl = stage_gb(lds, gp(a.in[I_LNMIX_G]) + l * D_, gp(a.in[I_LNMIX_B]) + l * D_); pg8::EpiResidLN<false> E{lptr(a.out), HB, l == 0 ? SL0 : SL1, l == 0 ? SL1 : SL0, gl, nullptr, (LAS float*)(lds + 131072), ALPHA}; pg8::gemm_phase(lds, g, S, E);
            } else if (s == 13 && PHX(13)) {
            } else if (s == 14 && PHX(14)) {
                pg8::Gemm g{HB, (const bf16_t*)(wb + OW_1), D_, D_, D_, 0, 0, 0, 0}; S.init(M_ / 256, FF_ / 256, 1, 1, G, bx);
                float* cs = cs_ptr(lptr(a.ws), l, 1); pg8::EpiStoreLN<1> E{HID, FF_, 1 << 30, 1.f, l == 0 ? SL1 : SL0, cs, cs + FF_}; pg8::gemm_phase(lds, g, S, E);
            } else if (s == 15 && PHX(15)) {
                pg8::Gemm g{HID, (const bf16_t*)(wb + OW_2), FF_, FF_, FF_, 0, 0, 0, 0}; S.init(M_ / 256, 4, 1, 1, G, bx);
                const LAS float* gl = stage_gb(lds, gp(a.in[I_LNXA_G]) + l * D_, gp(a.in[I_LNXA_B]) + l * D_); pg8::EpiResidLN<false> E{lptr(a.out), l == 0 ? HB : (bf16_t*)nullptr, l == 0 ? SL1 : SL0, l == 0 ? SL0 : SL1, gl, nullptr, (LAS float*)(lds + 131072), ALPHA}; pg8::gemm_phase(lds, g, S, E);
            } else if (PHX(16)) {
                if (l == 1) ln_phase(a, gp(a.in[I_LNMLP_G]) + l * D_, gp(a.in[I_LNMLP_B]) + l * D_, G);
            }
        }
        if (ph + 1 < a.ph_hi) { const int s_ = (ph - 1) % 17; const bool empty_ = ph > 0 && (s_ == 7 || s_ == 10 || s_ == 13 || (s_ == 16 && ph < 18)); if (a.coop && !empty_) { if (a.ph_hi < 0) cg::this_grid().sync();   xcd_barrier(xbar); } }
    }
}

constexpr int NPHASES = 1 + 2 * 17;
#ifndef MULTI_LAUNCH
#define MULTI_LAUNCH 0
#endif

extern "C" void kernel_launch(void* const* d_in, const int* in_sizes, int n_in, void* d_out, int out_size, void* d_ws, size_t ws_size, hipStream_t stream) {
    static int grid = 0;
    if (grid == 0) {
        if (n_in != 35 || out_size != M_ * D_ || ws_size < WS_END) { fprintf(stderr, "kernel_launch: unexpected sizes n_in %d out %d ws %zu\n", n_in, out_size, ws_size); grid = -1; return; }
        int dev = 0, cus = 0, per_cu = 0;
        hipGetDevice(&dev); hipDeviceGetAttribute(&cus, hipDeviceAttributeMultiprocessorCount, dev);
        if (hipFuncSetAttribute((const void*)fwd, hipFuncAttributeMaxDynamicSharedMemorySize, LDS_BYTES) != hipSuccess) { fprintf(stderr, "kernel_launch: hipFuncSetAttribute failed\n"); grid = -1; return; }
        if (hipOccupancyMaxActiveBlocksPerMultiprocessor(&per_cu, (const void*)fwd, 512, LDS_BYTES) != hipSuccess || per_cu < 1) { fprintf(stderr, "kernel_launch: occupancy query says %d\n", per_cu); per_cu = 1; }
        (void)hipGetLastError();
        grid = cus * per_cu;
    }
    if (grid < 0) return;
    (void)hipMemsetAsync(d_ws, 0, 65536, stream);
    Args a{};
    for (int i = 0; i < 35; ++i) a.in[i] = (const float*)d_in[i];
    a.out = (float*)d_out; a.ws = (unsigned char*)d_ws;
#if MULTI_LAUNCH
    for (int ph = 0; ph < NPHASES; ++ph) { a.ph_lo = ph; a.ph_hi = ph + 1; a.coop = 0; hipLaunchKernelGGL(fwd, dim3(grid), dim3(512), LDS_BYTES, stream, a); }
#else
    a.ph_lo = 0; a.ph_hi = NPHASES; a.coop = 1;
    void* args[] = {&a};
    hipError_t e = hipLaunchCooperativeKernel((const void*)fwd, dim3(grid), dim3(512), args, LDS_BYTES, stream);
    if (e != hipSuccess) fprintf(stderr, "cooperative launch failed: %s (grid %d)\n", hipGetErrorString(e), grid);
#endif
}
```

```cpp
#include <hip/hip_runtime.h>
#include <hip/hip_cooperative_groups.h>
#include <cstdio>
#include <cstdint>
namespace cg = cooperative_groups;

#define LAS __attribute__((address_space(3)))
typedef unsigned short bf16_t;
typedef short bf16x8 __attribute__((ext_vector_type(8)));
typedef float f32x4 __attribute__((ext_vector_type(4)));
typedef float f32x2 __attribute__((ext_vector_type(2)));
typedef unsigned u32x4 __attribute__((ext_vector_type(4)));
typedef unsigned u32x2 __attribute__((ext_vector_type(2)));

constexpr int B_ = 8, T_ = 8192, D_ = 1024, M_ = B_ * T_, NP = 2320, NPP = 2560, FF_ = 4096, MEMT = 256;
constexpr float LN_EPS = 1e-5f;
constexpr float ALPHA = 1.41421356237f;
constexpr int PQ = 0, PK = 256, PV = 512, PZ = 768, PX = 1280, PDT = 2048, PU = 2064;

constexpr size_t MiB = 1u << 20;
constexpr size_t WS_W = 1 * MiB, LWB = 32 * MiB;
constexpr size_t OW_IN = 0, OW_OUT = 5 * MiB, OW_Q = 7 * MiB, OW_K = 9 * MiB, OW_V = 11 * MiB, OW_O = 13 * MiB, OW_1 = 15 * MiB, OW_2 = 23 * MiB, OW_GLU = 31 * MiB;
constexpr size_t WS_MEMB = 65 * MiB, WS_KM = 69 * MiB, WS_VMT = 77 * MiB, WS_TM = 85 * MiB, WS_SM = 93 * MiB, WS_MISC = 97 * MiB;
constexpr size_t WS_HB = 100 * MiB, WS_PROJ = 228 * MiB, WS_MIXED = 518 * MiB, WS_CONV = 646 * MiB, WS_HID = 228 * MiB;
constexpr size_t WS_S = 228 * MiB, WS_QB = 484 * MiB, WS_OB = 612 * MiB, WS_ST = 744 * MiB, WS_UX = 872 * MiB, WS_S5S = 936 * MiB, WS_SL = 1000 * MiB, WS_END = 1004 * MiB;
constexpr size_t MISC_CS = 262144;
constexpr int LDS_BYTES = 157696 + 64;

__device__ __forceinline__ float bf2f(unsigned u) { return __uint_as_float(u << 16); }
__device__ __forceinline__ float bflo(unsigned u) { return __uint_as_float(u << 16); }
__device__ __forceinline__ float bfhi(unsigned u) { return __uint_as_float(u & 0xffff0000u); }
__device__ __forceinline__ unsigned f2bf(float f) { unsigned u = __float_as_uint(f); return (u + 0x7fffu + ((u >> 16) & 1u)) >> 16; }
__device__ __forceinline__ unsigned pk2(float lo, float hi) { return f2bf(lo) | (f2bf(hi) << 16); }
__device__ __forceinline__ unsigned pk2hw(float lo, float hi) { unsigned r; asm volatile("v_cvt_pk_bf16_f32 %0, %1, %2" : "=v"(r) : "v"(lo), "v"(hi)); return r; }
__device__ __forceinline__ float wave_sum(float v) {
#pragma unroll
    for (int o = 1; o < 64; o <<= 1) v += __shfl_xor(v, o);
    return v;
}
__device__ __forceinline__ float wave_max(float v) {
#pragma unroll
    for (int o = 1; o < 64; o <<= 1) v = fmaxf(v, __shfl_xor(v, o));
    return v;
}
__device__ __forceinline__ float silu_f(float x) { return x * __builtin_amdgcn_rcpf(1.f + __expf(-x)); }
__device__ __forceinline__ float gelu_tanh(float x) { const float y = 0.7978845608f * (x + 0.044715f * x * x * x); const float t = 1.f - 2.f * __builtin_amdgcn_rcpf(1.f + __expf(2.f * y)); return 0.5f * x * (1.f + t); }
__device__ __forceinline__ int ltid() { int t = threadIdx.x; asm volatile("" : "+v"(t)); return t; }
__device__ __forceinline__ int lbid() { int t = blockIdx.x; asm volatile("" : "+s"(t)); return t; }
#define GAS __attribute__((address_space(1)))
__device__ __forceinline__ size_t zopq() { size_t z = 0; asm volatile("" : "+s"(z)); return z; }
template <class P> __device__ __forceinline__ P* gp(P* p) { return (P*)((char*)p + zopq()); }
template <class P> __device__ __forceinline__ P* lptr(P* p) { return (P*)((char*)p + zopq()); }
#define LDS_WAIT() asm volatile("s_waitcnt lgkmcnt(0)" ::: "memory")

namespace pg8 {
constexpr int BM = 256, BK = 64, HALF = 128, HTB = HALF * BK * 2, STAGE_BYTES = 8 * HTB;
__host__ __device__ __forceinline__ int lds_byte(int r, int c) { const int st = (r >> 4) * 2 + (c >> 5), rr = r & 15, cc = c & 31, ob = rr * 64 + cc * 2; return st * 1024 + (ob ^ (((ob >> 9) & 1) << 5)); }
__host__ __device__ __forceinline__ void stage_rc(int b, int& R, int& C) { const int st = b / 1024, sb = b % 1024, swz = sb ^ (((sb >> 9) & 1) << 5); R = (st >> 1) * 16 + swz / 64; C = (st & 1) * 32 + (swz % 64) / 2; }
__host__ __device__ __forceinline__ int perm32(int rho) { const int n = rho >> 4, i = rho & 15; return 8 * (i >> 2) + 4 * n + (i & 3); }

struct Unit { int pm, pn, b1, b2; };
struct Gemm { const bf16_t* A; const bf16_t* Bt; int lda, ldb, K; size_t aS1, aS2, bS1, bS2; };

struct Sched {
    int nM, nN, nB2, total, G, c;
    __device__ __forceinline__ void init(int nM_, int nN_, int nB1_, int nB2_, int G_, int c_) { nM = nM_; nN = nN_; nB2 = nB2_; total = nM_ * nN_ * nB1_ * nB2_; G = G_; c = c_; }
    __device__ __forceinline__ bool next(int i, Unit& u) const {
        const long L = (long)i * G + c; if (L >= total) return false;
        int w = (int)L;
        { const int q = total / 8, r = total % 8, xcd = w % 8, off = w / 8; w = (xcd < r ? xcd * (q + 1) : r * (q + 1) + (xcd - r) * q) + off; }
        const int per = nM * nN; const int bt = w / per; w -= bt * per;
        const int nig = 8 * nN, gid = w / nig, fm = gid * 8, gsz = (nM - fm) < 8 ? (nM - fm) : 8;
        u.pm = fm + ((w % nig) % gsz); u.pn = (w % nig) / gsz; u.b1 = bt / nB2; u.b2 = bt % nB2; return true;
    }
};

typedef f32x4 Acc[2][2][4][2];

template <int ACT> struct EpiStore {
    static constexpr bool PERM = true;
    bf16_t* C; int ldc; size_t cS1, cS2; int ncols; float scale;
    __device__ __forceinline__ void operator()(const Acc& acc, const Unit& u, int wr, int wc, int fr, int fq) const {
        asm volatile("" : "+v"(fr), "+v"(fq));
        bf16_t* base = C + u.b1 * cS1 + u.b2 * cS2;
        const int row0 = u.pm * BM + wr * 64 + fr, col0 = u.pn * BM + wc * 32 + 8 * fq;
#pragma unroll
        for (int ai = 0; ai < 2; ++ai)
#pragma unroll
            for (int m = 0; m < 4; ++m) { bf16_t* rowp = base + (size_t)(row0 + ai * HALF + m * 16) * ldc + col0;
#pragma unroll
                for (int bj = 0; bj < 2; ++bj) { f32x4 v0 = acc[ai][bj][m][0], v1 = acc[ai][bj][m][1];
                    if (ACT == 1) {
#pragma unroll
                        for (int e = 0; e < 4; ++e) { float a0 = fmaxf(v0[e], 0.f), a1 = fmaxf(v1[e], 0.f); v0[e] = a0 * a0; v1[e] = a1 * a1; } }
                    v0 = v0 * scale; v1 = v1 * scale;
                    u32x4 w; w.x = pk2(v0[0], v0[1]); w.y = pk2(v0[2], v0[3]); w.z = pk2(v1[0], v1[1]); w.w = pk2(v1[2], v1[3]);
                    if (col0 + bj * HALF < ncols) *(u32x4*)(rowp + bj * HALF) = w; }
                asm volatile("" ::: "memory"); }
    }
};
struct EpiF32 {
    static constexpr bool PERM = false;
    float* C; int ldc; size_t cS1, cS2;
    __device__ __forceinline__ void operator()(const Acc& acc, const Unit& u, int wr, int wc, int fr, int fq) const {
        asm volatile("" : "+v"(fr), "+v"(fq));
        float* base = C + u.b1 * cS1 + u.b2 * cS2;
        const int row0 = u.pm * BM + wr * 64 + fr, col0 = u.pn * BM + wc * 32 + 4 * fq;
#pragma unroll
        for (int ai = 0; ai < 2; ++ai)
#pragma unroll
            for (int m = 0; m < 4; ++m) { float* rowp = base + (size_t)(row0 + ai * HALF + m * 16) * ldc + col0;
#pragma unroll
                for (int bj = 0; bj < 2; ++bj)
#pragma unroll
                    for (int n = 0; n < 2; ++n) *(f32x4*)(rowp + bj * HALF + n * 16) = acc[ai][bj][m][n];
                asm volatile("" ::: "memory"); }
    }
};
struct EpiResid {
    static constexpr bool PERM = false;
    float* H; float alpha;
    __device__ __forceinline__ void operator()(const Acc& acc, const Unit& u, int wr, int wc, int fr, int fq) const {
        asm volatile("" : "+v"(fr), "+v"(fq));
        const int row0 = u.pm * BM + wr * 64 + fr, col0 = u.pn * BM + wc * 32 + 4 * fq;
#pragma unroll
        for (int ai = 0; ai < 2; ++ai)
#pragma unroll
            for (int m = 0; m < 4; ++m) { float* rowp = H + (size_t)(row0 + ai * HALF + m * 16) * D_ + col0;
#pragma unroll
                for (int bj = 0; bj < 2; ++bj)
#pragma unroll
                    for (int n = 0; n < 2; ++n) { f32x4* p = (f32x4*)(rowp + bj * HALF + n * 16); const f32x4 h = *p; *p = h * alpha + acc[ai][bj][m][n]; }
                asm volatile("" ::: "memory"); }
    }
};
struct EpiS5Y {
    static constexpr bool PERM = true;
    bf16_t* MIXED;
    __device__ __forceinline__ void operator()(const Acc& acc, const Unit& u, int wr, int wc, int fr, int fq) const {
        asm volatile("" : "+v"(fr), "+v"(fq));
        const int row0 = u.pm * BM + wr * 64 + fr, col0 = wc * 32 + 8 * fq;
#pragma unroll
        for (int ai = 0; ai < 2; ++ai)
#pragma unroll
            for (int m = 0; m < 4; ++m) { const int row = row0 + ai * HALF + m * 16;
#pragma unroll
                for (int bj = 0; bj < 2; ++bj) { const int col = col0 + bj * HALF, j = col >> 4, ho = col & 15;
                    const f32x4 v0 = acc[ai][bj][m][0], v1 = acc[ai][bj][m][1];
                    u32x4 w; w.x = pk2(gelu_tanh(v0[0]), gelu_tanh(v0[1])); w.y = pk2(gelu_tanh(v0[2]), gelu_tanh(v0[3])); w.z = pk2(gelu_tanh(v1[0]), gelu_tanh(v1[1])); w.w = pk2(gelu_tanh(v1[2]), gelu_tanh(v1[3]));
                    *(u32x4*)(MIXED + ((size_t)row * 16 + j) * D_ + 768 + u.b1 * 16 + ho) = w; asm volatile("" ::: "memory"); } }
    }
};
struct EpiGLU {
    static constexpr bool PERM = true;
    bf16_t* MIXED; const float* bias;
    __device__ __forceinline__ void operator()(const Acc& acc, const Unit& u, int wr, int wc, int fr, int fq) const {
        asm volatile("" : "+v"(fr), "+v"(fq));
        const int row0 = u.pm * BM + wr * 64 + fr, col0 = wc * 32 + 8 * fq;
#pragma unroll
        for (int ai = 0; ai < 2; ++ai)
#pragma unroll
            for (int m = 0; m < 4; ++m) { const int row = row0 + ai * HALF + m * 16;
#pragma unroll
                for (int bj = 0; bj < 2; ++bj) { const int col = col0 + bj * HALF;
                    u32x4* gp = (u32x4*)(MIXED + (size_t)row * D_ + 768 + col); const u32x4 gv = *gp;
                    const f32x4 b0 = *(const f32x4*)(bias + col), b1 = *(const f32x4*)(bias + col + 4);
                    const f32x4 v0 = acc[ai][bj][m][0] + b0, v1 = acc[ai][bj][m][1] + b1;
                    float o[8]; const unsigned gw[4] = {gv.x, gv.y, gv.z, gv.w};
#pragma unroll
                    for (int e = 0; e < 4; ++e) { const float a = e < 2 ? v0[2 * e] : v1[2 * e - 4], b = e < 2 ? v0[2 * e + 1] : v1[2 * e - 3];
                        o[2 * e] = bflo(gw[e]) * __builtin_amdgcn_rcpf(1.f + __expf(-a)); o[2 * e + 1] = bfhi(gw[e]) * __builtin_amdgcn_rcpf(1.f + __expf(-b)); }
                    u32x4 w; w.x = pk2(o[0], o[1]); w.y = pk2(o[2], o[3]); w.z = pk2(o[4], o[5]); w.w = pk2(o[6], o[7]);
                    *gp = w; asm volatile("" ::: "memory"); } }
    }
};

struct EpiSoftmax {
    static constexpr bool PERM = true;
    bf16_t* C; int ldc; size_t cS1, cS2; LAS float* red;
    __device__ __forceinline__ void operator()(const Acc& acc, const Unit& u, int wr, int wc, int fr, int fq) const {
        asm volatile("" : "+v"(fr), "+v"(fq));
        LAS float* red2 = red + 1024;
        float mx[2][4];
#pragma unroll
        for (int ai = 0; ai < 2; ++ai)
#pragma unroll
            for (int m = 0; m < 4; ++m) { float v = -1e30f;
#pragma unroll
                for (int bj = 0; bj < 2; ++bj)
#pragma unroll
                    for (int n = 0; n < 2; ++n) { const f32x4 x = acc[ai][bj][m][n]; v = fmaxf(v, fmaxf(fmaxf(x[0], x[1]), fmaxf(x[2], x[3]))); }
                v = fmaxf(v, __shfl_xor(v, 16)); v = fmaxf(v, __shfl_xor(v, 32));
                if (fq == 0) red[(ai * HALF + wr * 64 + m * 16 + fr) * 4 + wc] = v; }
        asm volatile("s_waitcnt lgkmcnt(0)" ::: "memory"); __builtin_amdgcn_s_barrier(); asm volatile("" ::: "memory");
        float sm[2][4];
#pragma unroll
        for (int ai = 0; ai < 2; ++ai)
#pragma unroll
            for (int m = 0; m < 4; ++m) { const f32x4 r4 = *(const LAS f32x4*)(red + (ai * HALF + wr * 64 + m * 16 + fr) * 4);
                const float M = fmaxf(fmaxf(r4[0], r4[1]), fmaxf(r4[2], r4[3])); mx[ai][m] = M; float s = 0.f;
#pragma unroll
                for (int bj = 0; bj < 2; ++bj)
#pragma unroll
                    for (int n = 0; n < 2; ++n) { const f32x4 x = acc[ai][bj][m][n]; s += (__expf(x[0] - M) + __expf(x[1] - M)) + (__expf(x[2] - M) + __expf(x[3] - M)); }
                s += __shfl_xor(s, 16); s += __shfl_xor(s, 32);
                if (fq == 0) red2[(ai * HALF + wr * 64 + m * 16 + fr) * 4 + wc] = s; }
        asm volatile("s_waitcnt lgkmcnt(0)" ::: "memory"); __builtin_amdgcn_s_barrier(); asm volatile("" ::: "memory");
        bf16_t* base = C + u.b1 * cS1 + u.b2 * cS2;
        const int row0 = u.pm * BM + wr * 64 + fr, col0 = wc * 32 + 8 * fq;
#pragma unroll
        for (int ai = 0; ai < 2; ++ai)
#pragma unroll
            for (int m = 0; m < 4; ++m) { const f32x4 r4 = *(const LAS f32x4*)(red2 + (ai * HALF + wr * 64 + m * 16 + fr) * 4);
                const float inv = 1.f / ((r4[0] + r4[1]) + (r4[2] + r4[3])), M = mx[ai][m];
                bf16_t* rowp = base + (size_t)(row0 + ai * HALF + m * 16) * ldc + col0;
#pragma unroll
                for (int bj = 0; bj < 2; ++bj) { const f32x4 v0 = acc[ai][bj][m][0], v1 = acc[ai][bj][m][1];
                    u32x4 w; w.x = pk2(__expf(v0[0] - M) * inv, __expf(v0[1] - M) * inv); w.y = pk2(__expf(v0[2] - M) * inv, __expf(v0[3] - M) * inv);
                    w.z = pk2(__expf(v1[0] - M) * inv, __expf(v1[1] - M) * inv); w.w = pk2(__expf(v1[2] - M) * inv, __expf(v1[3] - M) * inv);
                    *(u32x4*)(rowp + bj * HALF) = w; }
                asm volatile("" ::: "memory"); }
    }
};


__device__ __forceinline__ void row_stats(const float* SL, size_t row, float& mu, float& rs) {
    const f32x4 a = *(const f32x4*)(SL + row * 8), b = *(const f32x4*)(SL + row * 8 + 4);
    const float S = (a[0] + a[2]) + (b[0] + b[2]), Q = (a[1] + a[3]) + (b[1] + b[3]);
    mu = S * (1.f / D_); rs = rsqrtf(fmaxf(Q * (1.f / D_) - mu * mu, 0.f) + LN_EPS);
}
template <bool FIRST, bool LAST> struct EpiResidLN {
    static constexpr bool PERM = false;
    float* H; bf16_t* HB; const float* SLr; float* SLw; const LAS float* gl; const float* unused_; LAS float* red; float alpha;
    __device__ __forceinline__ void operator()(const Acc& acc, const Unit& u, int wr, int wc, int fr, int fq) const {
        asm volatile("" : "+v"(fr), "+v"(fq));
        const int col0 = u.pn * BM + wc * 32 + 4 * fq;
        const size_t rowb = (size_t)u.pm * BM + wr * 64 + fr;
        u32x2 hA[4], hB[4]; f32x4 sna = (f32x4){0.f, 0.f, 0.f, 0.f}, snb = (f32x4){0.f, 0.f, 0.f, 0.f};
        if (!FIRST) { sna = *(const f32x4*)(SLr + rowb * 8); snb = *(const f32x4*)(SLr + rowb * 8 + 4); }
#pragma unroll
        for (int q = 0; q < 4; ++q) { hA[q] = *(const u32x2*)(HB + rowb * D_ + col0 + (q >> 1) * HALF + (q & 1) * 16); hB[q] = *(const u32x2*)(HB + (rowb + 16) * D_ + col0 + (q >> 1) * HALF + (q & 1) * 16); }
#pragma unroll
        for (int i = 0; i < 8; ++i) { const int ai = i >> 2, m = i & 3; const int rl = ai * HALF + wr * 64 + m * 16 + fr; const size_t row = (size_t)u.pm * BM + rl;
                float mu = 0.f, rs = 1.f;
                if (!FIRST) { const float S = (sna[0] + sna[2]) + (snb[0] + snb[2]), Q = (sna[1] + sna[3]) + (snb[1] + snb[3]); mu = S * (1.f / D_); rs = rsqrtf(fmaxf(Q * (1.f / D_) - mu * mu, 0.f) + LN_EPS); }
                u32x2 hc[4];
#pragma unroll
                for (int q = 0; q < 4; ++q) { hc[q] = hA[q]; hA[q] = hB[q]; }
                if (i < 7) { const size_t rown = rowb + ((i + 1) >> 2) * HALF + ((i + 1) & 3) * 16;
                    if (!FIRST) { sna = *(const f32x4*)(SLr + rown * 8); snb = *(const f32x4*)(SLr + rown * 8 + 4); } }
                if (i < 6) { const size_t rown = rowb + ((i + 2) >> 2) * HALF + ((i + 2) & 3) * 16;
#pragma unroll
                    for (int q = 0; q < 4; ++q) hB[q] = *(const u32x2*)(HB + rown * D_ + col0 + (q >> 1) * HALF + (q & 1) * 16); }
                float sm = 0.f, sq = 0.f; float* hp = H + row * D_ + col0; bf16_t* bp = HB + row * D_ + col0;
#pragma unroll
                for (int q = 0; q < 4; ++q) { const int bj = q >> 1, n = q & 1, co = bj * HALF + n * 16; f32x4 h = (f32x4){bflo(hc[q].x), bfhi(hc[q].x), bflo(hc[q].y), bfhi(hc[q].y)};
                        if (!FIRST) { const f32x4 g = *(const LAS f32x4*)(gl + col0 + co), b = *(const LAS f32x4*)(gl + D_ + col0 + co); h = (h - mu) * rs * g + b; }
                        const f32x4 pre = h * alpha + acc[ai][bj][m][n];
                        if (LAST) *(f32x4*)(hp + co) = pre;
                        else { u32x2 w; w.x = pk2(pre[0], pre[1]); w.y = pk2(pre[2], pre[3]); *(u32x2*)(bp + co) = w; }
                        sm += (pre[0] + pre[1]) + (pre[2] + pre[3]); sq += (pre[0] * pre[0] + pre[1] * pre[1]) + (pre[2] * pre[2] + pre[3] * pre[3]); }
                sm += __shfl_xor(sm, 16); sm += __shfl_xor(sm, 32); sq += __shfl_xor(sq, 16); sq += __shfl_xor(sq, 32);
                if (fq == 0) *(LAS f32x2*)(red + (rl * 4 + wc) * 2) = (f32x2){sm, sq};
                asm volatile("" ::: "memory"); }
        asm volatile("s_waitcnt lgkmcnt(0)" ::: "memory"); __builtin_amdgcn_s_barrier(); asm volatile("" ::: "memory");
        const int t = (wr * 4 + wc) * 64 + fq * 16 + fr;
        if (t < 256) { const f32x4 p0 = *(const LAS f32x4*)(red + t * 8), p1 = *(const LAS f32x4*)(red + t * 8 + 4);
            *(f32x2*)(SLw + ((size_t)u.pm * BM + t) * 8 + u.pn * 2) = (f32x2){(p0[0] + p0[2]) + (p1[0] + p1[2]), (p0[1] + p0[3]) + (p1[1] + p1[3])}; }
    }
};
template <int ACT> struct EpiStoreLN {
    static constexpr bool PERM = true;
    bf16_t* C; int ldc; int ncols; float scale; const float* SLr; const float* CS; const float* CB;
    __device__ __forceinline__ void operator()(const Acc& acc, const Unit& u, int wr, int wc, int fr, int fq) const {
        asm volatile("" : "+v"(fr), "+v"(fq));
        const int row0 = u.pm * BM + wr * 64 + fr, col0 = u.pn * BM + wc * 32 + 8 * fq;
        f32x4 cs[2][2], cbv[2][2];
#pragma unroll
        for (int bj = 0; bj < 2; ++bj) { const int c = col0 + bj * HALF; cs[bj][0] = *(const f32x4*)(CS + c); cs[bj][1] = *(const f32x4*)(CS + c + 4); cbv[bj][0] = *(const f32x4*)(CB + c); cbv[bj][1] = *(const f32x4*)(CB + c + 4); }
        f32x4 sna = *(const f32x4*)(SLr + (size_t)row0 * 8), snb = *(const f32x4*)(SLr + (size_t)row0 * 8 + 4);
#pragma unroll
        for (int i = 0; i < 8; ++i) { const int ai = i >> 2, m = i & 3; const size_t row = (size_t)(row0 + ai * HALF + m * 16);
            const float S = (sna[0] + sna[2]) + (snb[0] + snb[2]), Q = (sna[1] + sna[3]) + (snb[1] + snb[3]); const float mu = S * (1.f / D_), rs = rsqrtf(fmaxf(Q * (1.f / D_) - mu * mu, 0.f) + LN_EPS);
            if (i < 7) { const size_t rown = (size_t)(row0 + ((i + 1) >> 2) * HALF + ((i + 1) & 3) * 16); sna = *(const f32x4*)(SLr + rown * 8); snb = *(const f32x4*)(SLr + rown * 8 + 4); }
            bf16_t* rowp = C + row * ldc + col0;
#pragma unroll
            for (int bj = 0; bj < 2; ++bj) { const int c = col0 + bj * HALF;
                f32x4 v0 = (acc[ai][bj][m][0] - cs[bj][0] * mu) * rs + cbv[bj][0], v1 = (acc[ai][bj][m][1] - cs[bj][1] * mu) * rs + cbv[bj][1];
                if (ACT == 1) {
#pragma unroll
                    for (int e = 0; e < 4; ++e) { float a0 = fmaxf(v0[e], 0.f), a1 = fmaxf(v1[e], 0.f); v0[e] = a0 * a0; v1[e] = a1 * a1; } }
                v0 = v0 * scale; v1 = v1 * scale;
                u32x4 w; w.x = pk2(v0[0], v0[1]); w.y = pk2(v0[2], v0[3]); w.z = pk2(v1[0], v1[1]); w.w = pk2(v1[2], v1[3]);
                if (c < ncols) *(u32x4*)(rowp + bj * HALF) = w; }
            asm volatile("" ::: "memory"); }
    }
};

template <class Epi>
__device__ __forceinline__ void gemm_phase(LAS unsigned char* lds, const Gemm g, const Sched& S, const Epi& E) {
    constexpr bool ALIGN_EPI = true;
    const int tid = ltid(), wid = __builtin_amdgcn_readfirstlane(tid >> 6), lane = tid & 63, wr = wid >> 2, wc = wid & 3, fr = lane & 15, fq = lane >> 4;
    int K_ = g.K; asm volatile("" : "+s"(K_)); const int K = K_, nt = K / BK;
    unsigned voffA[2], voffB[2];
#pragma unroll
    for (int i = 0; i < 2; ++i) { int R, C; stage_rc(tid * 16 + i * 8192, R, C); const int Rb = Epi::PERM ? ((R & ~31) + perm32(R & 31)) : R;
        voffA[i] = (unsigned)(R * g.lda + C) * 2u; voffB[i] = (unsigned)(Rb * g.ldb + C) * 2u; }
    const size_t kstep = (size_t)(BK * 2);
    const size_t hstepA = (size_t)HALF * g.lda * 2, hstepB = (size_t)HALF * g.ldb * 2;
    const unsigned ldsw = (unsigned)wid * 1024u;
    const int aoff = lds_byte(wr * 64 + fr, fq * 8), boff = lds_byte(wc * 32 + fr, fq * 8);
#define PG8_UA(u) ((const char*)g.A + ((size_t)(u).b1 * g.aS1 + (size_t)(u).b2 * g.aS2 + (size_t)(u).pm * BM * g.lda) * 2)
#define PG8_UB(u) ((const char*)g.Bt + ((size_t)(u).b1 * g.bS1 + (size_t)(u).b2 * g.bS2 + (size_t)(u).pn * BM * g.ldb) * 2)
#define PG8_SA(b, h) (((b) * 2 + (h)) * HTB)
#define PG8_SB(b, h) ((4 + (b) * 2 + (h)) * HTB)
#define PG8_STAGE(bufoff, gbase, voff) do { _Pragma("unroll") for (int _i = 0; _i < 2; ++_i) \
        __builtin_amdgcn_global_load_lds((const unsigned*)((const char*)(gbase) + (voff)[_i]), (LAS unsigned*)(lds + (bufoff) + ldsw + _i * 8192), 16, 0, 0); } while (0)
#define PG8_LDA(dst, b, h) do { _Pragma("unroll") for (int m = 0; m < 4; ++m) _Pragma("unroll") for (int k = 0; k < 2; ++k) dst[m][k] = *(const LAS bf16x8*)(lds + PG8_SA(b, h) + aoff + m * 2048 + k * 1024); } while (0)
#define PG8_LDB(dst, b, h) do { _Pragma("unroll") for (int n = 0; n < 2; ++n) _Pragma("unroll") for (int k = 0; k < 2; ++k) dst[n][k] = *(const LAS bf16x8*)(lds + PG8_SB(b, h) + boff + n * 2048 + k * 1024); } while (0)
#define PG8_MMA(ai, bj, At, Bt) do { __builtin_amdgcn_s_setprio(1); _Pragma("unroll") for (int m = 0; m < 4; ++m) _Pragma("unroll") for (int n = 0; n < 2; ++n) _Pragma("unroll") for (int k = 0; k < 2; ++k) \
        acc[ai][bj][m][n] = __builtin_amdgcn_mfma_f32_16x16x32_bf16(Bt[n][k], At[m][k], acc[ai][bj][m][n], 0, 0, 0); __builtin_amdgcn_s_setprio(0); } while (0)
#define PG8_WAIT_V(n) asm volatile("s_waitcnt vmcnt(" #n ")" ::: "memory")
#define PG8_WAIT_L(n) asm volatile("s_waitcnt lgkmcnt(" #n ")" ::: "memory")
#define PG8_BAR __builtin_amdgcn_s_barrier()
#define PG8_SCHED __builtin_amdgcn_sched_barrier(0)
    Unit cur, nxt; int ui = 0;
    if (!S.next(0, cur)) return;
    Acc acc;
#pragma unroll
    for (int a = 0; a < 2; ++a)
#pragma unroll
        for (int b = 0; b < 2; ++b)
#pragma unroll
            for (int m = 0; m < 4; ++m)
#pragma unroll
                for (int n = 0; n < 2; ++n) acc[a][b][m][n] = (f32x4){0.f, 0.f, 0.f, 0.f};
    bf16x8 At[4][2], B0[2][2], B1[2][2];
    const char* cA = PG8_UA(cur); const char* cB = PG8_UB(cur);
    PG8_STAGE(PG8_SB(0, 0), cB, voffB); PG8_STAGE(PG8_SB(0, 1), cB + hstepB, voffB); PG8_STAGE(PG8_SA(0, 0), cA, voffA); PG8_STAGE(PG8_SA(0, 1), cA + hstepA, voffA);
    if (wr == 1) PG8_BAR;
    PG8_WAIT_V(2); PG8_BAR;
    PG8_STAGE(PG8_SB(1, 0), cB + kstep, voffB); PG8_STAGE(PG8_SA(1, 0), cA + kstep, voffA); PG8_STAGE(PG8_SB(1, 1), cB + hstepB + kstep, voffB);
    PG8_WAIT_V(6); PG8_BAR;
    for (;;) {
        const bool has_next = S.next(ui + 1, nxt);
        const char* nA = has_next ? PG8_UA(nxt) : cA; const char* nB = has_next ? PG8_UB(nxt) : cB;
        for (int t = 0; t < nt; t += 2) {
            const bool last = (t == nt - 2);
            const char* a1 = cA + (size_t)(t + 1) * kstep;
            const char* a2 = last ? nA : cA + (size_t)(t + 2) * kstep; const char* b2 = last ? nB : cB + (size_t)(t + 2) * kstep;
            const char* a3 = a2 + kstep; const char* b3 = b2 + kstep;
            PG8_LDB(B0, 0, 0); PG8_LDB(B1, 0, 1); PG8_SCHED; PG8_LDA(At, 0, 0); PG8_STAGE(PG8_SA(1, 1), a1 + hstepA, voffA);
            PG8_WAIT_V(8); PG8_WAIT_L(0); PG8_BAR; PG8_MMA(0, 0, At, B0); PG8_MMA(0, 1, At, B1); PG8_BAR; PG8_SCHED;
            PG8_LDA(At, 0, 1); PG8_STAGE(PG8_SB(0, 0), b2, voffB); PG8_STAGE(PG8_SB(0, 1), b2 + hstepB, voffB); PG8_STAGE(PG8_SA(0, 0), a2, voffA);
            PG8_WAIT_V(8); PG8_WAIT_L(0); PG8_BAR; PG8_MMA(1, 0, At, B0); PG8_MMA(1, 1, At, B1); PG8_BAR; PG8_SCHED;
            PG8_LDB(B0, 1, 0); PG8_LDB(B1, 1, 1); PG8_SCHED; PG8_LDA(At, 1, 0); PG8_STAGE(PG8_SA(0, 1), a2 + hstepA, voffA);
            PG8_WAIT_V(8); PG8_WAIT_L(0); PG8_BAR; PG8_MMA(0, 0, At, B0); PG8_MMA(0, 1, At, B1); PG8_BAR; PG8_SCHED;
            PG8_LDA(At, 1, 1); PG8_STAGE(PG8_SB(1, 0), b3, voffB); PG8_STAGE(PG8_SB(1, 1), b3 + hstepB, voffB); PG8_STAGE(PG8_SA(1, 0), a3, voffA);
            PG8_WAIT_V(8); PG8_WAIT_L(0); PG8_BAR; PG8_MMA(1, 0, At, B0); PG8_MMA(1, 1, At, B1); PG8_BAR; PG8_SCHED;
        }
        if constexpr (ALIGN_EPI) { if (wr == 0) PG8_BAR; }
        E(acc, cur, wr, wc, fr, fq);
        if (!has_next) break;
#pragma unroll
        for (int a = 0; a < 2; ++a)
#pragma unroll
            for (int b = 0; b < 2; ++b)
#pragma unroll
                for (int m = 0; m < 4; ++m)
#pragma unroll
                    for (int n = 0; n < 2; ++n) acc[a][b][m][n] = (f32x4){0.f, 0.f, 0.f, 0.f};
        cur = nxt; cA = nA; cB = nB; ++ui;
        if constexpr (ALIGN_EPI) { if (wr == 1) PG8_BAR; }
    }
    PG8_WAIT_V(0);
    if constexpr (!ALIGN_EPI) { if (wr == 0) PG8_BAR; }
    PG8_BAR;
#undef PG8_UA
#undef PG8_UB
#undef PG8_SA
#undef PG8_SB
#undef PG8_STAGE
#undef PG8_LDA
#undef PG8_LDB
#undef PG8_MMA
#undef PG8_WAIT_V
#undef PG8_WAIT_L
#undef PG8_BAR
#undef PG8_SCHED
}
}

struct Args { const float* in[35]; float* out; unsigned char* ws; int ph_lo, ph_hi, coop, pad; };
enum { I_X = 0, I_MEM, I_LNIN_G, I_LNIN_B, I_WIN, I_RPB, I_CONVW, I_CONVB, I_DTB, I_ALOG, I_SSDD, I_SSDNW, I_LRE, I_LIM, I_LOGDT, I_BRE, I_BIM, I_CRE, I_CIM, I_S5D, I_GLUW, I_GLUB,
       I_WOUT, I_LNMIX_G, I_LNMIX_B, I_WQ, I_WK, I_WV, I_WO, I_LNXA_G, I_LNXA_B, I_W1, I_W2, I_LNMLP_G, I_LNMLP_B };

__device__ __forceinline__ int opq(int i) { asm volatile("" : "+s"(i)); return i; }
__device__ __forceinline__ void transpose_item(const float* W, int K, int N, bf16_t* WT, LAS float* scr, int item, int nblk, int lane, const float* rs) {
    const int kb = item / nblk, nb = item % nblk, k0 = 64 * kb, n0 = 32 * nb;
    const int nn = n0 + (lane & 31);
#pragma unroll
    for (int i = 0; i < 32; ++i) { const int kk = 2 * i + (lane >> 5); scr[kk * 33 + (lane & 31)] = (nn < N) ? W[(size_t)(k0 + kk) * N + nn] * (rs ? rs[k0 + kk] : 1.f) : 0.f; }
    LDS_WAIT();
    const int c = lane & 7;
#pragma unroll
    for (int j = 0; j < 4; ++j) { const int n = (lane >> 3) + 8 * j; const LAS float* s = scr + (8 * c) * 33 + n;
        u32x4 o; o.x = pk2(s[0 * 33], s[1 * 33]); o.y = pk2(s[2 * 33], s[3 * 33]); o.z = pk2(s[4 * 33], s[5 * 33]); o.w = pk2(s[6 * 33], s[7 * 33]);
        *(u32x4*)(WT + (size_t)(n0 + n) * K + k0 + 8 * c) = o; }
    LDS_WAIT();
}
__device__ __forceinline__ void tr_matrix(const float* W, int K, int N, int nblk, bf16_t* WT, LAS float* scr, int gw, int NGW, int lane, const float* rs = nullptr) {
    const int nitems = (K / 64) * nblk;
    for (int it = gw; it < nitems; it += NGW) transpose_item(W, K, N, WT, scr, it, nblk, lane, rs);
}
__device__ __forceinline__ void ln_row(const float* xrow, float* hrow, bf16_t* brow, const float* gam, const float* bet, int lane) {
    const f32x4* xr = (const f32x4*)xrow + lane;
    f32x4 v[4]; float s = 0.f;
#pragma unroll
    for (int j = 0; j < 4; ++j) { v[j] = xr[64 * j]; s += (v[j].x + v[j].y) + (v[j].z + v[j].w); }
    const float mean = wave_sum(s) * (1.f / D_); float s2 = 0.f;
#pragma unroll
    for (int j = 0; j < 4; ++j) { v[j] = v[j] - mean; s2 += (v[j].x * v[j].x + v[j].y * v[j].y) + (v[j].z * v[j].z + v[j].w * v[j].w); }
    const float rstd = rsqrtf(wave_sum(s2) * (1.f / D_) + LN_EPS);
    f32x4* ho = (f32x4*)hrow + lane; u32x2* bo = (u32x2*)brow + lane;
#pragma unroll
    for (int j = 0; j < 4; ++j) { const f32x4 g = ((const f32x4*)gam)[lane + 64 * j], b = ((const f32x4*)bet)[lane + 64 * j];
        const f32x4 y = v[j] * rstd * g + b; ho[64 * j] = y; u32x2 w; w.x = pk2(y.x, y.y); w.y = pk2(y.z, y.w); bo[64 * j] = w; }
}

__device__ __forceinline__ void ln_row2(const float* x0, const float* x1, float* h0, float* h1, bf16_t* b0, bf16_t* b1, const float* gam, const float* bet, int lane) {
    const f32x4* xr0 = (const f32x4*)x0 + lane; const f32x4* xr1 = (const f32x4*)x1 + lane;
    f32x4 v[4], w[4]; float s = 0.f, t = 0.f;
#pragma unroll
    for (int j = 0; j < 4; ++j) { v[j] = xr0[64 * j]; w[j] = xr1[64 * j]; }
#pragma unroll
    for (int j = 0; j < 4; ++j) { s += (v[j].x + v[j].y) + (v[j].z + v[j].w); t += (w[j].x + w[j].y) + (w[j].z + w[j].w); }
#pragma unroll
    for (int o = 1; o < 64; o <<= 1) { s += __shfl_xor(s, o); t += __shfl_xor(t, o); }
    const float m0 = s * (1.f / D_), m1 = t * (1.f / D_); float s2 = 0.f, t2 = 0.f;
#pragma unroll
    for (int j = 0; j < 4; ++j) { v[j] = v[j] - m0; w[j] = w[j] - m1; s2 += (v[j].x * v[j].x + v[j].y * v[j].y) + (v[j].z * v[j].z + v[j].w * v[j].w); t2 += (w[j].x * w[j].x + w[j].y * w[j].y) + (w[j].z * w[j].z + w[j].w * w[j].w); }
#pragma unroll
    for (int o = 1; o < 64; o <<= 1) { s2 += __shfl_xor(s2, o); t2 += __shfl_xor(t2, o); }
    const float r0 = rsqrtf(s2 * (1.f / D_) + LN_EPS), r1 = rsqrtf(t2 * (1.f / D_) + LN_EPS);
    f32x4* ho0 = (f32x4*)h0 + lane; f32x4* ho1 = (f32x4*)h1 + lane; u32x2* bo0 = (u32x2*)b0 + lane; u32x2* bo1 = (u32x2*)b1 + lane;
#pragma unroll
    for (int j = 0; j < 4; ++j) { const f32x4 g = ((const f32x4*)gam)[lane + 64 * j], b = ((const f32x4*)bet)[lane + 64 * j];
        const f32x4 y0 = v[j] * r0 * g + b, y1 = w[j] * r1 * g + b; if (h0) { ho0[64 * j] = y0; ho1[64 * j] = y1; }
        if (b0) { u32x2 p; p.x = pk2(y0.x, y0.y); p.y = pk2(y0.z, y0.w); bo0[64 * j] = p; p.x = pk2(y1.x, y1.y); p.y = pk2(y1.z, y1.w); bo1[64 * j] = p; } }
}
__device__ __forceinline__ void s5_item(const Args& a, LAS unsigned char* lds, int item, int tid) {
    const int j = item & 15, g = (item >> 4) & 15, l = item >> 8;
    LAS f32x2* Ap = (LAS f32x2*)(lds + 73728);
    LAS f32x2* Bb = (LAS f32x2*)(lds + 73728 + 17408);
    LAS f32x2* Cc = (LAS f32x2*)(lds + 73728 + 17408 + 16384);
    for (int e = tid; e < 2 * 17 * 64; e += 512) { const int p = e & 63, d = (e >> 6) % 17, dir = e / (17 * 64);
        const int gi = (l * 2 + dir) * 16 + g; const float dt = expf(gp(a.in[I_LOGDT])[gi]); const float lr = gp(a.in[I_LRE])[gi * 64 + p], li = gp(a.in[I_LIM])[gi * 64 + p];
        const float mag = expf((float)d * lr * dt); const float th = (float)d * (li * dt); Ap[e] = (f32x2){mag * cosf(th), mag * sinf(th)}; }
    for (int e = tid; e < 2 * 64 * 16; e += 512) { const int h = e & 15, p = (e >> 4) & 63, dir = e >> 10;
        const int gi = (l * 2 + dir) * 16 + g; const float dt = expf(gp(a.in[I_LOGDT])[gi]); const float lr = gp(a.in[I_LRE])[gi * 64 + p], li = gp(a.in[I_LIM])[gi * 64 + p];
        const float mag = expf(lr * dt); const float ar = mag * cosf(li * dt), ai = mag * sinf(li * dt); const float den = lr * lr + li * li;
        const float fr = ((ar - 1.f) * lr + ai * li) / den, fi = (ai * lr - (ar - 1.f) * li) / den;
        const float br = gp(a.in[I_BRE])[((size_t)gi * 64 + p) * 16 + h], bi = gp(a.in[I_BIM])[((size_t)gi * 64 + p) * 16 + h];
        Bb[e] = (f32x2){fr * br - fi * bi, fr * bi + fi * br}; }
    for (int e = tid; e < 2 * 16 * 64; e += 512) { const int p = e & 63, h = (e >> 6) & 15, dir = e >> 10;
        const int gi = (l * 2 + dir) * 16 + g; Cc[e] = (f32x2){gp(a.in[I_CRE])[((size_t)gi * 16 + h) * 64 + p], gp(a.in[I_CIM])[((size_t)gi * 16 + h) * 64 + p]}; }
    __syncthreads();
    bf16_t* TM = (bf16_t*)(lptr(a.ws) + WS_TM) + ((size_t)(l * 16 + g) * 256 + j * 16) * 512;
    for (int e = tid; e < 16 * 512; e += 512) { const int k = e & 511, ho = e >> 9; float v = 0.f;
        if (k < 256) { const int i = k >> 4, hi = k & 15;
            if (i <= j) { const int dd = j - i; float s = 0.f;
                for (int p = 0; p < 64; ++p) { const f32x2 c = Cc[(0 * 16 + ho) * 64 + p], ap = Ap[(0 * 17 + dd) * 64 + p], bb = Bb[(0 * 64 + p) * 16 + hi];
                    const float wr_ = c.x * ap.x - c.y * ap.y, wi_ = c.x * ap.y + c.y * ap.x; s += wr_ * bb.x - wi_ * bb.y; }
                v += s; }
            if (i >= j) { const int dd = i - j; float s = 0.f;
                for (int p = 0; p < 64; ++p) { const f32x2 c = Cc[(1 * 16 + ho) * 64 + p], ap = Ap[(1 * 17 + dd) * 64 + p], bb = Bb[(1 * 64 + p) * 16 + hi];
                    const float wr_ = c.x * ap.x - c.y * ap.y, wi_ = c.x * ap.y + c.y * ap.x; s += wr_ * bb.x - wi_ * bb.y; }
                v += s; }
            if (i == j && hi == ho) v += gp(a.in[I_S5D])[l * 256 + g * 16 + ho];
        } else { const int dir = (k >= 384), p = ((k - 256) & 127) >> 1, ri = k & 1; const int dd = dir ? 16 - j : j + 1;
            const f32x2 c = Cc[(dir * 16 + ho) * 64 + p], ap = Ap[(dir * 17 + dd) * 64 + p];
            v = ri ? -(c.x * ap.y + c.y * ap.x) : (c.x * ap.x - c.y * ap.y); }
        TM[(size_t)ho * 512 + k] = (bf16_t)f2bf(v); }
    bf16_t* SM = (bf16_t*)(lptr(a.ws) + WS_SM) + ((size_t)(l * 16 + g) * 256 + j * 16) * 256;
    for (int e = tid; e < 16 * 256; e += 512) { const int k = e & 255, nn = e >> 8, n = j * 16 + nn; const int dir = n >> 7, p = (n & 127) >> 1, ri = n & 1, i = k >> 4, hi = k & 15;
        const int dd = dir ? i : 15 - i; const f32x2 ap = Ap[(dir * 17 + dd) * 64 + p], bb = Bb[(dir * 64 + p) * 16 + hi];
        const float v = ri ? (ap.x * bb.y + ap.y * bb.x) : (ap.x * bb.x - ap.y * bb.y);
        SM[(size_t)nn * 256 + k] = (bf16_t)f2bf(v); }
    if (j == 0 && tid < 128) { const int dir = tid >> 6, p = tid & 63; ((f32x2*)(lptr(a.ws) + WS_MISC))[((l * 2 + dir) * 16 + g) * 64 + p] = Ap[(dir * 17 + 16) * 64 + p]; }
    __syncthreads();
}

__device__ __forceinline__ void prologue(const Args& a, LAS unsigned char* lds, int G) {
    const int tid = ltid(), lane = tid & 63, wave = tid >> 6;
    const int gw = lbid() * 8 + wave, NGW = G * 8;
    LAS float* scr = (LAS float*)(lds + wave * 8448);
    for (int l = 0; l < 2; ++l) {
        unsigned char* wb = lptr(a.ws) + WS_W + l * LWB;
        tr_matrix(gp(a.in[I_WIN]) + (size_t)l * D_ * NP, D_, NP, NPP / 32, (bf16_t*)(wb + OW_IN), scr, gw, NGW, lane, l == 1 ? gp(a.in[I_LNMLP_G]) : nullptr);
        tr_matrix(gp(a.in[I_WOUT]) + (size_t)l * D_ * D_, D_, D_, 32, (bf16_t*)(wb + OW_OUT), scr, gw, NGW, lane);
        tr_matrix(gp(a.in[I_WQ]) + (size_t)l * D_ * D_, D_, D_, 32, (bf16_t*)(wb + OW_Q), scr, gw, NGW, lane, gp(a.in[I_LNMIX_G]) + l * D_);
        tr_matrix(gp(a.in[I_WK]) + (size_t)l * D_ * D_, D_, D_, 32, (bf16_t*)(wb + OW_K), scr, gw, NGW, lane);
        tr_matrix(gp(a.in[I_WV]) + (size_t)l * D_ * D_, D_, D_, 32, (bf16_t*)(wb + OW_V), scr, gw, NGW, lane);
        tr_matrix(gp(a.in[I_WO]) + (size_t)l * D_ * D_, D_, D_, 32, (bf16_t*)(wb + OW_O), scr, gw, NGW, lane);
        tr_matrix(gp(a.in[I_W1]) + (size_t)l * D_ * FF_, D_, FF_, 128, (bf16_t*)(wb + OW_1), scr, gw, NGW, lane, gp(a.in[I_LNXA_G]) + l * D_);
        tr_matrix(gp(a.in[I_W2]) + (size_t)l * FF_ * D_, FF_, D_, 32, (bf16_t*)(wb + OW_2), scr, gw, NGW, lane);
        tr_matrix(gp(a.in[I_GLUW]) + (size_t)l * 256 * 256, 256, 256, 8, (bf16_t*)(wb + OW_GLU), scr, gw, NGW, lane);
    }
    { const int gt = lbid() * 512 + tid, NT = G * 512; const f32x4* src = (const f32x4*)gp(a.in[I_MEM]); u32x2* dst = (u32x2*)(lptr(a.ws) + WS_MEMB);
      for (int i = gt; i < B_ * MEMT * D_ / 4; i += NT) { const f32x4 v = src[i]; u32x2 w; w.x = pk2(v.x, v.y); w.y = pk2(v.z, v.w); dst[i] = w; } }
    __syncthreads();
    for (int it = lbid(); it < 512; it += G) s5_item(a, lds, it, tid);
    { const float* X = gp(a.in[I_X]); float* H = lptr(a.out); bf16_t* HBp = (bf16_t*)(lptr(a.ws) + WS_HB);
      for (int m = gw; m < M_ / 2; m += NGW) { const size_t r0 = (size_t)m * D_, r1 = (size_t)(m + M_ / 2) * D_;
          ln_row2(X + r0, X + r1, (float*)nullptr, (float*)nullptr, HBp + r0, HBp + r1, gp(a.in[I_LNIN_G]), gp(a.in[I_LNIN_B]), lane); } }
}


__device__ __forceinline__ float* cs_ptr(unsigned char* ws, int l, int set) {
    float* base = (float*)(ws + WS_MISC + MISC_CS) + (size_t)l * 16384;
    return base + (set == 0 ? 0 : set == 1 ? 2048 : 10240);
}
__device__ __forceinline__ void colsum_set(const bf16_t* WT, int N, const float* gam, const float* bet, float* CS, int gw, int NGW, int lane) {
    for (int n = gw; n < N; n += NGW) { const bf16_t* r = WT + (size_t)n * D_; float s = 0.f, c = 0.f;
#pragma unroll
        for (int j = 0; j < 2; ++j) { const int k = (lane + 64 * j) * 8; const u32x4 v = *(const u32x4*)(r + k);
            const f32x4 g0 = *(const f32x4*)(gam + k), g1 = *(const f32x4*)(gam + k + 4), b0 = *(const f32x4*)(bet + k), b1 = *(const f32x4*)(bet + k + 4);
            const float w[8] = {bflo(v.x), bfhi(v.x), bflo(v.y), bfhi(v.y), bflo(v.z), bfhi(v.z), bflo(v.w), bfhi(v.w)};
            s += ((w[0] + w[1]) + (w[2] + w[3])) + ((w[4] + w[5]) + (w[6] + w[7]));
            c += w[0] * (b0[0] / g0[0]) + w[1] * (b0[1] / g0[1]) + w[2] * (b0[2] / g0[2]) + w[3] * (b0[3] / g0[3]) + w[4] * (b1[0] / g1[0]) + w[5] * (b1[1] / g1[1]) + w[6] * (b1[2] / g1[2]) + w[7] * (b1[3] / g1[3]); }
        s = wave_sum(s); c = wave_sum(c);
        if (lane == 0) { CS[n] = s; CS[N + n] = c; } }
}
__device__ __forceinline__ void colsum_phase(const Args& a, int G) {
    const int tid = ltid(), lane = tid & 63, gw = lbid() * 8 + (tid >> 6), NGW = G * 8;
    unsigned char* ws = lptr(a.ws);
    for (int l = 0; l < 2; ++l) { unsigned char* wb = ws + WS_W + (size_t)l * LWB;
        colsum_set((const bf16_t*)(wb + OW_Q), D_, gp(a.in[I_LNMIX_G]) + l * D_, gp(a.in[I_LNMIX_B]) + l * D_, cs_ptr(ws, l, 0), gw, NGW, lane);
        colsum_set((const bf16_t*)(wb + OW_1), FF_, gp(a.in[I_LNXA_G]) + l * D_, gp(a.in[I_LNXA_B]) + l * D_, cs_ptr(ws, l, 1), gw, NGW, lane);
        if (l == 1) colsum_set((const bf16_t*)(wb + OW_IN), NPP, gp(a.in[I_LNMLP_G]), gp(a.in[I_LNMLP_B]), cs_ptr(ws, l, 2), gw, NGW, lane); }
}
__device__ __forceinline__ void na_phase(const bf16_t* PROJ, bf16_t* MIXED, const float* rpb, int G) {
    const int tid = ltid();
    for (int it = lbid(); it < 512; it += G) {
        const int h = it & 3, rg = (it >> 2) & 15, b = it >> 6;
        const int r = rg * 8 + (tid >> 6), c = tid & 63;
        const size_t row = (size_t)b * T_ + r * 64 + c;
        float q[64], o[64];
        { const u32x4* qp = (const u32x4*)(PROJ + row * NP + PQ + h * 64);
#pragma unroll
          for (int i = 0; i < 8; ++i) { const u32x4 v = qp[i]; q[8 * i + 0] = bflo(v.x) * 0.125f; q[8 * i + 1] = bfhi(v.x) * 0.125f; q[8 * i + 2] = bflo(v.y) * 0.125f; q[8 * i + 3] = bfhi(v.y) * 0.125f;
              q[8 * i + 4] = bflo(v.z) * 0.125f; q[8 * i + 5] = bfhi(v.z) * 0.125f; q[8 * i + 6] = bflo(v.w) * 0.125f; q[8 * i + 7] = bfhi(v.w) * 0.125f; } }
#pragma unroll
        for (int d = 0; d < 64; ++d) o[d] = 0.f;
        const int r0 = min(max(r - 4, 0), 120), c0 = min(max(c - 8, 0), 48);
        float mx = -1e30f, lsum = 0.f;
        const float* rp = rpb + h * 15 * 31;
#pragma unroll 1
        for (int kk = 0; kk < 128; ++kk) {
            const int kr = kk >> 4, kc = kk & 15;
            const int krow = r0 + kr;
            const bf16_t* kptr = PROJ + ((size_t)b * T_ + krow * 64 + c0 + kc) * NP + PK + h * 64;
            const u32x4* kp = (const u32x4*)kptr; float acc = 0.f;
#pragma unroll
            for (int i = 0; i < 8; ++i) { const u32x4 v = kp[i];
                acc += q[8 * i + 0] * bflo(v.x) + q[8 * i + 1] * bfhi(v.x) + q[8 * i + 2] * bflo(v.y) + q[8 * i + 3] * bfhi(v.y)
                     + q[8 * i + 4] * bflo(v.z) + q[8 * i + 5] * bfhi(v.z) + q[8 * i + 6] * bflo(v.w) + q[8 * i + 7] * bfhi(v.w); }
            int dc = c0 + kc - c; dc = min(max(dc, -15), 15);
            const float sc = acc + rp[(krow - r + 7) * 31 + dc + 15];
            if (sc > mx) { const float al = __expf(mx - sc); mx = sc; lsum *= al;
#pragma unroll
                for (int d = 0; d < 64; ++d) o[d] *= al; }
            const float p = __expf(sc - mx); lsum += p; const u32x4* vp = (const u32x4*)(kptr + (PV - PK));
#pragma unroll
            for (int i = 0; i < 8; ++i) { const u32x4 v = vp[i];
                o[8 * i + 0] += p * bflo(v.x); o[8 * i + 1] += p * bfhi(v.x); o[8 * i + 2] += p * bflo(v.y); o[8 * i + 3] += p * bfhi(v.y);
                o[8 * i + 4] += p * bflo(v.z); o[8 * i + 5] += p * bfhi(v.z); o[8 * i + 6] += p * bflo(v.w); o[8 * i + 7] += p * bfhi(v.w); }
        }
        const float inv = 1.f / lsum; u32x4* op = (u32x4*)(MIXED + row * D_ + h * 64);
#pragma unroll
        for (int i = 0; i < 8; ++i) { u32x4 w; w.x = pk2(o[8 * i] * inv, o[8 * i + 1] * inv); w.y = pk2(o[8 * i + 2] * inv, o[8 * i + 3] * inv); w.z = pk2(o[8 * i + 4] * inv, o[8 * i + 5] * inv); w.w = pk2(o[8 * i + 6] * inv, o[8 * i + 7] * inv); op[i] = w; }
    }
}

__device__ __forceinline__ void conv_phase(const bf16_t* PROJ, bf16_t* CONV, const float* cw, const float* cb, int G) {
    const int gt = lbid() * 512 + ltid(), NT = G * 512;
    for (int idx = gt; idx < (M_ / 8) * 96; idx += NT) { const int rb = idx / 96, ch = (idx - rb * 96) * 8, row0 = rb * 8, t0 = row0 & (T_ - 1);
        u32x4 x[12];
#pragma unroll
        for (int i = 0; i < 12; ++i) { const int tt = t0 + i - 2; x[i] = (tt >= 0 && tt < T_) ? *(const u32x4*)(PROJ + (size_t)(row0 + i - 2) * NP + PX + ch) : (u32x4){0u, 0u, 0u, 0u}; }
        float w[5][8], bias[8];
#pragma unroll
        for (int jj = 0; jj < 5; ++jj) { const f32x4 w0 = *(const f32x4*)(cw + jj * 768 + ch), w1 = *(const f32x4*)(cw + jj * 768 + ch + 4);
            w[jj][0] = w0[0]; w[jj][1] = w0[1]; w[jj][2] = w0[2]; w[jj][3] = w0[3]; w[jj][4] = w1[0]; w[jj][5] = w1[1]; w[jj][6] = w1[2]; w[jj][7] = w1[3]; }
        { const f32x4 b0 = *(const f32x4*)(cb + ch), b1 = *(const f32x4*)(cb + ch + 4); bias[0] = b0[0]; bias[1] = b0[1]; bias[2] = b0[2]; bias[3] = b0[3]; bias[4] = b1[0]; bias[5] = b1[1]; bias[6] = b1[2]; bias[7] = b1[3]; }
#pragma unroll
        for (int o = 0; o < 8; ++o) { float acc[8];
#pragma unroll
            for (int e = 0; e < 8; ++e) acc[e] = bias[e];
#pragma unroll
            for (int jj = 0; jj < 5; ++jj) { const u32x4 v = x[o + jj];
                acc[0] += w[jj][0] * bflo(v.x); acc[1] += w[jj][1] * bfhi(v.x); acc[2] += w[jj][2] * bflo(v.y); acc[3] += w[jj][3] * bfhi(v.y);
                acc[4] += w[jj][4] * bflo(v.z); acc[5] += w[jj][5] * bfhi(v.z); acc[6] += w[jj][6] * bflo(v.w); acc[7] += w[jj][7] * bfhi(v.w); }
            u32x4 r; r.x = pk2(silu_f(acc[0]), silu_f(acc[1])); r.y = pk2(silu_f(acc[2]), silu_f(acc[3])); r.z = pk2(silu_f(acc[4]), silu_f(acc[5])); r.w = pk2(silu_f(acc[6]), silu_f(acc[7]));
            *(u32x4*)(CONV + (size_t)(row0 + o) * 768 + ch) = r; } }
}
__device__ __forceinline__ void s5_gather_phase(const bf16_t* PROJ, bf16_t* UX, int G) {
    const int gt = lbid() * 512 + ltid(), NT = G * 512;
    for (int idx = gt; idx < M_ * 32; idx += NT) { const int row = idx >> 5, part = idx & 31, g = part >> 1, hf = part & 1, b = row >> 13, t = row & (T_ - 1), c = t >> 4, i = t & 15;
        const u32x4 v = *(const u32x4*)(PROJ + (size_t)row * NP + PU + g * 16 + hf * 8);
        *(u32x4*)(UX + ((size_t)g * 4096 + b * 512 + c) * 512 + i * 16 + hf * 8) = v; }
}

__device__ __forceinline__ float softplus_f(float x) { return x > 20.f ? x : log1pf(expf(x)); }

__device__ __forceinline__ void ssd_passA(const Args& a, int l, LAS unsigned char* lds, int G) {
    const bf16_t* PROJ = (const bf16_t*)(lptr(a.ws) + WS_PROJ); const bf16_t* CONV = (const bf16_t*)(lptr(a.ws) + WS_CONV);
    float* ST = (float*)(lptr(a.ws) + WS_ST); float* CD = (float*)(lptr(a.ws) + WS_MISC + 65536);
    const int tid = ltid(), sub = tid & 255, dir = tid >> 8, p = sub >> 2, nq = sub & 3;
    LAS float* dts = (LAS float*)lds; LAS float* dAs = dts + 256;
    for (int it = lbid(); it < 4096; it += G) {
        const int hd = it & 7, c = (it >> 3) & 63, b = it >> 9, g = hd >> 2;
        if (sub < 128) { const int s = sub; const size_t row = (size_t)b * T_ + c * 128 + s;
            const float raw = bf2f(PROJ[row * NP + PDT + dir * 8 + hd]); const float dt = softplus_f(raw + gp(a.in[I_DTB])[(l * 2 + dir) * 8 + hd]);
            const float av = -expf(gp(a.in[I_ALOG])[(l * 2 + dir) * 8 + hd]); dts[dir * 128 + s] = dt; dAs[dir * 128 + s] = expf(dt * av); }
        __syncthreads();
        float h[16];
#pragma unroll
        for (int j = 0; j < 16; ++j) h[j] = 0.f;
        float cdp = 1.f;
        for (int ss = 0; ss < 128; ++ss) { const int s = dir ? 127 - ss : ss; const size_t row = (size_t)b * T_ + c * 128 + s;
            const float dA = dAs[dir * 128 + s], dtv = dts[dir * 128 + s];
            const float xv = bf2f(CONV[row * 768 + hd * 64 + p]) * dtv;
            const u32x4* bp = (const u32x4*)(CONV + row * 768 + 512 + g * 64 + nq * 16); const u32x4 b0 = bp[0], b1 = bp[1];
            const unsigned bw[8] = {b0.x, b0.y, b0.z, b0.w, b1.x, b1.y, b1.z, b1.w};
#pragma unroll
            for (int j = 0; j < 8; ++j) { h[2 * j] = h[2 * j] * dA + xv * bflo(bw[j]); h[2 * j + 1] = h[2 * j + 1] * dA + xv * bfhi(bw[j]); }
            cdp *= dA; }
        float* sp = ST + ((((size_t)(b * 64 + c) * 8 + hd) * 2 + dir) * 64 + p) * 64 + nq * 16;
#pragma unroll
        for (int j = 0; j < 4; ++j) ((f32x4*)sp)[j] = (f32x4){h[4 * j], h[4 * j + 1], h[4 * j + 2], h[4 * j + 3]};
        if (sub == 0) CD[((b * 64 + c) * 8 + hd) * 2 + dir] = cdp;
        __syncthreads();
    }
}
__device__ __forceinline__ void ssd_scan(const Args& a, int G) {
    float* ST = (float*)(lptr(a.ws) + WS_ST); const float* CD = (const float*)(lptr(a.ws) + WS_MISC + 65536);
    const int gt = lbid() * 512 + ltid(), NT = G * 512;
    for (int e = gt; e < 8 * 8 * 2 * 4096; e += NT) { const int pn = e & 4095, dir = (e >> 12) & 1, hd = (e >> 13) & 7, b = e >> 16;
        float H = 0.f;
#pragma unroll 8
        for (int cc = 0; cc < 64; ++cc) { const int c = dir ? 63 - cc : cc; const size_t idx = (((size_t)(b * 64 + c) * 8 + hd) * 2 + dir);
            const float tmp = ST[idx * 4096 + pn]; ST[idx * 4096 + pn] = H; H = H * CD[idx] + tmp; } }
}
__device__ __forceinline__ void ssd_passC(const Args& a, int l, LAS unsigned char* lds, int G) {
    const bf16_t* PROJ = (const bf16_t*)(lptr(a.ws) + WS_PROJ); const bf16_t* CONV = (const bf16_t*)(lptr(a.ws) + WS_CONV); bf16_t* MIXED = (bf16_t*)(lptr(a.ws) + WS_MIXED);
    const float* ST = (const float*)(lptr(a.ws) + WS_ST);
    const int tid = ltid(), sub = tid & 255, half = tid >> 8, p = sub >> 2, nq = sub & 3;
    LAS float* dts = (LAS float*)lds + half * 512; LAS float* dAs = dts + 256;
    LAS float* yl = (LAS float*)(lds + 8192) + half * 8192;
    for (int it = lbid(); it < 2048; it += G) {
        const int hp = it & 3, c = (it >> 2) & 63, b = it >> 8, hd = hp * 2 + half, g = hd >> 2;
        { const int dir = sub >> 7, s = sub & 127; const size_t row = (size_t)b * T_ + c * 128 + s;
          const float raw = bf2f(PROJ[row * NP + PDT + dir * 8 + hd]); const float dt = softplus_f(raw + gp(a.in[I_DTB])[(l * 2 + dir) * 8 + hd]);
          const float av = -expf(gp(a.in[I_ALOG])[(l * 2 + dir) * 8 + hd]); dts[dir * 128 + s] = dt; dAs[dir * 128 + s] = expf(dt * av); }
        __syncthreads();
#pragma unroll 1
        for (int dir = 0; dir < 2; ++dir) {
            float h[16];
            const float* sp = ST + ((((size_t)(b * 64 + c) * 8 + hd) * 2 + dir) * 64 + p) * 64 + nq * 16;
#pragma unroll
            for (int j = 0; j < 4; ++j) { const f32x4 v = ((const f32x4*)sp)[j]; h[4 * j] = v.x; h[4 * j + 1] = v.y; h[4 * j + 2] = v.z; h[4 * j + 3] = v.w; }
#pragma unroll 2
            for (int ss = 0; ss < 128; ++ss) { const int s = dir ? 127 - ss : ss; const size_t row = (size_t)b * T_ + c * 128 + s;
                const float dA = dAs[dir * 128 + s], dtv = dts[dir * 128 + s];
                const float xv = bf2f(CONV[row * 768 + hd * 64 + p]) * dtv;
                const u32x4* bp = (const u32x4*)(CONV + row * 768 + 512 + g * 64 + nq * 16); const u32x4 b0 = bp[0], b1 = bp[1];
                const u32x4* cp = (const u32x4*)(CONV + row * 768 + 640 + g * 64 + nq * 16); const u32x4 c0 = cp[0], c1 = cp[1];
                const unsigned bw[8] = {b0.x, b0.y, b0.z, b0.w, b1.x, b1.y, b1.z, b1.w}; const unsigned cw[8] = {c0.x, c0.y, c0.z, c0.w, c1.x, c1.y, c1.z, c1.w};
                float y = 0.f;
#pragma unroll
                for (int j = 0; j < 8; ++j) { h[2 * j] = h[2 * j] * dA + xv * bflo(bw[j]); h[2 * j + 1] = h[2 * j + 1] * dA + xv * bfhi(bw[j]);
                    y += h[2 * j] * bflo(cw[j]) + h[2 * j + 1] * bfhi(cw[j]); }
                y += __shfl_xor(y, 1); y += __shfl_xor(y, 2);
                if (nq == 0) { if (dir == 0) yl[s * 64 + p] = y; else yl[s * 64 + p] += y; } }
        }
        __syncthreads();
        const float dsk = gp(a.in[I_SSDD])[l * 8 + hd];
        for (int e = sub; e < 128 * 64; e += 256) { const int s = e >> 6, pp = e & 63; const size_t row = (size_t)b * T_ + c * 128 + s;
            const float xs = bf2f(CONV[row * 768 + hd * 64 + pp]), z = bf2f(PROJ[row * NP + PZ + hd * 64 + pp]);
            const float yv = (yl[e] + dsk * xs) * silu_f(z);
            MIXED[row * D_ + 256 + hd * 64 + pp] = (bf16_t)f2bf(yv); }
        __syncthreads();
    }
}
__device__ __forceinline__ void ssd_norm(const Args& a, int l, int G) {
    bf16_t* MIXED = (bf16_t*)(lptr(a.ws) + WS_MIXED); const float* nw = gp(a.in[I_SSDNW]) + l * 512;
    const int tid = ltid(), lane = tid & 63, gw = lbid() * 8 + (tid >> 6), NGW = G * 8;
    for (int m = gw; m < M_; m += NGW) { u32x4* p = (u32x4*)(MIXED + (size_t)m * D_ + 256) + lane; const u32x4 v = *p;
        float x[8] = {bflo(v.x), bfhi(v.x), bflo(v.y), bfhi(v.y), bflo(v.z), bfhi(v.z), bflo(v.w), bfhi(v.w)}; float s = 0.f;
#pragma unroll
        for (int e = 0; e < 8; ++e) s += x[e] * x[e];
        const float r = rsqrtf(wave_sum(s) * (1.f / 512.f) + LN_EPS); const f32x4 w0 = ((const f32x4*)nw)[2 * lane], w1 = ((const f32x4*)nw)[2 * lane + 1];
        u32x4 o; o.x = pk2(x[0] * r * w0.x, x[1] * r * w0.y); o.y = pk2(x[2] * r * w0.z, x[3] * r * w0.w); o.z = pk2(x[4] * r * w1.x, x[5] * r * w1.y); o.w = pk2(x[6] * r * w1.z, x[7] * r * w1.w);
        *p = o; }
}
__device__ __forceinline__ void s5_scan(const Args& a, int l, int G) {
    const int tid = ltid(); if (tid >= 64) return;
    const int p = tid; const float* S5S = (const float*)(lptr(a.ws) + WS_S5S); bf16_t* UX = (bf16_t*)(lptr(a.ws) + WS_UX);
    for (int it = lbid(); it < 256; it += G) { const int g = it & 15, b = (it >> 4) & 7, dir = it >> 7;
        const f32x2 A16 = ((const f32x2*)(lptr(a.ws) + WS_MISC))[((l * 2 + dir) * 16 + g) * 64 + p];
        float xr = 0.f, xi = 0.f;
#pragma unroll 1
        for (int cb = 0; cb < 512; cb += 16) { f32x2 s[16];
#pragma unroll
            for (int k = 0; k < 16; ++k) { const int cc = cb + k, c = dir ? 511 - cc : cc; const size_t row = (size_t)g * 4096 + b * 512 + c; s[k] = *(const f32x2*)(S5S + row * 256 + dir * 128 + 2 * p); }
#pragma unroll
            for (int k = 0; k < 16; ++k) { const int cc = cb + k, c = dir ? 511 - cc : cc; const size_t row = (size_t)g * 4096 + b * 512 + c;
                *(unsigned*)(UX + row * 512 + 256 + dir * 128 + 2 * p) = pk2(xr, xi);
                const float nr = A16.x * xr - A16.y * xi + s[k].x, ni = A16.x * xi + A16.y * xr + s[k].y; xr = nr; xi = ni; } } }
}

#define MFMA16(A, B, C) __builtin_amdgcn_mfma_f32_16x16x32_bf16(A, B, C, 0, 0, 0)
constexpr int SSD_WAVE_LDS = 19456, SSD_XS = 66, SSD_MS = 72;
__device__ __forceinline__ bf16x8 ld_frag_strided(const LAS bf16_t* T, int LS, int s0, int x) {
    bf16x8 f;
#pragma unroll
    for (int j = 0; j < 8; ++j) f[j] = (short)T[(s0 + j) * LS + x];
    return f;
}
__device__ __forceinline__ void ssd_tables(const Args& a, int l, const bf16_t* PROJ, size_t row0, int hd, int dir, int lane, float& dt, float& cum, float& tot) {
    const float raw = bf2f(PROJ[(row0 + lane) * NP + PDT + dir * 8 + hd]);
    dt = softplus_f(raw + gp(a.in[I_DTB])[(l * 2 + dir) * 8 + hd]);
    const float av = -expf(gp(a.in[I_ALOG])[(l * 2 + dir) * 8 + hd]);
    const float e = dt * av; float ps = e;
#pragma unroll
    for (int o = 1; o < 64; o <<= 1) { const float t = __shfl_up(ps, o); if (lane >= o) ps += t; }
    tot = __shfl(ps, 63);
    cum = dir ? (tot - ps + e) : ps;
}
__device__ __forceinline__ void ssd_passA2(const Args& a, int l, LAS unsigned char* lds, int G) {
    const bf16_t* PROJ = (const bf16_t*)(lptr(a.ws) + WS_PROJ); const bf16_t* CONV = (const bf16_t*)(lptr(a.ws) + WS_CONV);
    bf16_t* ST = (bf16_t*)(lptr(a.ws) + WS_ST); float* CD = (float*)(lptr(a.ws) + WS_MISC + 65536);
    const int tid = ltid(), lane = tid & 63, wave = tid >> 6, fr = lane & 15, fq = lane >> 4, hd = wave, g4 = hd >> 2;
    LAS bf16_t* Xl = (LAS bf16_t*)(lds + wave * SSD_WAVE_LDS); LAS bf16_t* Bl = Xl + 64 * SSD_XS; LAS float* tab = (LAS float*)(lds + wave * SSD_WAVE_LDS + 17664);
    for (int it = lbid(); it < 8 * 128 * 2; it += G) { const int dir = it & 1, c = (it >> 1) & 127, b = it >> 8;
        const size_t row0 = (size_t)b * T_ + c * 64;
        u32x4 xv[8], bv[8];
#pragma unroll
        for (int i = 0; i < 8; ++i) { const int q = lane + 64 * i, s = q >> 3, pc = (q & 7) * 8;
            xv[i] = *(const u32x4*)(CONV + (row0 + s) * 768 + hd * 64 + pc); bv[i] = *(const u32x4*)(CONV + (row0 + s) * 768 + 512 + g4 * 64 + pc); }
        float dt, cum, tot; ssd_tables(a, l, PROJ, row0, hd, dir, lane, dt, cum, tot);
        tab[lane] = dt * __expf(tot - cum);
        LDS_WAIT();
#pragma unroll
        for (int i = 0; i < 8; ++i) { const int q = lane + 64 * i, s = q >> 3, pc = (q & 7) * 8; const float w = tab[s];
            const u32x4 v = xv[i]; LAS unsigned* d = (LAS unsigned*)(Xl + s * SSD_XS + pc);
            d[0] = pk2(bflo(v.x) * w, bfhi(v.x) * w); d[1] = pk2(bflo(v.y) * w, bfhi(v.y) * w); d[2] = pk2(bflo(v.z) * w, bfhi(v.z) * w); d[3] = pk2(bflo(v.w) * w, bfhi(v.w) * w);
            const u32x4 vb = bv[i]; LAS unsigned* db = (LAS unsigned*)(Bl + s * SSD_XS + pc);
            db[0] = vb.x; db[1] = vb.y; db[2] = vb.z; db[3] = vb.w; }
        LDS_WAIT();
        f32x4 acc[4][4];
#pragma unroll
        for (int mi = 0; mi < 4; ++mi)
#pragma unroll
            for (int nj = 0; nj < 4; ++nj) acc[mi][nj] = (f32x4){0.f, 0.f, 0.f, 0.f};
#pragma unroll
        for (int ks = 0; ks < 2; ++ks) { bf16x8 af[4], bg[4];
#pragma unroll
            for (int mi = 0; mi < 4; ++mi) af[mi] = ld_frag_strided(Bl, SSD_XS, 32 * ks + 8 * fq, 16 * mi + fr);
#pragma unroll
            for (int nj = 0; nj < 4; ++nj) bg[nj] = ld_frag_strided(Xl, SSD_XS, 32 * ks + 8 * fq, 16 * nj + fr);
#pragma unroll
            for (int mi = 0; mi < 4; ++mi)
#pragma unroll
                for (int nj = 0; nj < 4; ++nj) acc[mi][nj] = MFMA16(af[mi], bg[nj], acc[mi][nj]); }
        const size_t idx = ((size_t)(b * 128 + c) * 8 + hd) * 2 + dir; bf16_t* sp = ST + idx * 4096;
#pragma unroll
        for (int mi = 0; mi < 4; ++mi)
#pragma unroll
            for (int nj = 0; nj < 4; ++nj) { u32x2 w; w.x = pk2(acc[mi][nj][0], acc[mi][nj][1]); w.y = pk2(acc[mi][nj][2], acc[mi][nj][3]); *(u32x2*)(sp + (16 * nj + fr) * 64 + 16 * mi + 4 * fq) = w; }
        if (lane == 0) CD[idx] = __expf(tot);
        LDS_WAIT();
    }
}
__device__ __forceinline__ void ssd_scan2(const Args& a, int G) {
    unsigned* ST32 = (unsigned*)(lptr(a.ws) + WS_ST); const float* CD = (const float*)(lptr(a.ws) + WS_MISC + 65536);
    const int gt = lbid() * 512 + ltid(), NT = G * 512;
    for (int e = gt; e < 8 * 8 * 2 * 2048; e += NT) { const int pn2 = e & 2047, dir = (e >> 11) & 1, hd = (e >> 12) & 7, b = e >> 15;
        float H0 = 0.f, H1 = 0.f;
#pragma unroll 1
        for (int cb = 0; cb < 128; cb += 16) { unsigned v[16]; float cd[16];
#pragma unroll
            for (int k = 0; k < 16; ++k) { const int cc = cb + k, c = dir ? 127 - cc : cc; const size_t idx = ((size_t)(b * 128 + c) * 8 + hd) * 2 + dir; v[k] = ST32[idx * 2048 + pn2]; cd[k] = CD[idx]; }
#pragma unroll
            for (int k = 0; k < 16; ++k) { const int cc = cb + k, c = dir ? 127 - cc : cc; const size_t idx = ((size_t)(b * 128 + c) * 8 + hd) * 2 + dir;
                ST32[idx * 2048 + pn2] = pk2(H0, H1); H0 = H0 * cd[k] + bflo(v[k]); H1 = H1 * cd[k] + bfhi(v[k]); } } }
}
__device__ __forceinline__ void ssd_passC2(const Args& a, int l, LAS unsigned char* lds, int G) {
    const bf16_t* PROJ = (const bf16_t*)(lptr(a.ws) + WS_PROJ); const bf16_t* CONV = (const bf16_t*)(lptr(a.ws) + WS_CONV); bf16_t* MIXED = (bf16_t*)(lptr(a.ws) + WS_MIXED);
    const bf16_t* ST = (const bf16_t*)(lptr(a.ws) + WS_ST);
    const int tid = ltid(), lane = tid & 63, wave = tid >> 6, hd = wave, g4 = hd >> 2;
    LAS bf16_t* Xl = (LAS bf16_t*)(lds + wave * SSD_WAVE_LDS); LAS bf16_t* Ml = (LAS bf16_t*)(lds + wave * SSD_WAVE_LDS + 8448); LAS float* tab = (LAS float*)(lds + wave * SSD_WAVE_LDS + 17664);
    LAS float* ssq = (LAS float*)(lds + 8 * SSD_WAVE_LDS);
    const float dsk = gp(a.in[I_SSDD])[l * 8 + hd];
    for (int it = lbid(); it < 8 * 128; it += G) { const int c = it & 127, b = it >> 7;
        const size_t row0 = (size_t)b * T_ + c * 64;
        f32x4 Y[4][4];
#pragma unroll
        for (int mi = 0; mi < 4; ++mi)
#pragma unroll
            for (int nj = 0; nj < 4; ++nj) Y[mi][nj] = (f32x4){0.f, 0.f, 0.f, 0.f};
        bf16x8 cfr[4][2];
        { int ln_ = lane; asm volatile("" : "+v"(ln_)); const int fr = ln_ & 15, fq = ln_ >> 4;
          u32x4 xv[8]; bf16x8 h0[4][2], h1[4][2];
#pragma unroll
          for (int i = 0; i < 8; ++i) { const int q = ln_ + 64 * i, s = q >> 3, pc = (q & 7) * 8; xv[i] = *(const u32x4*)(CONV + (row0 + s) * 768 + hd * 64 + pc); }
          const bf16_t* hp = ST + (((size_t)(b * 128 + c) * 8 + hd) * 2) * 4096;
#pragma unroll
          for (int t4 = 0; t4 < 4; ++t4) { const bf16_t* cp = CONV + (row0 + 16 * t4 + fr) * 768 + 640 + g4 * 64 + 8 * fq; cfr[t4][0] = *(const bf16x8*)cp; cfr[t4][1] = *(const bf16x8*)(cp + 32);
              const bf16_t* ap = hp + (16 * t4 + fr) * 64 + 8 * fq; h0[t4][0] = *(const bf16x8*)ap; h0[t4][1] = *(const bf16x8*)(ap + 32); h1[t4][0] = *(const bf16x8*)(ap + 4096); h1[t4][1] = *(const bf16x8*)(ap + 4096 + 32); }
          { float dt, cum, tot; ssd_tables(a, l, PROJ, row0, hd, 0, lane, dt, cum, tot); tab[lane] = dt; tab[64 + lane] = cum;
            ssd_tables(a, l, PROJ, row0, hd, 1, lane, dt, cum, tot); tab[128 + lane] = dt; tab[192 + lane] = cum; }
#pragma unroll
          for (int i = 0; i < 8; ++i) { const int q = ln_ + 64 * i, s = q >> 3, pc = (q & 7) * 8; LAS unsigned* d = (LAS unsigned*)(Xl + s * SSD_XS + pc);
              d[0] = xv[i].x; d[1] = xv[i].y; d[2] = xv[i].z; d[3] = xv[i].w; }
          LDS_WAIT();
#pragma unroll
          for (int nj = 0; nj < 4; ++nj) { const float sc0 = __expf(tab[64 + 16 * nj + fr]), sc1 = __expf(tab[192 + 16 * nj + fr]);
#pragma unroll
              for (int mi = 0; mi < 4; ++mi) { f32x4 t = MFMA16(h0[mi][0], cfr[nj][0], ((f32x4){0.f, 0.f, 0.f, 0.f})); t = MFMA16(h0[mi][1], cfr[nj][1], t);
                  f32x4 u = MFMA16(h1[mi][0], cfr[nj][0], ((f32x4){0.f, 0.f, 0.f, 0.f})); u = MFMA16(h1[mi][1], cfr[nj][1], u);
                  Y[mi][nj] += t * sc0 + u * sc1; } } }
        f32x4 Gt[4][4];
#pragma unroll
        for (int mi = 0; mi < 4; ++mi)
#pragma unroll
            for (int nj = 0; nj < 4; ++nj) Gt[mi][nj] = (f32x4){0.f, 0.f, 0.f, 0.f};
        { int ln_ = lane; asm volatile("" : "+v"(ln_)); const int fr = ln_ & 15, fq = ln_ >> 4;
          bf16x8 bfr[4][2];
#pragma unroll
          for (int mi = 0; mi < 4; ++mi) { const bf16_t* bp = CONV + (row0 + 16 * mi + fr) * 768 + 512 + g4 * 64 + 8 * fq; bfr[mi][0] = *(const bf16x8*)bp; bfr[mi][1] = *(const bf16x8*)(bp + 32); }
#pragma unroll
          for (int ks = 0; ks < 2; ++ks)
#pragma unroll
            for (int mi = 0; mi < 4; ++mi)
#pragma unroll
                for (int nj = 0; nj < 4; ++nj) Gt[mi][nj] = MFMA16(bfr[mi][ks], cfr[nj][ks], Gt[mi][nj]); }
        u32x2 ez[4][4];
#pragma unroll
        for (int dir = 0; dir < 2; ++dir) { int ln_ = lane; asm volatile("" : "+v"(ln_)); const int fr = ln_ & 15, fq = ln_ >> 4;
            if (dir == 1) {
#pragma unroll
                for (int nj = 0; nj < 4; ++nj) { const size_t row = row0 + 16 * nj + fr;
#pragma unroll
                    for (int mi = 0; mi < 4; ++mi) { const int p0 = 16 * mi + 4 * fq; ez[mi][nj] = *(const u32x2*)(PROJ + row * NP + PZ + hd * 64 + p0); } } }
#pragma unroll
            for (int nj = 0; nj < 4; ++nj) { const int lq = 16 * nj + fr; const float cl = tab[dir * 128 + 64 + lq];
#pragma unroll
                for (int mi = 0; mi < 4; ++mi) { const f32x4 cs = *(const LAS f32x4*)(tab + dir * 128 + 64 + 16 * mi + 4 * fq), ds = *(const LAS f32x4*)(tab + dir * 128 + 16 * mi + 4 * fq);
                    float v[4];
#pragma unroll
                    for (int r = 0; r < 4; ++r) { const int s = 16 * mi + 4 * fq + r; const bool valid = dir ? (s >= lq) : (s <= lq);
                        v[r] = valid ? Gt[mi][nj][r] * __expf(cl - cs[r]) * ds[r] : 0.f; }
                    u32x2 w; w.x = pk2(v[0], v[1]); w.y = pk2(v[2], v[3]); *(LAS u32x2*)(Ml + lq * SSD_MS + 16 * mi + 4 * fq) = w; } }
            asm volatile("s_waitcnt lgkmcnt(0)" ::: );
#pragma unroll
            for (int ks = 0; ks < 2; ++ks) { bf16x8 af[4], bg[4];
#pragma unroll
                for (int mi = 0; mi < 4; ++mi) af[mi] = ld_frag_strided(Xl, SSD_XS, 32 * ks + 8 * fq, 16 * mi + fr);
#pragma unroll
                for (int nj = 0; nj < 4; ++nj) bg[nj] = *(const LAS bf16x8*)(Ml + (16 * nj + fr) * SSD_MS + 32 * ks + 8 * fq);
#pragma unroll
                for (int mi = 0; mi < 4; ++mi)
#pragma unroll
                    for (int nj = 0; nj < 4; ++nj) Y[mi][nj] = MFMA16(af[mi], bg[nj], Y[mi][nj]); }
            asm volatile("s_waitcnt lgkmcnt(0)" ::: );
        }
        float part[4];
        { int ln_ = lane; asm volatile("" : "+v"(ln_)); const int fr = ln_ & 15, fq = ln_ >> 4;
#pragma unroll
        for (int nj = 0; nj < 4; ++nj) { float ps = 0.f;
#pragma unroll
            for (int mi = 0; mi < 4; ++mi) { const LAS unsigned* xp = (const LAS unsigned*)(Xl + (16 * nj + fr) * SSD_XS + 16 * mi + 4 * fq); u32x2 xs; xs.x = xp[0]; xs.y = xp[1]; const u32x2 zz = ez[mi][nj];
                f32x4 y = Y[mi][nj];
                y[0] = (y[0] + dsk * bflo(xs.x)) * silu_f(bflo(zz.x)); y[1] = (y[1] + dsk * bfhi(xs.x)) * silu_f(bfhi(zz.x));
                y[2] = (y[2] + dsk * bflo(xs.y)) * silu_f(bflo(zz.y)); y[3] = (y[3] + dsk * bfhi(xs.y)) * silu_f(bfhi(zz.y));
                Y[mi][nj] = y; ps += (y[0] * y[0] + y[1] * y[1]) + (y[2] * y[2] + y[3] * y[3]); }
            ps += __shfl_xor(ps, 16); ps += __shfl_xor(ps, 32); part[nj] = ps; }
        if (fq == 0) {
#pragma unroll
            for (int nj = 0; nj < 4; ++nj) ssq[wave * 64 + 16 * nj + fr] = part[nj]; } }
        __syncthreads();
        const float* nw = gp(a.in[I_SSDNW]) + l * 512 + hd * 64;
        { int ln_ = lane; asm volatile("" : "+v"(ln_)); const int fr = ln_ & 15, fq = ln_ >> 4;
#pragma unroll
        for (int nj = 0; nj < 4; ++nj) { const int lq = 16 * nj + fr; float tot = 0.f;
#pragma unroll
            for (int w = 0; w < 8; ++w) tot += ssq[w * 64 + lq];
            const float rs = rsqrtf(tot * (1.f / 512.f) + LN_EPS); const size_t row = row0 + lq;
#pragma unroll
            for (int mi = 0; mi < 4; ++mi) { const int p0 = 16 * mi + 4 * fq; const f32x4 wv = *(const f32x4*)(nw + p0); const f32x4 y = Y[mi][nj];
                u32x2 w; w.x = pk2(y[0] * rs * wv[0], y[1] * rs * wv[1]); w.y = pk2(y[2] * rs * wv[2], y[3] * rs * wv[3]);
                *(u32x2*)(MIXED + row * D_ + 256 + hd * 64 + p0) = w; } } }
        __syncthreads();
    }
}

__device__ __forceinline__ void na_phase2(const bf16_t* PROJ, bf16_t* MIXED, const float* rpb, LAS unsigned char* lds, int G) {
    const int tid = ltid(), lane = tid & 63, wave = __builtin_amdgcn_readfirstlane(tid >> 6), j = wave & 3;
    LAS bf16_t* Vl = (LAS bf16_t*)(lds + wave * SSD_WAVE_LDS);
    LAS float* rpl = (LAS float*)(lds + wave * SSD_WAVE_LDS + 8448);
    const int t_lo = j < 2 ? 0 : j - 1, t_hi = j == 0 ? 1 : (j == 3 ? 3 : j + 1);
    const bool pr0 = t_lo <= 1, pr1 = t_hi >= 2;
    const int fr = lane & 15, fq = lane >> 4;
    int bix[4][4];
    { const int c = 16 * j + fr, c0 = min(max(c - 8, 0), 48);
#pragma unroll
      for (int kt = 0; kt < 4; ++kt)
#pragma unroll
          for (int e = 0; e < 4; ++e) { const int kc = 16 * kt + 4 * fq + e; bix[kt][e] = (kc >= c0 && kc < c0 + 16) ? min(max(kc - c, -15), 15) + 15 : -1; } }
    unsigned koff[4], voff[8];
#pragma unroll
    for (int kt = 0; kt < 4; ++kt) koff[kt] = (unsigned)((16 * kt + fr) * NP + PK + 8 * fq) * 2u;
#pragma unroll
    for (int i = 0; i < 8; ++i) { const int q = lane + 64 * i; voff[i] = (unsigned)((q >> 3) * NP + PV + (q & 7) * 8) * 2u; }
    constexpr float L2E = 1.44269504089f;
    const int per_ = (8 * 128 * 2 + G - 1) / G, it0_ = lbid() * per_, it1_ = min(it0_ + per_, 8 * 128 * 2);
    for (int it = it0_; it < it1_; ++it) {
        const int r = it & 127, hp = (it >> 7) & 1, b = it >> 8, h = hp * 2 + (wave >> 2);
        const int r0 = min(max(r - 4, 0), 120);
        const size_t rowq0 = (size_t)b * T_ + r * 64;
        { const float* rph = rpb + h * 15 * 31;
#pragma unroll
          for (int i = 0; i < 8; ++i) { const int e = lane + 64 * i; if (e < 465) rpl[e] = rph[e] * L2E; } }
        bf16x8 qf[2];
        { const bf16_t* qp = PROJ + (rowq0 + 16 * j + fr) * NP + PQ + h * 64 + 8 * fq; qf[0] = *(const bf16x8*)qp; qf[1] = *(const bf16x8*)(qp + 32); }
        f32x4 O[4];
#pragma unroll
        for (int mi = 0; mi < 4; ++mi) O[mi] = (f32x4){0.f, 0.f, 0.f, 0.f};
        float mx = -1e30f, lsum = 0.f;
        bf16x8 kn[4][2]; u32x4 vn[8];
        const char* kbase = (const char*)(PROJ + ((size_t)b * T_ + r0 * 64) * NP + h * 64);
#pragma unroll
        for (int kt = 0; kt < 4; ++kt) if (kt >= t_lo && kt <= t_hi) { kn[kt][0] = *(const bf16x8*)(kbase + koff[kt]); kn[kt][1] = *(const bf16x8*)(kbase + koff[kt] + 64); }
#pragma unroll
        for (int i = 0; i < 8; ++i) if (i < 4 ? pr0 : pr1) vn[i] = *(const u32x4*)(kbase + voff[i]);
#pragma unroll 1
        for (int kr = 0; kr < 8; ++kr) {
            const int krow = r0 + kr;
            int ln_ = lane; asm volatile("" : "+v"(ln_)); const int fr = ln_ & 15, fq = ln_ >> 4;
#pragma unroll
            for (int i = 0; i < 8; ++i) if (i < 4 ? pr0 : pr1) { const int q = ln_ + 64 * i, key = q >> 3, dc = (q & 7) * 8; LAS unsigned* d = (LAS unsigned*)(Vl + key * SSD_XS + dc);
                d[0] = vn[i].x; d[1] = vn[i].y; d[2] = vn[i].z; d[3] = vn[i].w; }
            f32x4 S[4];
            const LAS float* rpr = rpl + (krow - r + 7) * 31;
#pragma unroll
            for (int kt = 0; kt < 4; ++kt) if (kt >= t_lo && kt <= t_hi) { f32x4 t = MFMA16(kn[kt][0], qf[0], ((f32x4){0.f, 0.f, 0.f, 0.f})); S[kt] = MFMA16(kn[kt][1], qf[1], t); }
            kbase += (size_t)64 * NP * 2;
            if (kr < 7) {
#pragma unroll
                for (int kt = 0; kt < 4; ++kt) if (kt >= t_lo && kt <= t_hi) { kn[kt][0] = *(const bf16x8*)(kbase + koff[kt]); kn[kt][1] = *(const bf16x8*)(kbase + koff[kt] + 64); }
#pragma unroll
                for (int i = 0; i < 8; ++i) if (i < 4 ? pr0 : pr1) vn[i] = *(const u32x4*)(kbase + voff[i]); }
            float gm = -1e30f;
#pragma unroll
            for (int kt = 0; kt < 4; ++kt) {
                if (kt >= t_lo && kt <= t_hi) { f32x4 t = S[kt];
#pragma unroll
                    for (int e = 0; e < 4; ++e) { const int bi = bix[kt][e]; const float s = bi >= 0 ? t[e] * (0.125f * L2E) + rpr[bi] : -1e30f; t[e] = s; gm = fmaxf(gm, s); }
                    S[kt] = t; }
                else S[kt] = (f32x4){-1e30f, -1e30f, -1e30f, -1e30f}; }
            gm = fmaxf(gm, __shfl_xor(gm, 16)); gm = fmaxf(gm, __shfl_xor(gm, 32));
            const float mnew = fmaxf(mx, gm), al = __builtin_amdgcn_exp2f(mx - mnew); mx = mnew; lsum *= al;
#pragma unroll
            for (int mi = 0; mi < 4; ++mi) O[mi] = O[mi] * al;
#pragma unroll
            for (int kt = 0; kt < 4; ++kt) {
                if (kt >= t_lo && kt <= t_hi) {
#pragma unroll
                    for (int e = 0; e < 4; ++e) { const float p = __builtin_amdgcn_exp2f(S[kt][e] - mnew); S[kt][e] = p; lsum += p; } }
                else S[kt] = (f32x4){0.f, 0.f, 0.f, 0.f}; }
#pragma unroll
            for (int pr = 0; pr < 2; ++pr) if (pr == 0 ? pr0 : pr1) {
                const unsigned w0 = pk2hw(S[2 * pr][0], S[2 * pr][1]), w1 = pk2hw(S[2 * pr][2], S[2 * pr][3]), w2 = pk2hw(S[2 * pr + 1][0], S[2 * pr + 1][1]), w3 = pk2hw(S[2 * pr + 1][2], S[2 * pr + 1][3]);
                const u32x4 w = {w0, w1, w2, w3}; const bf16x8 pf = __builtin_bit_cast(bf16x8, w);
#pragma unroll
                for (int mi = 0; mi < 4; ++mi) { bf16x8 af;
#pragma unroll
                    for (int jj = 0; jj < 4; ++jj) { af[jj] = (short)Vl[(32 * pr + 4 * fq + jj) * SSD_XS + 16 * mi + fr]; af[4 + jj] = (short)Vl[(32 * pr + 16 + 4 * fq + jj) * SSD_XS + 16 * mi + fr]; }
                    O[mi] = MFMA16(af, pf, O[mi]); } }
        }
        { lsum += __shfl_xor(lsum, 16); lsum += __shfl_xor(lsum, 32); const float inv = 1.f / lsum;
          bf16_t* op = MIXED + (rowq0 + 16 * j + fr) * D_ + h * 64 + 4 * fq;
#pragma unroll
          for (int mi = 0; mi < 4; ++mi) { u32x2 w; w.x = pk2hw(O[mi][0] * inv, O[mi][1] * inv); w.y = pk2hw(O[mi][2] * inv, O[mi][3] * inv); *(u32x2*)(op + 16 * mi) = w; } }
    }
}
__device__ __forceinline__ void ln_phase(const Args& a, const float* gam, const float* bet, int G) {
    const int tid = ltid(), lane = tid & 63, gw = lbid() * 8 + (tid >> 6), NGW = G * 8;
    float* H = lptr(a.out); bf16_t* HB = (bf16_t*)(lptr(a.ws) + WS_HB);
    for (int m = gw; m < M_ / 2; m += NGW) { const size_t r0 = (size_t)m * D_, r1 = (size_t)(m + M_ / 2) * D_;
        ln_row2(H + r0, H + r1, H + r0, H + r1, (bf16_t*)nullptr, (bf16_t*)nullptr, gam, bet, lane); }
}
__device__ __forceinline__ void xsoftmax_phase(const Args& a, int G) {
    const float* S = (const float*)(lptr(a.ws) + WS_S); bf16_t* P = (bf16_t*)(lptr(a.ws) + WS_QB);
    const int tid = ltid(), lane = tid & 63, gw = lbid() * 8 + (tid >> 6), NGW = G * 8;
    for (int m = gw; m < M_; m += NGW) {
#pragma unroll
        for (int j = 0; j < 4; ++j) { const f32x4 v = ((const f32x4*)(S + (size_t)m * D_ + j * 256))[lane];
            const float mx = wave_max(fmaxf(fmaxf(v.x, v.y), fmaxf(v.z, v.w)));
            const float e0 = __expf(v.x - mx), e1 = __expf(v.y - mx), e2 = __expf(v.z - mx), e3 = __expf(v.w - mx);
            const float inv = 1.f / wave_sum((e0 + e1) + (e2 + e3));
            u32x2 w; w.x = pk2(e0 * inv, e1 * inv); w.y = pk2(e2 * inv, e3 * inv); ((u32x2*)(P + (size_t)m * D_ + j * 256))[lane] = w; } }
}

#define XB_TMO      128
#define XB_XCNT(j)  (256  + 64 * (j))
#define XB_XSUB(j)  (1280 + 64 * (j))
#define XB_XGEN(j)  (2304 + 64 * (j))
#define XB_TOP      3328
#define XB_TOPGEN   3392
#define XCD_BAR_WORDS 3456
#define XB_SPIN_CAP (1u << 18)

__device__ __forceinline__ unsigned xb_ld(unsigned* p)              { return __hip_atomic_load(p, __ATOMIC_RELAXED, __HIP_MEMORY_SCOPE_AGENT); }
__device__ __forceinline__ unsigned xb_add(unsigned* p, unsigned v) { return __hip_atomic_fetch_add(p, v, __ATOMIC_RELAXED, __HIP_MEMORY_SCOPE_AGENT); }
__device__ __forceinline__ unsigned xb_xcc_id() { return (unsigned)__builtin_amdgcn_s_getreg((3 << 11) | 20) & 0xFu; }
#define XB_SPIN(cond, bar) do { unsigned _sp = 0; while (cond) { __builtin_amdgcn_s_sleep(1); \
    if ((++_sp & 255u) == 0u) { if (xb_ld(&(bar)[XB_TMO])) break; if (_sp > XB_SPIN_CAP) { atomicAdd(&(bar)[XB_TMO], 1u); break; } } } } while (0)

struct XcdBarrier {
    unsigned* bar; unsigned x;
    volatile LAS unsigned* st;
};

__device__ __forceinline__ XcdBarrier xcd_barrier_post(unsigned* bar, volatile LAS unsigned* st) {
    XcdBarrier b; b.bar = bar; b.x = xb_xcc_id(); b.st = st;
    if (threadIdx.x == 0) (void)xb_add(&bar[XB_XCNT(b.x)], 1u);
    return b;
}
__device__ __forceinline__ void xcd_barrier_complete(unsigned* bar, unsigned x, unsigned& nloc, unsigned& nx) {
    const unsigned G = gridDim.x * gridDim.y * gridDim.z;
    unsigned sum, cnt, mine, sp = 0u;
    for (;;) {
        sum = 0u; cnt = 0u; mine = 0u;
#pragma unroll
        for (unsigned j = 0; j < 16; ++j) { const unsigned c = xb_ld(&bar[XB_XCNT(j)]); sum += c; cnt += (c > 0u) ? 1u : 0u; mine = (j == x) ? c : mine; }
        if (sum == G) break;
        __builtin_amdgcn_s_sleep(1);
        if ((++sp & 255u) == 0u) { if (xb_ld(&bar[XB_TMO])) break; if (sp > XB_SPIN_CAP) { atomicAdd(&bar[XB_TMO], 1u); break; } }
    }
    nloc = mine > 0u ? mine : 1u; nx = cnt > 0u ? cnt : 1u;
}

__device__ __forceinline__ void xcd_barrier(const XcdBarrier& b) {
    asm volatile("s_waitcnt vmcnt(0)" ::: "memory");
    __syncthreads();
    if (threadIdx.x == 0) {
        unsigned* bar = b.bar;
        __builtin_amdgcn_s_waitcnt(0);
        unsigned nloc = b.st[0], nx = b.st[1];
        if (nloc == 0u) { xcd_barrier_complete(bar, b.x, nloc, nx); b.st[0] = nloc; b.st[1] = nx; }
        const unsigned old = xb_add(&bar[XB_XSUB(b.x)], 1u);
        const unsigned gen = old / nloc;
        if (old + 1u == (gen + 1u) * nloc) {
            __builtin_amdgcn_fence(__ATOMIC_RELEASE, "agent");
            asm volatile("s_waitcnt vmcnt(0)" ::: "memory");
            const unsigned og = xb_add(&bar[XB_TOP], 1u);
            const unsigned tg = og / nx;
            if (og + 1u == (tg + 1u) * nx) xb_add(&bar[XB_TOPGEN], 1u);
            else XB_SPIN(xb_ld(&bar[XB_TOPGEN]) == tg, bar);
            __builtin_amdgcn_fence(__ATOMIC_ACQUIRE, "agent");
            xb_add(&bar[XB_XGEN(b.x)], 1u);
            asm volatile("s_waitcnt vmcnt(0)" ::: "memory");
        } else {
            XB_SPIN(xb_ld(&bar[XB_XGEN(b.x)]) == gen, bar);
            __builtin_amdgcn_fence(__ATOMIC_ACQUIRE, "agent");
            asm volatile("s_waitcnt vmcnt(0)" ::: "memory");
        }
    }
    __syncthreads();
}

__device__ __forceinline__ const LAS float* stage_gb(LAS unsigned char* lds, const float* gam, const float* bet) {
    LAS float* gl = (LAS float*)(lds + 139264); const int t = ltid();
    *(LAS f32x4*)(gl + 4 * t) = (t < 256) ? ((const f32x4*)gam)[t] : ((const f32x4*)bet)[t - 256];
    __syncthreads(); return gl;
}
#ifndef ONLY_S
#define ONLY_S -1
#endif
#define PHX(x) (ONLY_S == -1 || ONLY_S == (x))
__global__ void __launch_bounds__(512, 2) fwd(Args a) {
    extern __shared__ __attribute__((aligned(16))) unsigned char lds_raw[];
    LAS unsigned char* lds = (LAS unsigned char*)lds_raw;
    volatile LAS unsigned* bst = (volatile LAS unsigned*)(lds + 157696);
    if (threadIdx.x < 16) bst[threadIdx.x] = 0u;
    __syncthreads();
    XcdBarrier xbar; xbar.bar = (unsigned*)(a.ws + 4096); xbar.x = 0; xbar.st = bst;
    if (a.coop) xbar = xcd_barrier_post((unsigned*)(a.ws + 4096), bst);
    for (int ph = a.ph_lo; ph < a.ph_hi; ++ph) {
    int G = gridDim.x; asm volatile("" : "+s"(G)); const int bx = lbid();
    bf16_t* HB = (bf16_t*)(lptr(a.ws) + WS_HB); bf16_t* PROJ = (bf16_t*)(lptr(a.ws) + WS_PROJ); bf16_t* MIXED = (bf16_t*)(lptr(a.ws) + WS_MIXED); bf16_t* CONV = (bf16_t*)(lptr(a.ws) + WS_CONV);
    bf16_t* UX = (bf16_t*)(lptr(a.ws) + WS_UX); bf16_t* MEMB = (bf16_t*)(lptr(a.ws) + WS_MEMB); bf16_t* KM = (bf16_t*)(lptr(a.ws) + WS_KM); bf16_t* VMT = (bf16_t*)(lptr(a.ws) + WS_VMT);
    bf16_t* QB = (bf16_t*)(lptr(a.ws) + WS_QB); bf16_t* OB = (bf16_t*)(lptr(a.ws) + WS_OB); bf16_t* HID = (bf16_t*)(lptr(a.ws) + WS_HID);
    float* SL0 = (float*)(lptr(a.ws) + WS_SL); float* SL1 = SL0 + (size_t)M_ * 8;
        if (ph == 0) { if (PHX(100)) prologue(a, lds, G); }
        else {
            const int l = (ph - 1) / 17, s = (ph - 1) % 17;
            unsigned char* wb = lptr(a.ws) + WS_W + (size_t)l * LWB;
            pg8::Sched S;
            if (s == 0 && PHX(0)) {
                if (l == 0) {
                    { pg8::Gemm g{MEMB, (const bf16_t*)(lptr(a.ws) + WS_W + OW_K), D_, D_, D_, 0, 0, LWB / 2, 0}; S.init(8, 4, 2, 1, G, bx);
                      pg8::EpiStore<0> E{KM, D_, (size_t)B_ * MEMT * D_, 0, 1 << 30, 1.f}; pg8::gemm_phase(lds, g, S, E); }
                    { pg8::Gemm g{(const bf16_t*)(lptr(a.ws) + WS_W + OW_V), MEMB, D_, D_, D_, LWB / 2, 0, 0, (size_t)MEMT * D_}; S.init(4, 1, 2, 8, G, bx);
                      pg8::EpiStore<0> E{VMT, MEMT, (size_t)B_ * D_ * MEMT, (size_t)D_ * MEMT, 1 << 30, 1.f}; pg8::gemm_phase(lds, g, S, E); }
                }
                pg8::Gemm g{HB, (const bf16_t*)(wb + OW_IN), D_, D_, D_, 0, 0, 0, 0}; S.init(M_ / 256, NPP / 256, 1, 1, G, bx);
                if (l == 0) { pg8::EpiStore<0> E{PROJ, NP, 0, 0, NP, 1.f}; pg8::gemm_phase(lds, g, S, E); }
                else { float* cs = cs_ptr(lptr(a.ws), 1, 2); pg8::EpiStoreLN<0> E{PROJ, NP, NP, 1.f, SL0  , cs, cs + NPP}; pg8::gemm_phase(lds, g, S, E); }
            } else if (s == 1 && PHX(1)) {
                if (l == 0) colsum_phase(a, G);
                na_phase2(PROJ, MIXED, gp(a.in[I_RPB]) + l * 4 * 15 * 31, lds, G);
#ifndef NO_CONV
                conv_phase(PROJ, CONV, gp(a.in[I_CONVW]) + l * 5 * 768, gp(a.in[I_CONVB]) + l * 768, G);
#endif
                s5_gather_phase(PROJ, UX, G);
            } else if (s == 2 && PHX(2)) {
                ssd_passA2(a, l, lds, G);
                __syncthreads();
                pg8::Gemm g{UX, (const bf16_t*)(lptr(a.ws) + WS_SM) + (size_t)l * 16 * 256 * 256, 512, 256, 256, (size_t)4096 * 512, 0, (size_t)256 * 256, 0}; S.init(16, 1, 16, 1, G, bx);
                pg8::EpiF32 E{(float*)(lptr(a.ws) + WS_S5S), 256, (size_t)4096 * 256, 0}; pg8::gemm_phase(lds, g, S, E);
            } else if (s == 3 && PHX(3)) {
                ssd_scan2(a, G);
                s5_scan(a, l, G);
            } else if (s == 4 && PHX(4)) {
#ifndef NO_PC
                ssd_passC2(a, l, lds, G);
#endif
                pg8::Gemm g{UX, (const bf16_t*)(lptr(a.ws) + WS_TM) + (size_t)l * 16 * 256 * 512, 512, 512, 512, (size_t)4096 * 512, 0, (size_t)256 * 512, 0}; S.init(16, 1, 16, 1, G, bx);
#ifndef NO_G4
                pg8::EpiS5Y E{MIXED}; pg8::gemm_phase(lds, g, S, E);
#endif
            } else if (s == 5 && PHX(5)) {
                pg8::Gemm g{MIXED + 768, (const bf16_t*)(wb + OW_GLU), D_, 256, 256, 0, 0, 0, 0}; S.init(M_ / 256, 1, 1, 1, G, bx);
                pg8::EpiGLU E{MIXED, gp(a.in[I_GLUB]) + l * 256}; pg8::gemm_phase(lds, g, S, E);
            } else if (s == 6 && PHX(6)) {
                pg8::Gemm g{MIXED, (const bf16_t*)(wb + OW_OUT), D_, D_, D_, 0, 0, 0, 0}; S.init(M_ / 256, 4, 1, 1, G, bx);
                if (l == 0) { pg8::EpiResidLN<true, false> E{lptr(a.out), HB, SL1, SL0, nullptr, nullptr, (LAS float*)(lds + 131072), ALPHA}; pg8::gemm_phase(lds, g, S, E); }
                else { const LAS float* gl = stage_gb(lds, gp(a.in[I_LNMLP_G]), gp(a.in[I_LNMLP_B])); pg8::EpiResidLN<false, false> E{lptr(a.out), HB, SL0, SL1, gl, nullptr, (LAS float*)(lds + 131072), ALPHA}; pg8::gemm_phase(lds, g, S, E); }
            } else if (s == 7 && PHX(7)) {
            } else if (s == 8 && PHX(8)) {
                pg8::Gemm g{HB, (const bf16_t*)(wb + OW_Q), D_, D_, D_, 0, 0, 0, 0}; S.init(M_ / 256, 4, 1, 1, G, bx);
                float* cs = cs_ptr(lptr(a.ws), l, 0); pg8::EpiStoreLN<0> E{QB, D_, 1 << 30, 0.0625f, l == 0 ? SL0 : SL1, cs, cs + D_}; pg8::gemm_phase(lds, g, S, E);
            } else if (s == 9 && PHX(9)) {
                pg8::Gemm g{QB, KM + (size_t)l * B_ * MEMT * D_, D_, D_, 256, (size_t)T_ * D_, 256, (size_t)MEMT * D_, 256}; S.init(T_ / 256, 1, 8, 4, G, bx);
                pg8::EpiSoftmax E{(bf16_t*)(lptr(a.ws) + WS_S), D_, (size_t)T_ * D_, 256, (LAS float*)(lds + 131072)}; pg8::gemm_phase(lds, g, S, E);
            } else if (s == 10 && PHX(10)) {
            } else if (s == 11 && PHX(11)) {
                pg8::Gemm g{(const bf16_t*)(lptr(a.ws) + WS_S), VMT + (size_t)l * B_ * D_ * MEMT, D_, MEMT, 256, (size_t)T_ * D_, 256, (size_t)D_ * MEMT, (size_t)256 * MEMT}; S.init(T_ / 256, 1, 8, 4, G, bx);
                pg8::EpiStore<0> E{OB, D_, (size_t)T_ * D_, 256, 1 << 30, 1.f}; pg8::gemm_phase(lds, g, S, E);
            } else if (s == 12 && PHX(12)) {
                pg8::Gemm g{OB, (const bf16_t*)(wb + OW_O), D_, D_, D_, 0, 0, 0, 0}; S.init(M_ / 256, 4, 1, 1, G, bx);
                const LAS float* gl = stage_gb(lds, gp(a.in[I_LNMIX_G]) + l * D_, gp(a.in[I_LNMIX_B]) + l * D_); pg8::EpiResidLN<false, false> E{lptr(a.out), HB, l == 0 ? SL0 : SL1, l == 0 ? SL1 : SL0, gl, nullptr, (LAS float*)(lds + 131072), ALPHA}; pg8::gemm_phase(lds, g, S, E);
            } else if (s == 13 && PHX(13)) {
            } else if (s == 14 && PHX(14)) {
                pg8::Gemm g{HB, (const bf16_t*)(wb + OW_1), D_, D_, D_, 0, 0, 0, 0}; S.init(M_ / 256, FF_ / 256, 1, 1, G, bx);
                float* cs = cs_ptr(lptr(a.ws), l, 1); pg8::EpiStoreLN<1> E{HID, FF_, 1 << 30, 1.f, l == 0 ? SL1 : SL0, cs, cs + FF_}; pg8::gemm_phase(lds, g, S, E);
            } else if (s == 15 && PHX(15)) {
                pg8::Gemm g{HID, (const bf16_t*)(wb + OW_2), FF_, FF_, FF_, 0, 0, 0, 0}; S.init(M_ / 256, 4, 1, 1, G, bx);
                const LAS float* gl = stage_gb(lds, gp(a.in[I_LNXA_G]) + l * D_, gp(a.in[I_LNXA_B]) + l * D_); if (l == 0) { pg8::EpiResidLN<false, false> E{lptr(a.out), HB, SL1, SL0, gl, nullptr, (LAS float*)(lds + 131072), ALPHA}; pg8::gemm_phase(lds, g, S, E); }
                else { pg8::EpiResidLN<false, true> E{lptr(a.out), HB, SL0, SL1, gl, nullptr, (LAS float*)(lds + 131072), ALPHA}; pg8::gemm_phase(lds, g, S, E); }
            } else if (PHX(16)) {
                if (l == 1) ln_phase(a, gp(a.in[I_LNMLP_G]) + l * D_, gp(a.in[I_LNMLP_B]) + l * D_, G);
            }
        }
        if (ph + 1 < a.ph_hi) { const int s_ = (ph - 1) % 17; const bool empty_ = ph > 0 && (s_ == 7 || s_ == 10 || s_ == 13 || (s_ == 16 && ph < 18)); if (a.coop && !empty_) { if (a.ph_hi < 0) cg::this_grid().sync();   xcd_barrier(xbar); } }
    }
}

constexpr int NPHASES = 1 + 2 * 17;
#ifndef MULTI_LAUNCH
#define MULTI_LAUNCH 0
#endif

extern "C" void kernel_launch(void* const* d_in, const int* in_sizes, int n_in, void* d_out, int out_size, void* d_ws, size_t ws_size, hipStream_t stream) {
    static int grid = 0;
    if (grid == 0) {
        if (n_in != 35 || out_size != M_ * D_ || ws_size < WS_END) { fprintf(stderr, "kernel_launch: unexpected sizes n_in %d out %d ws %zu\n", n_in, out_size, ws_size); grid = -1; return; }
        int dev = 0, cus = 0, per_cu = 0;
        hipGetDevice(&dev); hipDeviceGetAttribute(&cus, hipDeviceAttributeMultiprocessorCount, dev);
        if (hipFuncSetAttribute((const void*)fwd, hipFuncAttributeMaxDynamicSharedMemorySize, LDS_BYTES) != hipSuccess) { fprintf(stderr, "kernel_launch: hipFuncSetAttribute failed\n"); grid = -1; return; }
        if (hipOccupancyMaxActiveBlocksPerMultiprocessor(&per_cu, (const void*)fwd, 512, LDS_BYTES) != hipSuccess || per_cu < 1) { fprintf(stderr, "kernel_launch: occupancy query says %d\n", per_cu); per_cu = 1; }
        (void)hipGetLastError();
        grid = cus * per_cu;
    }
    if (grid < 0) return;
    (void)hipMemsetAsync(d_ws, 0, 65536, stream);
    Args a{};
    for (int i = 0; i < 35; ++i) a.in[i] = (const float*)d_in[i];
    a.out = (float*)d_out; a.ws = (unsigned char*)d_ws;
#if MULTI_LAUNCH
    for (int ph = 0; ph < NPHASES; ++ph) { a.ph_lo = ph; a.ph_hi = ph + 1; a.coop = 0; hipLaunchKernelGGL(fwd, dim3(grid), dim3(512), LDS_BYTES, stream, a); }
#else
    a.ph_lo = 0; a.ph_hi = NPHASES; a.coop = 1;
    void* args[] = {&a};
    hipError_t e = hipLaunchCooperativeKernel((const void*)fwd, dim3(grid), dim3(512), args, LDS_BYTES, stream);
    if (e != hipSuccess) fprintf(stderr, "cooperative launch failed: %s (grid %d)\n", hipGetErrorString(e), grid);
#endif
}
```

```cpp
#include <hip/hip_runtime.h>
#include <hip/hip_cooperative_groups.h>
#include <cstdio>
#include <cstdint>
namespace cg = cooperative_groups;

#define LAS __attribute__((address_space(3)))
typedef unsigned short bf16_t;
typedef short bf16x8 __attribute__((ext_vector_type(8)));
typedef float f32x4 __attribute__((ext_vector_type(4)));
typedef float f32x2 __attribute__((ext_vector_type(2)));
typedef unsigned u32x4 __attribute__((ext_vector_type(4)));
typedef unsigned u32x2 __attribute__((ext_vector_type(2)));

constexpr int B_ = 8, T_ = 8192, D_ = 1024, M_ = B_ * T_, NP = 2320, NPP = 2560, FF_ = 4096, MEMT = 256;
constexpr float LN_EPS = 1e-5f;
constexpr float ALPHA = 1.41421356237f;
constexpr int PQ = 0, PK = 256, PV = 512, PZ = 768, PX = 1280, PDT = 2048, PU = 2064;

constexpr size_t MiB = 1u << 20;
constexpr size_t WS_W = 1 * MiB, LWB = 32 * MiB;
constexpr size_t OW_IN = 0, OW_OUT = 5 * MiB, OW_Q = 7 * MiB, OW_K = 9 * MiB, OW_V = 11 * MiB, OW_O = 13 * MiB, OW_1 = 15 * MiB, OW_2 = 23 * MiB, OW_GLU = 31 * MiB;
constexpr size_t WS_MEMB = 65 * MiB, WS_KM = 69 * MiB, WS_VMT = 77 * MiB, WS_TM = 85 * MiB, WS_SM = 93 * MiB, WS_MISC = 97 * MiB;
constexpr size_t WS_HB = 100 * MiB, WS_PROJ = 228 * MiB, WS_MIXED = 518 * MiB, WS_CONV = 646 * MiB, WS_HID = 228 * MiB;
constexpr size_t WS_S = 228 * MiB, WS_QB = 484 * MiB, WS_OB = 612 * MiB, WS_ST = 744 * MiB, WS_UX = 872 * MiB, WS_S5S = 936 * MiB, WS_SL = 1000 * MiB, WS_END = 1004 * MiB;
constexpr size_t MISC_CS = 262144;
constexpr int LDS_BYTES = 157696 + 64;

__device__ __forceinline__ float bf2f(unsigned u) { return __uint_as_float(u << 16); }
__device__ __forceinline__ float bflo(unsigned u) { return __uint_as_float(u << 16); }
__device__ __forceinline__ float bfhi(unsigned u) { return __uint_as_float(u & 0xffff0000u); }
__device__ __forceinline__ unsigned f2bf(float f) { unsigned u = __float_as_uint(f); return (u + 0x7fffu + ((u >> 16) & 1u)) >> 16; }
__device__ __forceinline__ unsigned pk2(float lo, float hi) { return f2bf(lo) | (f2bf(hi) << 16); }
__device__ __forceinline__ unsigned pk2hw(float lo, float hi) { unsigned r; asm volatile("v_cvt_pk_bf16_f32 %0, %1, %2" : "=v"(r) : "v"(lo), "v"(hi)); return r; }
__device__ __forceinline__ float wave_sum(float v) {
#pragma unroll
    for (int o = 1; o < 64; o <<= 1) v += __shfl_xor(v, o);
    return v;
}
__device__ __forceinline__ float wave_max(float v) {
#pragma unroll
    for (int o = 1; o < 64; o <<= 1) v = fmaxf(v, __shfl_xor(v, o));
    return v;
}
__device__ __forceinline__ float silu_f(float x) { return x * __builtin_amdgcn_rcpf(1.f + __expf(-x)); }
__device__ __forceinline__ float gelu_tanh(float x) { const float y = 0.7978845608f * (x + 0.044715f * x * x * x); const float t = 1.f - 2.f * __builtin_amdgcn_rcpf(1.f + __expf(2.f * y)); return 0.5f * x * (1.f + t); }
__device__ __forceinline__ int ltid() { int t = threadIdx.x; asm volatile("" : "+v"(t)); return t; }
__device__ __forceinline__ int lbid() { int t = blockIdx.x; asm volatile("" : "+s"(t)); return t; }
#define GAS __attribute__((address_space(1)))
__device__ __forceinline__ size_t zopq() { size_t z = 0; asm volatile("" : "+s"(z)); return z; }
template <class P> __device__ __forceinline__ P* gp(P* p) { return (P*)((char*)p + zopq()); }
template <class P> __device__ __forceinline__ P* lptr(P* p) { return (P*)((char*)p + zopq()); }
#define LDS_WAIT() asm volatile("s_waitcnt lgkmcnt(0)" ::: "memory")

namespace pg8 {
constexpr int BM = 256, BK = 64, HALF = 128, HTB = HALF * BK * 2, STAGE_BYTES = 8 * HTB;
__host__ __device__ __forceinline__ int lds_byte(int r, int c) { const int st = (r >> 4) * 2 + (c >> 5), rr = r & 15, cc = c & 31, ob = rr * 64 + cc * 2; return st * 1024 + (ob ^ (((ob >> 9) & 1) << 5)); }
__host__ __device__ __forceinline__ void stage_rc(int b, int& R, int& C) { const int st = b / 1024, sb = b % 1024, swz = sb ^ (((sb >> 9) & 1) << 5); R = (st >> 1) * 16 + swz / 64; C = (st & 1) * 32 + (swz % 64) / 2; }
__host__ __device__ __forceinline__ int perm32(int rho) { const int n = rho >> 4, i = rho & 15; return 8 * (i >> 2) + 4 * n + (i & 3); }

struct Unit { int pm, pn, b1, b2; };
struct Gemm { const bf16_t* A; const bf16_t* Bt; int lda, ldb, K; size_t aS1, aS2, bS1, bS2; };

struct Sched {
    int nM, nN, nB2, total, G, c;
    __device__ __forceinline__ void init(int nM_, int nN_, int nB1_, int nB2_, int G_, int c_) { nM = nM_; nN = nN_; nB2 = nB2_; total = nM_ * nN_ * nB1_ * nB2_; G = G_; c = c_; }
    __device__ __forceinline__ bool next(int i, Unit& u) const {
        const long L = (long)i * G + c; if (L >= total) return false;
        int w = (int)L;
        { const int q = total / 8, r = total % 8, xcd = w % 8, off = w / 8; w = (xcd < r ? xcd * (q + 1) : r * (q + 1) + (xcd - r) * q) + off; }
        const int per = nM * nN; const int bt = w / per; w -= bt * per;
        const int nig = 8 * nN, gid = w / nig, fm = gid * 8, gsz = (nM - fm) < 8 ? (nM - fm) : 8;
        u.pm = fm + ((w % nig) % gsz); u.pn = (w % nig) / gsz; u.b1 = bt / nB2; u.b2 = bt % nB2; return true;
    }
};

typedef f32x4 Acc[2][2][4][2];

template <int ACT> struct EpiStore {
    static constexpr bool PERM = true;
    bf16_t* C; int ldc; size_t cS1, cS2; int ncols; float scale;
    __device__ __forceinline__ void operator()(const Acc& acc, const Unit& u, int wr, int wc, int fr, int fq) const {
        asm volatile("" : "+v"(fr), "+v"(fq));
        bf16_t* base = C + u.b1 * cS1 + u.b2 * cS2;
        const int row0 = u.pm * BM + wr * 64 + fr, col0 = u.pn * BM + wc * 32 + 8 * fq;
#pragma unroll
        for (int ai = 0; ai < 2; ++ai)
#pragma unroll
            for (int m = 0; m < 4; ++m) { bf16_t* rowp = base + (size_t)(row0 + ai * HALF + m * 16) * ldc + col0;
#pragma unroll
                for (int bj = 0; bj < 2; ++bj) { f32x4 v0 = acc[ai][bj][m][0], v1 = acc[ai][bj][m][1];
                    if (ACT == 1) {
#pragma unroll
                        for (int e = 0; e < 4; ++e) { float a0 = fmaxf(v0[e], 0.f), a1 = fmaxf(v1[e], 0.f); v0[e] = a0 * a0; v1[e] = a1 * a1; } }
                    v0 = v0 * scale; v1 = v1 * scale;
                    u32x4 w; w.x = pk2(v0[0], v0[1]); w.y = pk2(v0[2], v0[3]); w.z = pk2(v1[0], v1[1]); w.w = pk2(v1[2], v1[3]);
                    if (col0 + bj * HALF < ncols) *(u32x4*)(rowp + bj * HALF) = w; }
                asm volatile("" ::: "memory"); }
    }
};
struct EpiF32 {
    static constexpr bool PERM = false;
    float* C; int ldc; size_t cS1, cS2;
    __device__ __forceinline__ void operator()(const Acc& acc, const Unit& u, int wr, int wc, int fr, int fq) const {
        asm volatile("" : "+v"(fr), "+v"(fq));
        float* base = C + u.b1 * cS1 + u.b2 * cS2;
        const int row0 = u.pm * BM + wr * 64 + fr, col0 = u.pn * BM + wc * 32 + 4 * fq;
#pragma unroll
        for (int ai = 0; ai < 2; ++ai)
#pragma unroll
            for (int m = 0; m < 4; ++m) { float* rowp = base + (size_t)(row0 + ai * HALF + m * 16) * ldc + col0;
#pragma unroll
                for (int bj = 0; bj < 2; ++bj)
#pragma unroll
                    for (int n = 0; n < 2; ++n) *(f32x4*)(rowp + bj * HALF + n * 16) = acc[ai][bj][m][n];
                asm volatile("" ::: "memory"); }
    }
};
struct EpiResid {
    static constexpr bool PERM = false;
    float* H; float alpha;
    __device__ __forceinline__ void operator()(const Acc& acc, const Unit& u, int wr, int wc, int fr, int fq) const {
        asm volatile("" : "+v"(fr), "+v"(fq));
        const int row0 = u.pm * BM + wr * 64 + fr, col0 = u.pn * BM + wc * 32 + 4 * fq;
#pragma unroll
        for (int ai = 0; ai < 2; ++ai)
#pragma unroll
            for (int m = 0; m < 4; ++m) { float* rowp = H + (size_t)(row0 + ai * HALF + m * 16) * D_ + col0;
#pragma unroll
                for (int bj = 0; bj < 2; ++bj)
#pragma unroll
                    for (int n = 0; n < 2; ++n) { f32x4* p = (f32x4*)(rowp + bj * HALF + n * 16); const f32x4 h = *p; *p = h * alpha + acc[ai][bj][m][n]; }
                asm volatile("" ::: "memory"); }
    }
};
struct EpiS5Y {
    static constexpr bool PERM = true;
    bf16_t* MIXED;
    __device__ __forceinline__ void operator()(const Acc& acc, const Unit& u, int wr, int wc, int fr, int fq) const {
        asm volatile("" : "+v"(fr), "+v"(fq));
        const int row0 = u.pm * BM + wr * 64 + fr, col0 = wc * 32 + 8 * fq;
#pragma unroll
        for (int ai = 0; ai < 2; ++ai)
#pragma unroll
            for (int m = 0; m < 4; ++m) { const int row = row0 + ai * HALF + m * 16;
#pragma unroll
                for (int bj = 0; bj < 2; ++bj) { const int col = col0 + bj * HALF, j = col >> 4, ho = col & 15;
                    const f32x4 v0 = acc[ai][bj][m][0], v1 = acc[ai][bj][m][1];
                    u32x4 w; w.x = pk2(gelu_tanh(v0[0]), gelu_tanh(v0[1])); w.y = pk2(gelu_tanh(v0[2]), gelu_tanh(v0[3])); w.z = pk2(gelu_tanh(v1[0]), gelu_tanh(v1[1])); w.w = pk2(gelu_tanh(v1[2]), gelu_tanh(v1[3]));
                    *(u32x4*)(MIXED + ((size_t)row * 16 + j) * D_ + 768 + u.b1 * 16 + ho) = w; asm volatile("" ::: "memory"); } }
    }
};
struct EpiGLU {
    static constexpr bool PERM = true;
    bf16_t* MIXED; const float* bias;
    __device__ __forceinline__ void operator()(const Acc& acc, const Unit& u, int wr, int wc, int fr, int fq) const {
        asm volatile("" : "+v"(fr), "+v"(fq));
        const int row0 = u.pm * BM + wr * 64 + fr, col0 = wc * 32 + 8 * fq;
#pragma unroll
        for (int ai = 0; ai < 2; ++ai)
#pragma unroll
            for (int m = 0; m < 4; ++m) { const int row = row0 + ai * HALF + m * 16;
#pragma unroll
                for (int bj = 0; bj < 2; ++bj) { const int col = col0 + bj * HALF;
                    u32x4* gp = (u32x4*)(MIXED + (size_t)row * D_ + 768 + col); const u32x4 gv = *gp;
                    const f32x4 b0 = *(const f32x4*)(bias + col), b1 = *(const f32x4*)(bias + col + 4);
                    const f32x4 v0 = acc[ai][bj][m][0] + b0, v1 = acc[ai][bj][m][1] + b1;
                    float o[8]; const unsigned gw[4] = {gv.x, gv.y, gv.z, gv.w};
#pragma unroll
                    for (int e = 0; e < 4; ++e) { const float a = e < 2 ? v0[2 * e] : v1[2 * e - 4], b = e < 2 ? v0[2 * e + 1] : v1[2 * e - 3];
                        o[2 * e] = bflo(gw[e]) * __builtin_amdgcn_rcpf(1.f + __expf(-a)); o[2 * e + 1] = bfhi(gw[e]) * __builtin_amdgcn_rcpf(1.f + __expf(-b)); }
                    u32x4 w; w.x = pk2(o[0], o[1]); w.y = pk2(o[2], o[3]); w.z = pk2(o[4], o[5]); w.w = pk2(o[6], o[7]);
                    *gp = w; asm volatile("" ::: "memory"); } }
    }
};

struct EpiSoftmax {
    static constexpr bool PERM = true;
    bf16_t* C; int ldc; size_t cS1, cS2; LAS float* red;
    __device__ __forceinline__ void operator()(const Acc& acc, const Unit& u, int wr, int wc, int fr, int fq) const {
        asm volatile("" : "+v"(fr), "+v"(fq));
        LAS float* red2 = red + 1024;
        float mx[2][4];
#pragma unroll
        for (int ai = 0; ai < 2; ++ai)
#pragma unroll
            for (int m = 0; m < 4; ++m) { float v = -1e30f;
#pragma unroll
                for (int bj = 0; bj < 2; ++bj)
#pragma unroll
                    for (int n = 0; n < 2; ++n) { const f32x4 x = acc[ai][bj][m][n]; v = fmaxf(v, fmaxf(fmaxf(x[0], x[1]), fmaxf(x[2], x[3]))); }
                v = fmaxf(v, __shfl_xor(v, 16)); v = fmaxf(v, __shfl_xor(v, 32));
                if (fq == 0) red[(ai * HALF + wr * 64 + m * 16 + fr) * 4 + wc] = v; }
        asm volatile("s_waitcnt lgkmcnt(0)" ::: "memory"); __builtin_amdgcn_s_barrier(); asm volatile("" ::: "memory");
        float sm[2][4];
#pragma unroll
        for (int ai = 0; ai < 2; ++ai)
#pragma unroll
            for (int m = 0; m < 4; ++m) { const f32x4 r4 = *(const LAS f32x4*)(red + (ai * HALF + wr * 64 + m * 16 + fr) * 4);
                const float M = fmaxf(fmaxf(r4[0], r4[1]), fmaxf(r4[2], r4[3])); mx[ai][m] = M; float s = 0.f;
#pragma unroll
                for (int bj = 0; bj < 2; ++bj)
#pragma unroll
                    for (int n = 0; n < 2; ++n) { const f32x4 x = acc[ai][bj][m][n]; s += (__expf(x[0] - M) + __expf(x[1] - M)) + (__expf(x[2] - M) + __expf(x[3] - M)); }
                s += __shfl_xor(s, 16); s += __shfl_xor(s, 32);
                if (fq == 0) red2[(ai * HALF + wr * 64 + m * 16 + fr) * 4 + wc] = s; }
        asm volatile("s_waitcnt lgkmcnt(0)" ::: "memory"); __builtin_amdgcn_s_barrier(); asm volatile("" ::: "memory");
        bf16_t* base = C + u.b1 * cS1 + u.b2 * cS2;
        const int row0 = u.pm * BM + wr * 64 + fr, col0 = wc * 32 + 8 * fq;
#pragma unroll
        for (int ai = 0; ai < 2; ++ai)
#pragma unroll
            for (int m = 0; m < 4; ++m) { const f32x4 r4 = *(const LAS f32x4*)(red2 + (ai * HALF + wr * 64 + m * 16 + fr) * 4);
                const float inv = 1.f / ((r4[0] + r4[1]) + (r4[2] + r4[3])), M = mx[ai][m];
                bf16_t* rowp = base + (size_t)(row0 + ai * HALF + m * 16) * ldc + col0;
#pragma unroll
                for (int bj = 0; bj < 2; ++bj) { const f32x4 v0 = acc[ai][bj][m][0], v1 = acc[ai][bj][m][1];
                    u32x4 w; w.x = pk2(__expf(v0[0] - M) * inv, __expf(v0[1] - M) * inv); w.y = pk2(__expf(v0[2] - M) * inv, __expf(v0[3] - M) * inv);
                    w.z = pk2(__expf(v1[0] - M) * inv, __expf(v1[1] - M) * inv); w.w = pk2(__expf(v1[2] - M) * inv, __expf(v1[3] - M) * inv);
                    *(u32x4*)(rowp + bj * HALF) = w; }
                asm volatile("" ::: "memory"); }
    }
};


__device__ __forceinline__ void row_stats(const float* SL, size_t row, float& mu, float& rs) {
    const f32x4 a = *(const f32x4*)(SL + row * 8), b = *(const f32x4*)(SL + row * 8 + 4);
    const float S = (a[0] + a[2]) + (b[0] + b[2]), Q = (a[1] + a[3]) + (b[1] + b[3]);
    mu = S * (1.f / D_); rs = rsqrtf(fmaxf(Q * (1.f / D_) - mu * mu, 0.f) + LN_EPS);
}
template <bool FIRST, bool LAST> struct EpiResidLN {
    static constexpr bool PERM = false;
    float* H; bf16_t* HB; const float* SLr; float* SLw; const LAS float* gl; const float* unused_; LAS float* red; float alpha;
    __device__ __forceinline__ void operator()(const Acc& acc, const Unit& u, int wr, int wc, int fr, int fq) const {
        asm volatile("" : "+v"(fr), "+v"(fq));
        const int col0 = u.pn * BM + wc * 32 + 4 * fq;
        const size_t rowb = (size_t)u.pm * BM + wr * 64 + fr;
        u32x2 hA[4], hB[4]; f32x4 sna = (f32x4){0.f, 0.f, 0.f, 0.f}, snb = (f32x4){0.f, 0.f, 0.f, 0.f};
        if (!FIRST) { sna = *(const f32x4*)(SLr + rowb * 8); snb = *(const f32x4*)(SLr + rowb * 8 + 4); }
#pragma unroll
        for (int q = 0; q < 4; ++q) { hA[q] = *(const u32x2*)(HB + rowb * D_ + col0 + (q >> 1) * HALF + (q & 1) * 16); hB[q] = *(const u32x2*)(HB + (rowb + 16) * D_ + col0 + (q >> 1) * HALF + (q & 1) * 16); }
#pragma unroll
        for (int i = 0; i < 8; ++i) { const int ai = i >> 2, m = i & 3; const int rl = ai * HALF + wr * 64 + m * 16 + fr; const size_t row = (size_t)u.pm * BM + rl;
                float mu = 0.f, rs = 1.f;
                if (!FIRST) { const float S = (sna[0] + sna[2]) + (snb[0] + snb[2]), Q = (sna[1] + sna[3]) + (snb[1] + snb[3]); mu = S * (1.f / D_); rs = rsqrtf(fmaxf(Q * (1.f / D_) - mu * mu, 0.f) + LN_EPS); }
                u32x2 hc[4];
#pragma unroll
                for (int q = 0; q < 4; ++q) { hc[q] = hA[q]; hA[q] = hB[q]; }
                if (i < 7) { const size_t rown = rowb + ((i + 1) >> 2) * HALF + ((i + 1) & 3) * 16;
                    if (!FIRST) { sna = *(const f32x4*)(SLr + rown * 8); snb = *(const f32x4*)(SLr + rown * 8 + 4); } }
                if (i < 6) { const size_t rown = rowb + ((i + 2) >> 2) * HALF + ((i + 2) & 3) * 16;
#pragma unroll
                    for (int q = 0; q < 4; ++q) hB[q] = *(const u32x2*)(HB + rown * D_ + col0 + (q >> 1) * HALF + (q & 1) * 16); }
                float sm = 0.f, sq = 0.f; float* hp = H + row * D_ + col0; bf16_t* bp = HB + row * D_ + col0;
#pragma unroll
                for (int q = 0; q < 4; ++q) { const int bj = q >> 1, n = q & 1, co = bj * HALF + n * 16; f32x4 h = (f32x4){bflo(hc[q].x), bfhi(hc[q].x), bflo(hc[q].y), bfhi(hc[q].y)};
                        if (!FIRST) { const f32x4 g = *(const LAS f32x4*)(gl + col0 + co), b = *(const LAS f32x4*)(gl + D_ + col0 + co); h = (h - mu) * rs * g + b; }
                        const f32x4 pre = h * alpha + acc[ai][bj][m][n];
                        if (LAST) *(f32x4*)(hp + co) = pre;
                        else { u32x2 w; w.x = pk2(pre[0], pre[1]); w.y = pk2(pre[2], pre[3]); *(u32x2*)(bp + co) = w; }
                        sm += (pre[0] + pre[1]) + (pre[2] + pre[3]); sq += (pre[0] * pre[0] + pre[1] * pre[1]) + (pre[2] * pre[2] + pre[3] * pre[3]); }
                sm += __shfl_xor(sm, 16); sm += __shfl_xor(sm, 32); sq += __shfl_xor(sq, 16); sq += __shfl_xor(sq, 32);
                if (fq == 0) *(LAS f32x2*)(red + (rl * 4 + wc) * 2) = (f32x2){sm, sq};
                asm volatile("" ::: "memory"); }
        asm volatile("s_waitcnt lgkmcnt(0)" ::: "memory"); __builtin_amdgcn_s_barrier(); asm volatile("" ::: "memory");
        const int t = (wr * 4 + wc) * 64 + fq * 16 + fr;
        if (t < 256) { const f32x4 p0 = *(const LAS f32x4*)(red + t * 8), p1 = *(const LAS f32x4*)(red + t * 8 + 4);
            *(f32x2*)(SLw + ((size_t)u.pm * BM + t) * 8 + u.pn * 2) = (f32x2){(p0[0] + p0[2]) + (p1[0] + p1[2]), (p0[1] + p0[3]) + (p1[1] + p1[3])}; }
    }
};
template <int ACT> struct EpiStoreLN {
    static constexpr bool PERM = true;
    bf16_t* C; int ldc; int ncols; float scale; const float* SLr; const float* CS; const float* CB;
    __device__ __forceinline__ void operator()(const Acc& acc, const Unit& u, int wr, int wc, int fr, int fq) const {
        asm volatile("" : "+v"(fr), "+v"(fq));
        const int row0 = u.pm * BM + wr * 64 + fr, col0 = u.pn * BM + wc * 32 + 8 * fq;
        f32x4 cs[2][2], cbv[2][2];
#pragma unroll
        for (int bj = 0; bj < 2; ++bj) { const int c = col0 + bj * HALF; cs[bj][0] = *(const f32x4*)(CS + c); cs[bj][1] = *(const f32x4*)(CS + c + 4); cbv[bj][0] = *(const f32x4*)(CB + c); cbv[bj][1] = *(const f32x4*)(CB + c + 4); }
        f32x4 sna = *(const f32x4*)(SLr + (size_t)row0 * 8), snb = *(const f32x4*)(SLr + (size_t)row0 * 8 + 4);
#pragma unroll
        for (int i = 0; i < 8; ++i) { const int ai = i >> 2, m = i & 3; const size_t row = (size_t)(row0 + ai * HALF + m * 16);
            const float S = (sna[0] + sna[2]) + (snb[0] + snb[2]), Q = (sna[1] + sna[3]) + (snb[1] + snb[3]); const float mu = S * (1.f / D_), rs = rsqrtf(fmaxf(Q * (1.f / D_) - mu * mu, 0.f) + LN_EPS);
            if (i < 7) { const size_t rown = (size_t)(row0 + ((i + 1) >> 2) * HALF + ((i + 1) & 3) * 16); sna = *(const f32x4*)(SLr + rown * 8); snb = *(const f32x4*)(SLr + rown * 8 + 4); }
            bf16_t* rowp = C + row * ldc + col0;
#pragma unroll
            for (int bj = 0; bj < 2; ++bj) { const int c = col0 + bj * HALF;
                f32x4 v0 = (acc[ai][bj][m][0] - cs[bj][0] * mu) * rs + cbv[bj][0], v1 = (acc[ai][bj][m][1] - cs[bj][1] * mu) * rs + cbv[bj][1];
                if (ACT == 1) {
#pragma unroll
                    for (int e = 0; e < 4; ++e) { float a0 = fmaxf(v0[e], 0.f), a1 = fmaxf(v1[e], 0.f); v0[e] = a0 * a0; v1[e] = a1 * a1; } }
                v0 = v0 * scale; v1 = v1 * scale;
                u32x4 w; w.x = pk2(v0[0], v0[1]); w.y = pk2(v0[2], v0[3]); w.z = pk2(v1[0], v1[1]); w.w = pk2(v1[2], v1[3]);
                if (c < ncols) *(u32x4*)(rowp + bj * HALF) = w; }
            asm volatile("" ::: "memory"); }
    }
};

template <class Epi>
__device__ __forceinline__ void gemm_phase(LAS unsigned char* lds, const Gemm g, const Sched& S, const Epi& E) {
    constexpr bool ALIGN_EPI = true;
    const int tid = ltid(), wid = __builtin_amdgcn_readfirstlane(tid >> 6), lane = tid & 63, wr = wid >> 2, wc = wid & 3, fr = lane & 15, fq = lane >> 4;
    int K_ = g.K; asm volatile("" : "+s"(K_)); const int K = K_, nt = K / BK;
    unsigned voffA[2], voffB[2];
#pragma unroll
    for (int i = 0; i < 2; ++i) { int R, C; stage_rc(tid * 16 + i * 8192, R, C); const int Rb = Epi::PERM ? ((R & ~31) + perm32(R & 31)) : R;
        voffA[i] = (unsigned)(R * g.lda + C) * 2u; voffB[i] = (unsigned)(Rb * g.ldb + C) * 2u; }
    const size_t kstep = (size_t)(BK * 2);
    const size_t hstepA = (size_t)HALF * g.lda * 2, hstepB = (size_t)HALF * g.ldb * 2;
    const unsigned ldsw = (unsigned)wid * 1024u;
    const int aoff = lds_byte(wr * 64 + fr, fq * 8), boff = lds_byte(wc * 32 + fr, fq * 8);
#define PG8_UA(u) ((const char*)g.A + ((size_t)(u).b1 * g.aS1 + (size_t)(u).b2 * g.aS2 + (size_t)(u).pm * BM * g.lda) * 2)
#define PG8_UB(u) ((const char*)g.Bt + ((size_t)(u).b1 * g.bS1 + (size_t)(u).b2 * g.bS2 + (size_t)(u).pn * BM * g.ldb) * 2)
#define PG8_SA(b, h) (((b) * 2 + (h)) * HTB)
#define PG8_SB(b, h) ((4 + (b) * 2 + (h)) * HTB)
#define PG8_STAGE(bufoff, gbase, voff) do { _Pragma("unroll") for (int _i = 0; _i < 2; ++_i) \
        __builtin_amdgcn_global_load_lds((const unsigned*)((const char*)(gbase) + (voff)[_i]), (LAS unsigned*)(lds + (bufoff) + ldsw + _i * 8192), 16, 0, 0); } while (0)
#define PG8_LDA(dst, b, h) do { _Pragma("unroll") for (int m = 0; m < 4; ++m) _Pragma("unroll") for (int k = 0; k < 2; ++k) dst[m][k] = *(const LAS bf16x8*)(lds + PG8_SA(b, h) + aoff + m * 2048 + k * 1024); } while (0)
#define PG8_LDB(dst, b, h) do { _Pragma("unroll") for (int n = 0; n < 2; ++n) _Pragma("unroll") for (int k = 0; k < 2; ++k) dst[n][k] = *(const LAS bf16x8*)(lds + PG8_SB(b, h) + boff + n * 2048 + k * 1024); } while (0)
#define PG8_MMA(ai, bj, At, Bt) do { __builtin_amdgcn_s_setprio(1); _Pragma("unroll") for (int m = 0; m < 4; ++m) _Pragma("unroll") for (int n = 0; n < 2; ++n) _Pragma("unroll") for (int k = 0; k < 2; ++k) \
        acc[ai][bj][m][n] = __builtin_amdgcn_mfma_f32_16x16x32_bf16(Bt[n][k], At[m][k], acc[ai][bj][m][n], 0, 0, 0); __builtin_amdgcn_s_setprio(0); } while (0)
#define PG8_WAIT_V(n) asm volatile("s_waitcnt vmcnt(" #n ")" ::: "memory")
#define PG8_WAIT_L(n) asm volatile("s_waitcnt lgkmcnt(" #n ")" ::: "memory")
#define PG8_BAR __builtin_amdgcn_s_barrier()
#define PG8_SCHED __builtin_amdgcn_sched_barrier(0)
    Unit cur, nxt; int ui = 0;
    if (!S.next(0, cur)) return;
    Acc acc;
#pragma unroll
    for (int a = 0; a < 2; ++a)
#pragma unroll
        for (int b = 0; b < 2; ++b)
#pragma unroll
            for (int m = 0; m < 4; ++m)
#pragma unroll
                for (int n = 0; n < 2; ++n) acc[a][b][m][n] = (f32x4){0.f, 0.f, 0.f, 0.f};
    bf16x8 At[4][2], B0[2][2], B1[2][2];
    const char* cA = PG8_UA(cur); const char* cB = PG8_UB(cur);
    PG8_STAGE(PG8_SB(0, 0), cB, voffB); PG8_STAGE(PG8_SB(0, 1), cB + hstepB, voffB); PG8_STAGE(PG8_SA(0, 0), cA, voffA); PG8_STAGE(PG8_SA(0, 1), cA + hstepA, voffA);
    if (wr == 1) PG8_BAR;
    PG8_WAIT_V(2); PG8_BAR;
    PG8_STAGE(PG8_SB(1, 0), cB + kstep, voffB); PG8_STAGE(PG8_SA(1, 0), cA + kstep, voffA); PG8_STAGE(PG8_SB(1, 1), cB + hstepB + kstep, voffB);
    PG8_WAIT_V(6); PG8_BAR;
    for (;;) {
        const bool has_next = S.next(ui + 1, nxt);
        const char* nA = has_next ? PG8_UA(nxt) : cA; const char* nB = has_next ? PG8_UB(nxt) : cB;
        for (int t = 0; t < nt; t += 2) {
            const bool last = (t == nt - 2);
            const char* a1 = cA + (size_t)(t + 1) * kstep;
            const char* a2 = last ? nA : cA + (size_t)(t + 2) * kstep; const char* b2 = last ? nB : cB + (size_t)(t + 2) * kstep;
            const char* a3 = a2 + kstep; const char* b3 = b2 + kstep;
            PG8_LDB(B0, 0, 0); PG8_LDB(B1, 0, 1); PG8_SCHED; PG8_LDA(At, 0, 0); PG8_STAGE(PG8_SA(1, 1), a1 + hstepA, voffA);
            PG8_WAIT_V(8); PG8_WAIT_L(0); PG8_BAR; PG8_MMA(0, 0, At, B0); PG8_MMA(0, 1, At, B1); PG8_BAR; PG8_SCHED;
            PG8_LDA(At, 0, 1); PG8_STAGE(PG8_SB(0, 0), b2, voffB); PG8_STAGE(PG8_SB(0, 1), b2 + hstepB, voffB); PG8_STAGE(PG8_SA(0, 0), a2, voffA);
            PG8_WAIT_V(8); PG8_WAIT_L(0); PG8_BAR; PG8_MMA(1, 0, At, B0); PG8_MMA(1, 1, At, B1); PG8_BAR; PG8_SCHED;
            PG8_LDB(B0, 1, 0); PG8_LDB(B1, 1, 1); PG8_SCHED; PG8_LDA(At, 1, 0); PG8_STAGE(PG8_SA(0, 1), a2 + hstepA, voffA);
            PG8_WAIT_V(8); PG8_WAIT_L(0); PG8_BAR; PG8_MMA(0, 0, At, B0); PG8_MMA(0, 1, At, B1); PG8_BAR; PG8_SCHED;
            PG8_LDA(At, 1, 1); PG8_STAGE(PG8_SB(1, 0), b3, voffB); PG8_STAGE(PG8_SB(1, 1), b3 + hstepB, voffB); PG8_STAGE(PG8_SA(1, 0), a3, voffA);
            PG8_WAIT_V(8); PG8_WAIT_L(0); PG8_BAR; PG8_MMA(1, 0, At, B0); PG8_MMA(1, 1, At, B1); PG8_BAR; PG8_SCHED;
        }
        if constexpr (ALIGN_EPI) { if (wr == 0) PG8_BAR; }
        E(acc, cur, wr, wc, fr, fq);
        if (!has_next) break;
#pragma unroll
        for (int a = 0; a < 2; ++a)
#pragma unroll
            for (int b = 0; b < 2; ++b)
#pragma unroll
                for (int m = 0; m < 4; ++m)
#pragma unroll
                    for (int n = 0; n < 2; ++n) acc[a][b][m][n] = (f32x4){0.f, 0.f, 0.f, 0.f};
        cur = nxt; cA = nA; cB = nB; ++ui;
        if constexpr (ALIGN_EPI) { if (wr == 1) PG8_BAR; }
    }
    PG8_WAIT_V(0);
    if constexpr (!ALIGN_EPI) { if (wr == 0) PG8_BAR; }
    PG8_BAR;
#undef PG8_UA
#undef PG8_UB
#undef PG8_SA
#undef PG8_SB
#undef PG8_STAGE
#undef PG8_LDA
#undef PG8_LDB
#undef PG8_MMA
#undef PG8_WAIT_V
#undef PG8_WAIT_L
#undef PG8_BAR
#undef PG8_SCHED
}
}

struct Args { const float* in[35]; float* out; unsigned char* ws; int ph_lo, ph_hi, coop, pad; };
enum { I_X = 0, I_MEM, I_LNIN_G, I_LNIN_B, I_WIN, I_RPB, I_CONVW, I_CONVB, I_DTB, I_ALOG, I_SSDD, I_SSDNW, I_LRE, I_LIM, I_LOGDT, I_BRE, I_BIM, I_CRE, I_CIM, I_S5D, I_GLUW, I_GLUB,
       I_WOUT, I_LNMIX_G, I_LNMIX_B, I_WQ, I_WK, I_WV, I_WO, I_LNXA_G, I_LNXA_B, I_W1, I_W2, I_LNMLP_G, I_LNMLP_B };

__device__ __forceinline__ int opq(int i) { asm volatile("" : "+s"(i)); return i; }
__device__ __forceinline__ void transpose_item(const float* W, int K, int N, bf16_t* WT, LAS float* scr, int item, int nblk, int lane, const float* rs) {
    const int kb = item / nblk, nb = item % nblk, k0 = 64 * kb, n0 = 32 * nb;
    const int nn = n0 + (lane & 31);
#pragma unroll
    for (int i = 0; i < 32; ++i) { const int kk = 2 * i + (lane >> 5); scr[kk * 33 + (lane & 31)] = (nn < N) ? W[(size_t)(k0 + kk) * N + nn] * (rs ? rs[k0 + kk] : 1.f) : 0.f; }
    LDS_WAIT();
    const int c = lane & 7;
#pragma unroll
    for (int j = 0; j < 4; ++j) { const int n = (lane >> 3) + 8 * j; const LAS float* s = scr + (8 * c) * 33 + n;
        u32x4 o; o.x = pk2(s[0 * 33], s[1 * 33]); o.y = pk2(s[2 * 33], s[3 * 33]); o.z = pk2(s[4 * 33], s[5 * 33]); o.w = pk2(s[6 * 33], s[7 * 33]);
        *(u32x4*)(WT + (size_t)(n0 + n) * K + k0 + 8 * c) = o; }
    LDS_WAIT();
}
__device__ __forceinline__ void tr_matrix(const float* W, int K, int N, int nblk, bf16_t* WT, LAS float* scr, int gw, int NGW, int lane, const float* rs = nullptr) {
    const int nitems = (K / 64) * nblk;
    for (int it = gw; it < nitems; it += NGW) transpose_item(W, K, N, WT, scr, it, nblk, lane, rs);
}
__device__ __forceinline__ void ln_row(const float* xrow, float* hrow, bf16_t* brow, const float* gam, const float* bet, int lane) {
    const f32x4* xr = (const f32x4*)xrow + lane;
    f32x4 v[4]; float s = 0.f;
#pragma unroll
    for (int j = 0; j < 4; ++j) { v[j] = xr[64 * j]; s += (v[j].x + v[j].y) + (v[j].z + v[j].w); }
    const float mean = wave_sum(s) * (1.f / D_); float s2 = 0.f;
#pragma unroll
    for (int j = 0; j < 4; ++j) { v[j] = v[j] - mean; s2 += (v[j].x * v[j].x + v[j].y * v[j].y) + (v[j].z * v[j].z + v[j].w * v[j].w); }
    const float rstd = rsqrtf(wave_sum(s2) * (1.f / D_) + LN_EPS);
    f32x4* ho = (f32x4*)hrow + lane; u32x2* bo = (u32x2*)brow + lane;
#pragma unroll
    for (int j = 0; j < 4; ++j) { const f32x4 g = ((const f32x4*)gam)[lane + 64 * j], b = ((const f32x4*)bet)[lane + 64 * j];
        const f32x4 y = v[j] * rstd * g + b; ho[64 * j] = y; u32x2 w; w.x = pk2(y.x, y.y); w.y = pk2(y.z, y.w); bo[64 * j] = w; }
}

__device__ __forceinline__ void ln_row2(const float* x0, const float* x1, float* h0, float* h1, bf16_t* b0, bf16_t* b1, const float* gam, const float* bet, int lane) {
    const f32x4* xr0 = (const f32x4*)x0 + lane; const f32x4* xr1 = (const f32x4*)x1 + lane;
    f32x4 v[4], w[4]; float s = 0.f, t = 0.f;
#pragma unroll
    for (int j = 0; j < 4; ++j) { v[j] = xr0[64 * j]; w[j] = xr1[64 * j]; }
#pragma unroll
    for (int j = 0; j < 4; ++j) { s += (v[j].x + v[j].y) + (v[j].z + v[j].w); t += (w[j].x + w[j].y) + (w[j].z + w[j].w); }
#pragma unroll
    for (int o = 1; o < 64; o <<= 1) { s += __shfl_xor(s, o); t += __shfl_xor(t, o); }
    const float m0 = s * (1.f / D_), m1 = t * (1.f / D_); float s2 = 0.f, t2 = 0.f;
#pragma unroll
    for (int j = 0; j < 4; ++j) { v[j] = v[j] - m0; w[j] = w[j] - m1; s2 += (v[j].x * v[j].x + v[j].y * v[j].y) + (v[j].z * v[j].z + v[j].w * v[j].w); t2 += (w[j].x * w[j].x + w[j].y * w[j].y) + (w[j].z * w[j].z + w[j].w * w[j].w); }
#pragma unroll
    for (int o = 1; o < 64; o <<= 1) { s2 += __shfl_xor(s2, o); t2 += __shfl_xor(t2, o); }
    const float r0 = rsqrtf(s2 * (1.f / D_) + LN_EPS), r1 = rsqrtf(t2 * (1.f / D_) + LN_EPS);
    f32x4* ho0 = (f32x4*)h0 + lane; f32x4* ho1 = (f32x4*)h1 + lane; u32x2* bo0 = (u32x2*)b0 + lane; u32x2* bo1 = (u32x2*)b1 + lane;
#pragma unroll
    for (int j = 0; j < 4; ++j) { const f32x4 g = ((const f32x4*)gam)[lane + 64 * j], b = ((const f32x4*)bet)[lane + 64 * j];
        const f32x4 y0 = v[j] * r0 * g + b, y1 = w[j] * r1 * g + b; if (h0) { ho0[64 * j] = y0; ho1[64 * j] = y1; }
        if (b0) { u32x2 p; p.x = pk2(y0.x, y0.y); p.y = pk2(y0.z, y0.w); bo0[64 * j] = p; p.x = pk2(y1.x, y1.y); p.y = pk2(y1.z, y1.w); bo1[64 * j] = p; } }
}
__device__ __forceinline__ void s5_item(const Args& a, LAS unsigned char* lds, int item, int tid) {
    const int j = item & 15, g = (item >> 4) & 15, l = item >> 8;
    LAS f32x2* Ap = (LAS f32x2*)(lds + 73728);
    LAS f32x2* Bb = (LAS f32x2*)(lds + 73728 + 17408);
    LAS f32x2* Cc = (LAS f32x2*)(lds + 73728 + 17408 + 16384);
    for (int e = tid; e < 2 * 17 * 64; e += 512) { const int p = e & 63, d = (e >> 6) % 17, dir = e / (17 * 64);
        const int gi = (l * 2 + dir) * 16 + g; const float dt = expf(gp(a.in[I_LOGDT])[gi]); const float lr = gp(a.in[I_LRE])[gi * 64 + p], li = gp(a.in[I_LIM])[gi * 64 + p];
        const float mag = expf((float)d * lr * dt); const float th = (float)d * (li * dt); Ap[e] = (f32x2){mag * cosf(th), mag * sinf(th)}; }
    for (int e = tid; e < 2 * 64 * 16; e += 512) { const int h = e & 15, p = (e >> 4) & 63, dir = e >> 10;
        const int gi = (l * 2 + dir) * 16 + g; const float dt = expf(gp(a.in[I_LOGDT])[gi]); const float lr = gp(a.in[I_LRE])[gi * 64 + p], li = gp(a.in[I_LIM])[gi * 64 + p];
        const float mag = expf(lr * dt); const float ar = mag * cosf(li * dt), ai = mag * sinf(li * dt); const float den = lr * lr + li * li;
        const float fr = ((ar - 1.f) * lr + ai * li) / den, fi = (ai * lr - (ar - 1.f) * li) / den;
        const float br = gp(a.in[I_BRE])[((size_t)gi * 64 + p) * 16 + h], bi = gp(a.in[I_BIM])[((size_t)gi * 64 + p) * 16 + h];
        Bb[e] = (f32x2){fr * br - fi * bi, fr * bi + fi * br}; }
    for (int e = tid; e < 2 * 16 * 64; e += 512) { const int p = e & 63, h = (e >> 6) & 15, dir = e >> 10;
        const int gi = (l * 2 + dir) * 16 + g; Cc[e] = (f32x2){gp(a.in[I_CRE])[((size_t)gi * 16 + h) * 64 + p], gp(a.in[I_CIM])[((size_t)gi * 16 + h) * 64 + p]}; }
    __syncthreads();
    bf16_t* TM = (bf16_t*)(lptr(a.ws) + WS_TM) + ((size_t)(l * 16 + g) * 256 + j * 16) * 512;
    for (int e = tid; e < 16 * 512; e += 512) { const int k = e & 511, ho = e >> 9; float v = 0.f;
        if (k < 256) { const int i = k >> 4, hi = k & 15;
            if (i <= j) { const int dd = j - i; float s = 0.f;
                for (int p = 0; p < 64; ++p) { const f32x2 c = Cc[(0 * 16 + ho) * 64 + p], ap = Ap[(0 * 17 + dd) * 64 + p], bb = Bb[(0 * 64 + p) * 16 + hi];
                    const float wr_ = c.x * ap.x - c.y * ap.y, wi_ = c.x * ap.y + c.y * ap.x; s += wr_ * bb.x - wi_ * bb.y; }
                v += s; }
            if (i >= j) { const int dd = i - j; float s = 0.f;
                for (int p = 0; p < 64; ++p) { const f32x2 c = Cc[(1 * 16 + ho) * 64 + p], ap = Ap[(1 * 17 + dd) * 64 + p], bb = Bb[(1 * 64 + p) * 16 + hi];
                    const float wr_ = c.x * ap.x - c.y * ap.y, wi_ = c.x * ap.y + c.y * ap.x; s += wr_ * bb.x - wi_ * bb.y; }
                v += s; }
            if (i == j && hi == ho) v += gp(a.in[I_S5D])[l * 256 + g * 16 + ho];
        } else { const int dir = (k >= 384), p = ((k - 256) & 127) >> 1, ri = k & 1; const int dd = dir ? 16 - j : j + 1;
            const f32x2 c = Cc[(dir * 16 + ho) * 64 + p], ap = Ap[(dir * 17 + dd) * 64 + p];
            v = ri ? -(c.x * ap.y + c.y * ap.x) : (c.x * ap.x - c.y * ap.y); }
        TM[(size_t)ho * 512 + k] = (bf16_t)f2bf(v); }
    bf16_t* SM = (bf16_t*)(lptr(a.ws) + WS_SM) + ((size_t)(l * 16 + g) * 256 + j * 16) * 256;
    for (int e = tid; e < 16 * 256; e += 512) { const int k = e & 255, nn = e >> 8, n = j * 16 + nn; const int dir = n >> 7, p = (n & 127) >> 1, ri = n & 1, i = k >> 4, hi = k & 15;
        const int dd = dir ? i : 15 - i; const f32x2 ap = Ap[(dir * 17 + dd) * 64 + p], bb = Bb[(dir * 64 + p) * 16 + hi];
        const float v = ri ? (ap.x * bb.y + ap.y * bb.x) : (ap.x * bb.x - ap.y * bb.y);
        SM[(size_t)nn * 256 + k] = (bf16_t)f2bf(v); }
    if (j == 0 && tid < 128) { const int dir = tid >> 6, p = tid & 63; ((f32x2*)(lptr(a.ws) + WS_MISC))[((l * 2 + dir) * 16 + g) * 64 + p] = Ap[(dir * 17 + 16) * 64 + p]; }
    __syncthreads();
}

__device__ __forceinline__ void prologue(const Args& a, LAS unsigned char* lds, int G) {
    const int tid = ltid(), lane = tid & 63, wave = tid >> 6;
    const int gw = lbid() * 8 + wave, NGW = G * 8;
    LAS float* scr = (LAS float*)(lds + wave * 8448);
    for (int l = 0; l < 2; ++l) {
        unsigned char* wb = lptr(a.ws) + WS_W + l * LWB;
        tr_matrix(gp(a.in[I_WIN]) + (size_t)l * D_ * NP, D_, NP, NPP / 32, (bf16_t*)(wb + OW_IN), scr, gw, NGW, lane, l == 1 ? gp(a.in[I_LNMLP_G]) : nullptr);
        tr_matrix(gp(a.in[I_WOUT]) + (size_t)l * D_ * D_, D_, D_, 32, (bf16_t*)(wb + OW_OUT), scr, gw, NGW, lane);
        tr_matrix(gp(a.in[I_WQ]) + (size_t)l * D_ * D_, D_, D_, 32, (bf16_t*)(wb + OW_Q), scr, gw, NGW, lane, gp(a.in[I_LNMIX_G]) + l * D_);
        tr_matrix(gp(a.in[I_WK]) + (size_t)l * D_ * D_, D_, D_, 32, (bf16_t*)(wb + OW_K), scr, gw, NGW, lane);
        tr_matrix(gp(a.in[I_WV]) + (size_t)l * D_ * D_, D_, D_, 32, (bf16_t*)(wb + OW_V), scr, gw, NGW, lane);
        tr_matrix(gp(a.in[I_WO]) + (size_t)l * D_ * D_, D_, D_, 32, (bf16_t*)(wb + OW_O), scr, gw, NGW, lane);
        tr_matrix(gp(a.in[I_W1]) + (size_t)l * D_ * FF_, D_, FF_, 128, (bf16_t*)(wb + OW_1), scr, gw, NGW, lane, gp(a.in[I_LNXA_G]) + l * D_);
        tr_matrix(gp(a.in[I_W2]) + (size_t)l * FF_ * D_, FF_, D_, 32, (bf16_t*)(wb + OW_2), scr, gw, NGW, lane);
        tr_matrix(gp(a.in[I_GLUW]) + (size_t)l * 256 * 256, 256, 256, 8, (bf16_t*)(wb + OW_GLU), scr, gw, NGW, lane);
    }
    { const int gt = lbid() * 512 + tid, NT = G * 512; const f32x4* src = (const f32x4*)gp(a.in[I_MEM]); u32x2* dst = (u32x2*)(lptr(a.ws) + WS_MEMB);
      for (int i = gt; i < B_ * MEMT * D_ / 4; i += NT) { const f32x4 v = src[i]; u32x2 w; w.x = pk2(v.x, v.y); w.y = pk2(v.z, v.w); dst[i] = w; } }
    __syncthreads();
    for (int it = lbid(); it < 512; it += G) s5_item(a, lds, it, tid);
    { const float* X = gp(a.in[I_X]); float* H = lptr(a.out); bf16_t* HBp = (bf16_t*)(lptr(a.ws) + WS_HB);
      for (int m = gw; m < M_ / 2; m += NGW) { const size_t r0 = (size_t)m * D_, r1 = (size_t)(m + M_ / 2) * D_;
          ln_row2(X + r0, X + r1, (float*)nullptr, (float*)nullptr, HBp + r0, HBp + r1, gp(a.in[I_LNIN_G]), gp(a.in[I_LNIN_B]), lane); } }
}


__device__ __forceinline__ float* cs_ptr(unsigned char* ws, int l, int set) {
    float* base = (float*)(ws + WS_MISC + MISC_CS) + (size_t)l * 16384;
    return base + (set == 0 ? 0 : set == 1 ? 2048 : 10240);
}
__device__ __forceinline__ void colsum_set(const bf16_t* WT, int N, const float* gam, const float* bet, float* CS, int gw, int NGW, int lane) {
    for (int n = gw; n < N; n += NGW) { const bf16_t* r = WT + (size_t)n * D_; float s = 0.f, c = 0.f;
#pragma unroll
        for (int j = 0; j < 2; ++j) { const int k = (lane + 64 * j) * 8; const u32x4 v = *(const u32x4*)(r + k);
            const f32x4 g0 = *(const f32x4*)(gam + k), g1 = *(const f32x4*)(gam + k + 4), b0 = *(const f32x4*)(bet + k), b1 = *(const f32x4*)(bet + k + 4);
            const float w[8] = {bflo(v.x), bfhi(v.x), bflo(v.y), bfhi(v.y), bflo(v.z), bfhi(v.z), bflo(v.w), bfhi(v.w)};
            s += ((w[0] + w[1]) + (w[2] + w[3])) + ((w[4] + w[5]) + (w[6] + w[7]));
            c += w[0] * (b0[0] / g0[0]) + w[1] * (b0[1] / g0[1]) + w[2] * (b0[2] / g0[2]) + w[3] * (b0[3] / g0[3]) + w[4] * (b1[0] / g1[0]) + w[5] * (b1[1] / g1[1]) + w[6] * (b1[2] / g1[2]) + w[7] * (b1[3] / g1[3]); }
        s = wave_sum(s); c = wave_sum(c);
        if (lane == 0) { CS[n] = s; CS[N + n] = c; } }
}
__device__ __forceinline__ void colsum_phase(const Args& a, int G) {
    const int tid = ltid(), lane = tid & 63, gw = lbid() * 8 + (tid >> 6), NGW = G * 8;
    unsigned char* ws = lptr(a.ws);
    for (int l = 0; l < 2; ++l) { unsigned char* wb = ws + WS_W + (size_t)l * LWB;
        colsum_set((const bf16_t*)(wb + OW_Q), D_, gp(a.in[I_LNMIX_G]) + l * D_, gp(a.in[I_LNMIX_B]) + l * D_, cs_ptr(ws, l, 0), gw, NGW, lane);
        colsum_set((const bf16_t*)(wb + OW_1), FF_, gp(a.in[I_LNXA_G]) + l * D_, gp(a.in[I_LNXA_B]) + l * D_, cs_ptr(ws, l, 1), gw, NGW, lane);
        if (l == 1) colsum_set((const bf16_t*)(wb + OW_IN), NPP, gp(a.in[I_LNMLP_G]), gp(a.in[I_LNMLP_B]), cs_ptr(ws, l, 2), gw, NGW, lane); }
}
__device__ __forceinline__ void na_phase(const bf16_t* PROJ, bf16_t* MIXED, const float* rpb, int G) {
    const int tid = ltid();
    for (int it = lbid(); it < 512; it += G) {
        const int h = it & 3, rg = (it >> 2) & 15, b = it >> 6;
        const int r = rg * 8 + (tid >> 6), c = tid & 63;
        const size_t row = (size_t)b * T_ + r * 64 + c;
        float q[64], o[64];
        { const u32x4* qp = (const u32x4*)(PROJ + row * NP + PQ + h * 64);
#pragma unroll
          for (int i = 0; i < 8; ++i) { const u32x4 v = qp[i]; q[8 * i + 0] = bflo(v.x) * 0.125f; q[8 * i + 1] = bfhi(v.x) * 0.125f; q[8 * i + 2] = bflo(v.y) * 0.125f; q[8 * i + 3] = bfhi(v.y) * 0.125f;
              q[8 * i + 4] = bflo(v.z) * 0.125f; q[8 * i + 5] = bfhi(v.z) * 0.125f; q[8 * i + 6] = bflo(v.w) * 0.125f; q[8 * i + 7] = bfhi(v.w) * 0.125f; } }
#pragma unroll
        for (int d = 0; d < 64; ++d) o[d] = 0.f;
        const int r0 = min(max(r - 4, 0), 120), c0 = min(max(c - 8, 0), 48);
        float mx = -1e30f, lsum = 0.f;
        const float* rp = rpb + h * 15 * 31;
#pragma unroll 1
        for (int kk = 0; kk < 128; ++kk) {
            const int kr = kk >> 4, kc = kk & 15;
            const int krow = r0 + kr;
            const bf16_t* kptr = PROJ + ((size_t)b * T_ + krow * 64 + c0 + kc) * NP + PK + h * 64;
            const u32x4* kp = (const u32x4*)kptr; float acc = 0.f;
#pragma unroll
            for (int i = 0; i < 8; ++i) { const u32x4 v = kp[i];
                acc += q[8 * i + 0] * bflo(v.x) + q[8 * i + 1] * bfhi(v.x) + q[8 * i + 2] * bflo(v.y) + q[8 * i + 3] * bfhi(v.y)
                     + q[8 * i + 4] * bflo(v.z) + q[8 * i + 5] * bfhi(v.z) + q[8 * i + 6] * bflo(v.w) + q[8 * i + 7] * bfhi(v.w); }
            int dc = c0 + kc - c; dc = min(max(dc, -15), 15);
            const float sc = acc + rp[(krow - r + 7) * 31 + dc + 15];
            if (sc > mx) { const float al = __expf(mx - sc); mx = sc; lsum *= al;
#pragma unroll
                for (int d = 0; d < 64; ++d) o[d] *= al; }
            const float p = __expf(sc - mx); lsum += p; const u32x4* vp = (const u32x4*)(kptr + (PV - PK));
#pragma unroll
            for (int i = 0; i < 8; ++i) { const u32x4 v = vp[i];
                o[8 * i + 0] += p * bflo(v.x); o[8 * i + 1] += p * bfhi(v.x); o[8 * i + 2] += p * bflo(v.y); o[8 * i + 3] += p * bfhi(v.y);
                o[8 * i + 4] += p * bflo(v.z); o[8 * i + 5] += p * bfhi(v.z); o[8 * i + 6] += p * bflo(v.w); o[8 * i + 7] += p * bfhi(v.w); }
        }
        const float inv = 1.f / lsum; u32x4* op = (u32x4*)(MIXED + row * D_ + h * 64);
#pragma unroll
        for (int i = 0; i < 8; ++i) { u32x4 w; w.x = pk2(o[8 * i] * inv, o[8 * i + 1] * inv); w.y = pk2(o[8 * i + 2] * inv, o[8 * i + 3] * inv); w.z = pk2(o[8 * i + 4] * inv, o[8 * i + 5] * inv); w.w = pk2(o[8 * i + 6] * inv, o[8 * i + 7] * inv); op[i] = w; }
    }
}

__device__ __forceinline__ void conv_phase(const bf16_t* PROJ, bf16_t* CONV, const float* cw, const float* cb, int G) {
    const int gt = lbid() * 512 + ltid(), NT = G * 512;
    for (int idx = gt; idx < (M_ / 8) * 96; idx += NT) { const int rb = idx / 96, ch = (idx - rb * 96) * 8, row0 = rb * 8, t0 = row0 & (T_ - 1);
        u32x4 x[12];
#pragma unroll
        for (int i = 0; i < 12; ++i) { const int tt = t0 + i - 2; x[i] = (tt >= 0 && tt < T_) ? *(const u32x4*)(PROJ + (size_t)(row0 + i - 2) * NP + PX + ch) : (u32x4){0u, 0u, 0u, 0u}; }
        float w[5][8], bias[8];
#pragma unroll
        for (int jj = 0; jj < 5; ++jj) { const f32x4 w0 = *(const f32x4*)(cw + jj * 768 + ch), w1 = *(const f32x4*)(cw + jj * 768 + ch + 4);
            w[jj][0] = w0[0]; w[jj][1] = w0[1]; w[jj][2] = w0[2]; w[jj][3] = w0[3]; w[jj][4] = w1[0]; w[jj][5] = w1[1]; w[jj][6] = w1[2]; w[jj][7] = w1[3]; }
        { const f32x4 b0 = *(const f32x4*)(cb + ch), b1 = *(const f32x4*)(cb + ch + 4); bias[0] = b0[0]; bias[1] = b0[1]; bias[2] = b0[2]; bias[3] = b0[3]; bias[4] = b1[0]; bias[5] = b1[1]; bias[6] = b1[2]; bias[7] = b1[3]; }
#pragma unroll
        for (int o = 0; o < 8; ++o) { float acc[8];
#pragma unroll
            for (int e = 0; e < 8; ++e) acc[e] = bias[e];
#pragma unroll
            for (int jj = 0; jj < 5; ++jj) { const u32x4 v = x[o + jj];
                acc[0] += w[jj][0] * bflo(v.x); acc[1] += w[jj][1] * bfhi(v.x); acc[2] += w[jj][2] * bflo(v.y); acc[3] += w[jj][3] * bfhi(v.y);
                acc[4] += w[jj][4] * bflo(v.z); acc[5] += w[jj][5] * bfhi(v.z); acc[6] += w[jj][6] * bflo(v.w); acc[7] += w[jj][7] * bfhi(v.w); }
            u32x4 r; r.x = pk2(silu_f(acc[0]), silu_f(acc[1])); r.y = pk2(silu_f(acc[2]), silu_f(acc[3])); r.z = pk2(silu_f(acc[4]), silu_f(acc[5])); r.w = pk2(silu_f(acc[6]), silu_f(acc[7]));
            *(u32x4*)(CONV + (size_t)(row0 + o) * 768 + ch) = r; } }
}
__device__ __forceinline__ void s5_gather_phase(const bf16_t* PROJ, bf16_t* UX, int G) {
    const int gt = lbid() * 512 + ltid(), NT = G * 512;
    for (int idx = gt; idx < M_ * 32; idx += NT) { const int row = idx >> 5, part = idx & 31, g = part >> 1, hf = part & 1, b = row >> 13, t = row & (T_ - 1), c = t >> 4, i = t & 15;
        const u32x4 v = *(const u32x4*)(PROJ + (size_t)row * NP + PU + g * 16 + hf * 8);
        *(u32x4*)(UX + ((size_t)g * 4096 + b * 512 + c) * 512 + i * 16 + hf * 8) = v; }
}

__device__ __forceinline__ float softplus_f(float x) { return x > 20.f ? x : log1pf(expf(x)); }

__device__ __forceinline__ void ssd_passA(const Args& a, int l, LAS unsigned char* lds, int G) {
    const bf16_t* PROJ = (const bf16_t*)(lptr(a.ws) + WS_PROJ); const bf16_t* CONV = (const bf16_t*)(lptr(a.ws) + WS_CONV);
    float* ST = (float*)(lptr(a.ws) + WS_ST); float* CD = (float*)(lptr(a.ws) + WS_MISC + 65536);
    const int tid = ltid(), sub = tid & 255, dir = tid >> 8, p = sub >> 2, nq = sub & 3;
    LAS float* dts = (LAS float*)lds; LAS float* dAs = dts + 256;
    for (int it = lbid(); it < 4096; it += G) {
        const int hd = it & 7, c = (it >> 3) & 63, b = it >> 9, g = hd >> 2;
        if (sub < 128) { const int s = sub; const size_t row = (size_t)b * T_ + c * 128 + s;
            const float raw = bf2f(PROJ[row * NP + PDT + dir * 8 + hd]); const float dt = softplus_f(raw + gp(a.in[I_DTB])[(l * 2 + dir) * 8 + hd]);
            const float av = -expf(gp(a.in[I_ALOG])[(l * 2 + dir) * 8 + hd]); dts[dir * 128 + s] = dt; dAs[dir * 128 + s] = expf(dt * av); }
        __syncthreads();
        float h[16];
#pragma unroll
        for (int j = 0; j < 16; ++j) h[j] = 0.f;
        float cdp = 1.f;
        for (int ss = 0; ss < 128; ++ss) { const int s = dir ? 127 - ss : ss; const size_t row = (size_t)b * T_ + c * 128 + s;
            const float dA = dAs[dir * 128 + s], dtv = dts[dir * 128 + s];
            const float xv = bf2f(CONV[row * 768 + hd * 64 + p]) * dtv;
            const u32x4* bp = (const u32x4*)(CONV + row * 768 + 512 + g * 64 + nq * 16); const u32x4 b0 = bp[0], b1 = bp[1];
            const unsigned bw[8] = {b0.x, b0.y, b0.z, b0.w, b1.x, b1.y, b1.z, b1.w};
#pragma unroll
            for (int j = 0; j < 8; ++j) { h[2 * j] = h[2 * j] * dA + xv * bflo(bw[j]); h[2 * j + 1] = h[2 * j + 1] * dA + xv * bfhi(bw[j]); }
            cdp *= dA; }
        float* sp = ST + ((((size_t)(b * 64 + c) * 8 + hd) * 2 + dir) * 64 + p) * 64 + nq * 16;
#pragma unroll
        for (int j = 0; j < 4; ++j) ((f32x4*)sp)[j] = (f32x4){h[4 * j], h[4 * j + 1], h[4 * j + 2], h[4 * j + 3]};
        if (sub == 0) CD[((b * 64 + c) * 8 + hd) * 2 + dir] = cdp;
        __syncthreads();
    }
}
__device__ __forceinline__ void ssd_scan(const Args& a, int G) {
    float* ST = (float*)(lptr(a.ws) + WS_ST); const float* CD = (const float*)(lptr(a.ws) + WS_MISC + 65536);
    const int gt = lbid() * 512 + ltid(), NT = G * 512;
    for (int e = gt; e < 8 * 8 * 2 * 4096; e += NT) { const int pn = e & 4095, dir = (e >> 12) & 1, hd = (e >> 13) & 7, b = e >> 16;
        float H = 0.f;
#pragma unroll 8
        for (int cc = 0; cc < 64; ++cc) { const int c = dir ? 63 - cc : cc; const size_t idx = (((size_t)(b * 64 + c) * 8 + hd) * 2 + dir);
            const float tmp = ST[idx * 4096 + pn]; ST[idx * 4096 + pn] = H; H = H * CD[idx] + tmp; } }
}
__device__ __forceinline__ void ssd_passC(const Args& a, int l, LAS unsigned char* lds, int G) {
    const bf16_t* PROJ = (const bf16_t*)(lptr(a.ws) + WS_PROJ); const bf16_t* CONV = (const bf16_t*)(lptr(a.ws) + WS_CONV); bf16_t* MIXED = (bf16_t*)(lptr(a.ws) + WS_MIXED);
    const float* ST = (const float*)(lptr(a.ws) + WS_ST);
    const int tid = ltid(), sub = tid & 255, half = tid >> 8, p = sub >> 2, nq = sub & 3;
    LAS float* dts = (LAS float*)lds + half * 512; LAS float* dAs = dts + 256;
    LAS float* yl = (LAS float*)(lds + 8192) + half * 8192;
    for (int it = lbid(); it < 2048; it += G) {
        const int hp = it & 3, c = (it >> 2) & 63, b = it >> 8, hd = hp * 2 + half, g = hd >> 2;
        { const int dir = sub >> 7, s = sub & 127; const size_t row = (size_t)b * T_ + c * 128 + s;
          const float raw = bf2f(PROJ[row * NP + PDT + dir * 8 + hd]); const float dt = softplus_f(raw + gp(a.in[I_DTB])[(l * 2 + dir) * 8 + hd]);
          const float av = -expf(gp(a.in[I_ALOG])[(l * 2 + dir) * 8 + hd]); dts[dir * 128 + s] = dt; dAs[dir * 128 + s] = expf(dt * av); }
        __syncthreads();
#pragma unroll 1
        for (int dir = 0; dir < 2; ++dir) {
            float h[16];
            const float* sp = ST + ((((size_t)(b * 64 + c) * 8 + hd) * 2 + dir) * 64 + p) * 64 + nq * 16;
#pragma unroll
            for (int j = 0; j < 4; ++j) { const f32x4 v = ((const f32x4*)sp)[j]; h[4 * j] = v.x; h[4 * j + 1] = v.y; h[4 * j + 2] = v.z; h[4 * j + 3] = v.w; }
#pragma unroll 2
            for (int ss = 0; ss < 128; ++ss) { const int s = dir ? 127 - ss : ss; const size_t row = (size_t)b * T_ + c * 128 + s;
                const float dA = dAs[dir * 128 + s], dtv = dts[dir * 128 + s];
                const float xv = bf2f(CONV[row * 768 + hd * 64 + p]) * dtv;
                const u32x4* bp = (const u32x4*)(CONV + row * 768 + 512 + g * 64 + nq * 16); const u32x4 b0 = bp[0], b1 = bp[1];
                const u32x4* cp = (const u32x4*)(CONV + row * 768 + 640 + g * 64 + nq * 16); const u32x4 c0 = cp[0], c1 = cp[1];
                const unsigned bw[8] = {b0.x, b0.y, b0.z, b0.w, b1.x, b1.y, b1.z, b1.w}; const unsigned cw[8] = {c0.x, c0.y, c0.z, c0.w, c1.x, c1.y, c1.z, c1.w};
                float y = 0.f;
#pragma unroll
                for (int j = 0; j < 8; ++j) { h[2 * j] = h[2 * j] * dA + xv * bflo(bw[j]); h[2 * j + 1] = h[2 * j + 1] * dA + xv * bfhi(bw[j]);
                    y += h[2 * j] * bflo(cw[j]) + h[2 * j + 1] * bfhi(cw[j]); }
                y += __shfl_xor(y, 1); y += __shfl_xor(y, 2);
                if (nq == 0) { if (dir == 0) yl[s * 64 + p] = y; else yl[s * 64 + p] += y; } }
        }
        __syncthreads();
        const float dsk = gp(a.in[I_SSDD])[l * 8 + hd];
        for (int e = sub; e < 128 * 64; e += 256) { const int s = e >> 6, pp = e & 63; const size_t row = (size_t)b * T_ + c * 128 + s;
            const float xs = bf2f(CONV[row * 768 + hd * 64 + pp]), z = bf2f(PROJ[row * NP + PZ + hd * 64 + pp]);
            const float yv = (yl[e] + dsk * xs) * silu_f(z);
            MIXED[row * D_ + 256 + hd * 64 + pp] = (bf16_t)f2bf(yv); }
        __syncthreads();
    }
}
__device__ __forceinline__ void ssd_norm(const Args& a, int l, int G) {
    bf16_t* MIXED = (bf16_t*)(lptr(a.ws) + WS_MIXED); const float* nw = gp(a.in[I_SSDNW]) + l * 512;
    const int tid = ltid(), lane = tid & 63, gw = lbid() * 8 + (tid >> 6), NGW = G * 8;
    for (int m = gw; m < M_; m += NGW) { u32x4* p = (u32x4*)(MIXED + (size_t)m * D_ + 256) + lane; const u32x4 v = *p;
        float x[8] = {bflo(v.x), bfhi(v.x), bflo(v.y), bfhi(v.y), bflo(v.z), bfhi(v.z), bflo(v.w), bfhi(v.w)}; float s = 0.f;
#pragma unroll
        for (int e = 0; e < 8; ++e) s += x[e] * x[e];
        const float r = rsqrtf(wave_sum(s) * (1.f / 512.f) + LN_EPS); const f32x4 w0 = ((const f32x4*)nw)[2 * lane], w1 = ((const f32x4*)nw)[2 * lane + 1];
        u32x4 o; o.x = pk2(x[0] * r * w0.x, x[1] * r * w0.y); o.y = pk2(x[2] * r * w0.z, x[3] * r * w0.w); o.z = pk2(x[4] * r * w1.x, x[5] * r * w1.y); o.w = pk2(x[6] * r * w1.z, x[7] * r * w1.w);
        *p = o; }
}
__device__ __forceinline__ void s5_scan(const Args& a, int l, int G) {
    const int tid = ltid(); if (tid >= 64) return;
    const int p = tid; const bf16_t* S5S = (const bf16_t*)(lptr(a.ws) + WS_S5S); bf16_t* UX = (bf16_t*)(lptr(a.ws) + WS_UX);
    for (int it = lbid(); it < 256; it += G) { const int g = it & 15, b = (it >> 4) & 7, dir = it >> 7;
        const f32x2 A16 = ((const f32x2*)(lptr(a.ws) + WS_MISC))[((l * 2 + dir) * 16 + g) * 64 + p];
        float xr = 0.f, xi = 0.f;
#pragma unroll 1
        for (int cb = 0; cb < 512; cb += 16) { f32x2 s[16];
#pragma unroll
            for (int k = 0; k < 16; ++k) { const int cc = cb + k, c = dir ? 511 - cc : cc; const size_t row = (size_t)g * 4096 + b * 512 + c; const unsigned sv = *(const unsigned*)(S5S + row * 256 + dir * 128 + 2 * p); s[k] = (f32x2){bflo(sv), bfhi(sv)}; }
#pragma unroll
            for (int k = 0; k < 16; ++k) { const int cc = cb + k, c = dir ? 511 - cc : cc; const size_t row = (size_t)g * 4096 + b * 512 + c;
                *(unsigned*)(UX + row * 512 + 256 + dir * 128 + 2 * p) = pk2(xr, xi);
                const float nr = A16.x * xr - A16.y * xi + s[k].x, ni = A16.x * xi + A16.y * xr + s[k].y; xr = nr; xi = ni; } } }
}

#define MFMA16(A, B, C) __builtin_amdgcn_mfma_f32_16x16x32_bf16(A, B, C, 0, 0, 0)
constexpr int SSD_WAVE_LDS = 19456, SSD_XS = 66, SSD_MS = 72;
__device__ __forceinline__ bf16x8 ld_frag_strided(const LAS bf16_t* T, int LS, int s0, int x) {
    bf16x8 f;
#pragma unroll
    for (int j = 0; j < 8; ++j) f[j] = (short)T[(s0 + j) * LS + x];
    return f;
}
__device__ __forceinline__ void ssd_tables(const Args& a, int l, const bf16_t* PROJ, size_t row0, int hd, int dir, int lane, float& dt, float& cum, float& tot) {
    const float raw = bf2f(PROJ[(row0 + lane) * NP + PDT + dir * 8 + hd]);
    dt = softplus_f(raw + gp(a.in[I_DTB])[(l * 2 + dir) * 8 + hd]);
    const float av = -expf(gp(a.in[I_ALOG])[(l * 2 + dir) * 8 + hd]);
    const float e = dt * av; float ps = e;
#pragma unroll
    for (int o = 1; o < 64; o <<= 1) { const float t = __shfl_up(ps, o); if (lane >= o) ps += t; }
    tot = __shfl(ps, 63);
    cum = dir ? (tot - ps + e) : ps;
}
__device__ __forceinline__ void ssd_passA2(const Args& a, int l, LAS unsigned char* lds, int G) {
    const bf16_t* PROJ = (const bf16_t*)(lptr(a.ws) + WS_PROJ); const bf16_t* CONV = (const bf16_t*)(lptr(a.ws) + WS_CONV);
    bf16_t* ST = (bf16_t*)(lptr(a.ws) + WS_ST); float* CD = (float*)(lptr(a.ws) + WS_MISC + 65536);
    const int tid = ltid(), lane = tid & 63, wave = tid >> 6, fr = lane & 15, fq = lane >> 4, hd = wave, g4 = hd >> 2;
    LAS bf16_t* Xl = (LAS bf16_t*)(lds + wave * SSD_WAVE_LDS); LAS bf16_t* Bl = Xl + 64 * SSD_XS; LAS float* tab = (LAS float*)(lds + wave * SSD_WAVE_LDS + 17664);
    for (int it = lbid(); it < 8 * 128 * 2; it += G) { const int dir = it & 1, c = (it >> 1) & 127, b = it >> 8;
        const size_t row0 = (size_t)b * T_ + c * 64;
        u32x4 xv[8], bv[8];
#pragma unroll
        for (int i = 0; i < 8; ++i) { const int q = lane + 64 * i, s = q >> 3, pc = (q & 7) * 8;
            xv[i] = *(const u32x4*)(CONV + (row0 + s) * 768 + hd * 64 + pc); bv[i] = *(const u32x4*)(CONV + (row0 + s) * 768 + 512 + g4 * 64 + pc); }
        float dt, cum, tot; ssd_tables(a, l, PROJ, row0, hd, dir, lane, dt, cum, tot);
        tab[lane] = dt * __expf(tot - cum);
        LDS_WAIT();
#pragma unroll
        for (int i = 0; i < 8; ++i) { const int q = lane + 64 * i, s = q >> 3, pc = (q & 7) * 8; const float w = tab[s];
            const u32x4 v = xv[i]; LAS unsigned* d = (LAS unsigned*)(Xl + s * SSD_XS + pc);
            d[0] = pk2(bflo(v.x) * w, bfhi(v.x) * w); d[1] = pk2(bflo(v.y) * w, bfhi(v.y) * w); d[2] = pk2(bflo(v.z) * w, bfhi(v.z) * w); d[3] = pk2(bflo(v.w) * w, bfhi(v.w) * w);
            const u32x4 vb = bv[i]; LAS unsigned* db = (LAS unsigned*)(Bl + s * SSD_XS + pc);
            db[0] = vb.x; db[1] = vb.y; db[2] = vb.z; db[3] = vb.w; }
        LDS_WAIT();
        f32x4 acc[4][4];
#pragma unroll
        for (int mi = 0; mi < 4; ++mi)
#pragma unroll
            for (int nj = 0; nj < 4; ++nj) acc[mi][nj] = (f32x4){0.f, 0.f, 0.f, 0.f};
#pragma unroll
        for (int ks = 0; ks < 2; ++ks) { bf16x8 af[4], bg[4];
#pragma unroll
            for (int mi = 0; mi < 4; ++mi) af[mi] = ld_frag_strided(Bl, SSD_XS, 32 * ks + 8 * fq, 16 * mi + fr);
#pragma unroll
            for (int nj = 0; nj < 4; ++nj) bg[nj] = ld_frag_strided(Xl, SSD_XS, 32 * ks + 8 * fq, 16 * nj + fr);
#pragma unroll
            for (int mi = 0; mi < 4; ++mi)
#pragma unroll
                for (int nj = 0; nj < 4; ++nj) acc[mi][nj] = MFMA16(af[mi], bg[nj], acc[mi][nj]); }
        const size_t idx = ((size_t)(b * 128 + c) * 8 + hd) * 2 + dir; bf16_t* sp = ST + idx * 4096;
#pragma unroll
        for (int mi = 0; mi < 4; ++mi)
#pragma unroll
            for (int nj = 0; nj < 4; ++nj) { u32x2 w; w.x = pk2(acc[mi][nj][0], acc[mi][nj][1]); w.y = pk2(acc[mi][nj][2], acc[mi][nj][3]); *(u32x2*)(sp + (16 * nj + fr) * 64 + 16 * mi + 4 * fq) = w; }
        if (lane == 0) CD[idx] = __expf(tot);
        LDS_WAIT();
    }
}
__device__ __forceinline__ void ssd_scan2(const Args& a, int G) {
    unsigned* ST32 = (unsigned*)(lptr(a.ws) + WS_ST); const float* CD = (const float*)(lptr(a.ws) + WS_MISC + 65536);
    const int gt = lbid() * 512 + ltid(), NT = G * 512;
    for (int e = gt; e < 8 * 8 * 2 * 2048; e += NT) { const int pn2 = e & 2047, dir = (e >> 11) & 1, hd = (e >> 12) & 7, b = e >> 15;
        float H0 = 0.f, H1 = 0.f;
#pragma unroll 1
        for (int cb = 0; cb < 128; cb += 16) { unsigned v[16]; float cd[16];
#pragma unroll
            for (int k = 0; k < 16; ++k) { const int cc = cb + k, c = dir ? 127 - cc : cc; const size_t idx = ((size_t)(b * 128 + c) * 8 + hd) * 2 + dir; v[k] = ST32[idx * 2048 + pn2]; cd[k] = CD[idx]; }
#pragma unroll
            for (int k = 0; k < 16; ++k) { const int cc = cb + k, c = dir ? 127 - cc : cc; const size_t idx = ((size_t)(b * 128 + c) * 8 + hd) * 2 + dir;
                ST32[idx * 2048 + pn2] = pk2(H0, H1); H0 = H0 * cd[k] + bflo(v[k]); H1 = H1 * cd[k] + bfhi(v[k]); } } }
}
__device__ __forceinline__ void ssd_passC2(const Args& a, int l, LAS unsigned char* lds, int G) {
    const bf16_t* PROJ = (const bf16_t*)(lptr(a.ws) + WS_PROJ); const bf16_t* CONV = (const bf16_t*)(lptr(a.ws) + WS_CONV); bf16_t* MIXED = (bf16_t*)(lptr(a.ws) + WS_MIXED);
    const bf16_t* ST = (const bf16_t*)(lptr(a.ws) + WS_ST);
    const int tid = ltid(), lane = tid & 63, wave = tid >> 6, hd = wave, g4 = hd >> 2;
    LAS bf16_t* Xl = (LAS bf16_t*)(lds + wave * SSD_WAVE_LDS); LAS bf16_t* Ml = (LAS bf16_t*)(lds + wave * SSD_WAVE_LDS + 8448); LAS float* tab = (LAS float*)(lds + wave * SSD_WAVE_LDS + 17664);
    LAS float* ssq = (LAS float*)(lds + 8 * SSD_WAVE_LDS);
    const float dsk = gp(a.in[I_SSDD])[l * 8 + hd];
    for (int it = lbid(); it < 8 * 128; it += G) { const int c = it & 127, b = it >> 7;
        const size_t row0 = (size_t)b * T_ + c * 64;
        f32x4 Y[4][4];
#pragma unroll
        for (int mi = 0; mi < 4; ++mi)
#pragma unroll
            for (int nj = 0; nj < 4; ++nj) Y[mi][nj] = (f32x4){0.f, 0.f, 0.f, 0.f};
        bf16x8 cfr[4][2];
        { int ln_ = lane; asm volatile("" : "+v"(ln_)); const int fr = ln_ & 15, fq = ln_ >> 4;
          u32x4 xv[8]; bf16x8 h0[4][2], h1[4][2];
#pragma unroll
          for (int i = 0; i < 8; ++i) { const int q = ln_ + 64 * i, s = q >> 3, pc = (q & 7) * 8; xv[i] = *(const u32x4*)(CONV + (row0 + s) * 768 + hd * 64 + pc); }
          const bf16_t* hp = ST + (((size_t)(b * 128 + c) * 8 + hd) * 2) * 4096;
#pragma unroll
          for (int t4 = 0; t4 < 4; ++t4) { const bf16_t* cp = CONV + (row0 + 16 * t4 + fr) * 768 + 640 + g4 * 64 + 8 * fq; cfr[t4][0] = *(const bf16x8*)cp; cfr[t4][1] = *(const bf16x8*)(cp + 32);
              const bf16_t* ap = hp + (16 * t4 + fr) * 64 + 8 * fq; h0[t4][0] = *(const bf16x8*)ap; h0[t4][1] = *(const bf16x8*)(ap + 32); h1[t4][0] = *(const bf16x8*)(ap + 4096); h1[t4][1] = *(const bf16x8*)(ap + 4096 + 32); }
          { float dt, cum, tot; ssd_tables(a, l, PROJ, row0, hd, 0, lane, dt, cum, tot); tab[lane] = dt; tab[64 + lane] = cum;
            ssd_tables(a, l, PROJ, row0, hd, 1, lane, dt, cum, tot); tab[128 + lane] = dt; tab[192 + lane] = cum; }
#pragma unroll
          for (int i = 0; i < 8; ++i) { const int q = ln_ + 64 * i, s = q >> 3, pc = (q & 7) * 8; LAS unsigned* d = (LAS unsigned*)(Xl + s * SSD_XS + pc);
              d[0] = xv[i].x; d[1] = xv[i].y; d[2] = xv[i].z; d[3] = xv[i].w; }
          LDS_WAIT();
#pragma unroll
          for (int nj = 0; nj < 4; ++nj) { const float sc0 = __expf(tab[64 + 16 * nj + fr]), sc1 = __expf(tab[192 + 16 * nj + fr]);
#pragma unroll
              for (int mi = 0; mi < 4; ++mi) { f32x4 t = MFMA16(h0[mi][0], cfr[nj][0], ((f32x4){0.f, 0.f, 0.f, 0.f})); t = MFMA16(h0[mi][1], cfr[nj][1], t);
                  f32x4 u = MFMA16(h1[mi][0], cfr[nj][0], ((f32x4){0.f, 0.f, 0.f, 0.f})); u = MFMA16(h1[mi][1], cfr[nj][1], u);
                  Y[mi][nj] += t * sc0 + u * sc1; } } }
        f32x4 Gt[4][4];
#pragma unroll
        for (int mi = 0; mi < 4; ++mi)
#pragma unroll
            for (int nj = 0; nj < 4; ++nj) Gt[mi][nj] = (f32x4){0.f, 0.f, 0.f, 0.f};
        { int ln_ = lane; asm volatile("" : "+v"(ln_)); const int fr = ln_ & 15, fq = ln_ >> 4;
          bf16x8 bfr[4][2];
#pragma unroll
          for (int mi = 0; mi < 4; ++mi) { const bf16_t* bp = CONV + (row0 + 16 * mi + fr) * 768 + 512 + g4 * 64 + 8 * fq; bfr[mi][0] = *(const bf16x8*)bp; bfr[mi][1] = *(const bf16x8*)(bp + 32); }
#pragma unroll
          for (int ks = 0; ks < 2; ++ks)
#pragma unroll
            for (int mi = 0; mi < 4; ++mi)
#pragma unroll
                for (int nj = 0; nj < 4; ++nj) Gt[mi][nj] = MFMA16(bfr[mi][ks], cfr[nj][ks], Gt[mi][nj]); }
        u32x2 ez[4][4];
#pragma unroll
        for (int dir = 0; dir < 2; ++dir) { int ln_ = lane; asm volatile("" : "+v"(ln_)); const int fr = ln_ & 15, fq = ln_ >> 4;
            if (dir == 1) {
#pragma unroll
                for (int nj = 0; nj < 4; ++nj) { const size_t row = row0 + 16 * nj + fr;
#pragma unroll
                    for (int mi = 0; mi < 4; ++mi) { const int p0 = 16 * mi + 4 * fq; ez[mi][nj] = *(const u32x2*)(PROJ + row * NP + PZ + hd * 64 + p0); } } }
#pragma unroll
            for (int nj = 0; nj < 4; ++nj) { const int lq = 16 * nj + fr; const float cl = tab[dir * 128 + 64 + lq];
#pragma unroll
                for (int mi = 0; mi < 4; ++mi) { const f32x4 cs = *(const LAS f32x4*)(tab + dir * 128 + 64 + 16 * mi + 4 * fq), ds = *(const LAS f32x4*)(tab + dir * 128 + 16 * mi + 4 * fq);
                    float v[4];
#pragma unroll
                    for (int r = 0; r < 4; ++r) { const int s = 16 * mi + 4 * fq + r; const bool valid = dir ? (s >= lq) : (s <= lq);
                        v[r] = valid ? Gt[mi][nj][r] * __expf(cl - cs[r]) * ds[r] : 0.f; }
                    u32x2 w; w.x = pk2(v[0], v[1]); w.y = pk2(v[2], v[3]); *(LAS u32x2*)(Ml + lq * SSD_MS + 16 * mi + 4 * fq) = w; } }
            asm volatile("s_waitcnt lgkmcnt(0)" ::: );
#pragma unroll
            for (int ks = 0; ks < 2; ++ks) { bf16x8 af[4], bg[4];
#pragma unroll
                for (int mi = 0; mi < 4; ++mi) af[mi] = ld_frag_strided(Xl, SSD_XS, 32 * ks + 8 * fq, 16 * mi + fr);
#pragma unroll
                for (int nj = 0; nj < 4; ++nj) bg[nj] = *(const LAS bf16x8*)(Ml + (16 * nj + fr) * SSD_MS + 32 * ks + 8 * fq);
#pragma unroll
                for (int mi = 0; mi < 4; ++mi)
#pragma unroll
                    for (int nj = 0; nj < 4; ++nj) Y[mi][nj] = MFMA16(af[mi], bg[nj], Y[mi][nj]); }
            asm volatile("s_waitcnt lgkmcnt(0)" ::: );
        }
        float part[4];
        { int ln_ = lane; asm volatile("" : "+v"(ln_)); const int fr = ln_ & 15, fq = ln_ >> 4;
#pragma unroll
        for (int nj = 0; nj < 4; ++nj) { float ps = 0.f;
#pragma unroll
            for (int mi = 0; mi < 4; ++mi) { const LAS unsigned* xp = (const LAS unsigned*)(Xl + (16 * nj + fr) * SSD_XS + 16 * mi + 4 * fq); u32x2 xs; xs.x = xp[0]; xs.y = xp[1]; const u32x2 zz = ez[mi][nj];
                f32x4 y = Y[mi][nj];
                y[0] = (y[0] + dsk * bflo(xs.x)) * silu_f(bflo(zz.x)); y[1] = (y[1] + dsk * bfhi(xs.x)) * silu_f(bfhi(zz.x));
                y[2] = (y[2] + dsk * bflo(xs.y)) * silu_f(bflo(zz.y)); y[3] = (y[3] + dsk * bfhi(xs.y)) * silu_f(bfhi(zz.y));
                Y[mi][nj] = y; ps += (y[0] * y[0] + y[1] * y[1]) + (y[2] * y[2] + y[3] * y[3]); }
            ps += __shfl_xor(ps, 16); ps += __shfl_xor(ps, 32); part[nj] = ps; }
        if (fq == 0) {
#pragma unroll
            for (int nj = 0; nj < 4; ++nj) ssq[wave * 64 + 16 * nj + fr] = part[nj]; } }
        __syncthreads();
        const float* nw = gp(a.in[I_SSDNW]) + l * 512 + hd * 64;
        { int ln_ = lane; asm volatile("" : "+v"(ln_)); const int fr = ln_ & 15, fq = ln_ >> 4;
#pragma unroll
        for (int nj = 0; nj < 4; ++nj) { const int lq = 16 * nj + fr; float tot = 0.f;
#pragma unroll
            for (int w = 0; w < 8; ++w) tot += ssq[w * 64 + lq];
            const float rs = rsqrtf(tot * (1.f / 512.f) + LN_EPS); const size_t row = row0 + lq;
#pragma unroll
            for (int mi = 0; mi < 4; ++mi) { const int p0 = 16 * mi + 4 * fq; const f32x4 wv = *(const f32x4*)(nw + p0); const f32x4 y = Y[mi][nj];
                u32x2 w; w.x = pk2(y[0] * rs * wv[0], y[1] * rs * wv[1]); w.y = pk2(y[2] * rs * wv[2], y[3] * rs * wv[3]);
                *(u32x2*)(MIXED + row * D_ + 256 + hd * 64 + p0) = w; } } }
        __syncthreads();
    }
}

__device__ __forceinline__ void na_phase2(const bf16_t* PROJ, bf16_t* MIXED, const float* rpb, LAS unsigned char* lds, int G) {
    const int tid = ltid(), lane = tid & 63, wave = __builtin_amdgcn_readfirstlane(tid >> 6), j = wave & 3;
    LAS bf16_t* Vl = (LAS bf16_t*)(lds + wave * SSD_WAVE_LDS);
    LAS float* rpl = (LAS float*)(lds + wave * SSD_WAVE_LDS + 8448);
    const int t_lo = j < 2 ? 0 : j - 1, t_hi = j == 0 ? 1 : (j == 3 ? 3 : j + 1);
    const bool pr0 = t_lo <= 1, pr1 = t_hi >= 2;
    const int fr = lane & 15, fq = lane >> 4;
    int bix[4][4];
    { const int c = 16 * j + fr, c0 = min(max(c - 8, 0), 48);
#pragma unroll
      for (int kt = 0; kt < 4; ++kt)
#pragma unroll
          for (int e = 0; e < 4; ++e) { const int kc = 16 * kt + 4 * fq + e; bix[kt][e] = (kc >= c0 && kc < c0 + 16) ? min(max(kc - c, -15), 15) + 15 : -1; } }
    unsigned koff[4], voff[8];
#pragma unroll
    for (int kt = 0; kt < 4; ++kt) koff[kt] = (unsigned)((16 * kt + fr) * NP + PK + 8 * fq) * 2u;
#pragma unroll
    for (int i = 0; i < 8; ++i) { const int q = lane + 64 * i; voff[i] = (unsigned)((q >> 3) * NP + PV + (q & 7) * 8) * 2u; }
    constexpr float L2E = 1.44269504089f;
    const int per_ = (8 * 128 * 2 + G - 1) / G, it0_ = lbid() * per_, it1_ = min(it0_ + per_, 8 * 128 * 2);
    for (int it = it0_; it < it1_; ++it) {
        const int r = it & 127, hp = (it >> 7) & 1, b = it >> 8, h = hp * 2 + (wave >> 2);
        const int r0 = min(max(r - 4, 0), 120);
        const size_t rowq0 = (size_t)b * T_ + r * 64;
        { const float* rph = rpb + h * 15 * 31;
#pragma unroll
          for (int i = 0; i < 8; ++i) { const int e = lane + 64 * i; if (e < 465) rpl[e] = rph[e] * L2E; } }
        bf16x8 qf[2];
        { const bf16_t* qp = PROJ + (rowq0 + 16 * j + fr) * NP + PQ + h * 64 + 8 * fq; qf[0] = *(const bf16x8*)qp; qf[1] = *(const bf16x8*)(qp + 32); }
        f32x4 O[4];
#pragma unroll
        for (int mi = 0; mi < 4; ++mi) O[mi] = (f32x4){0.f, 0.f, 0.f, 0.f};
        float mx = -1e30f, lsum = 0.f;
        bf16x8 kn[4][2]; u32x4 vn[8];
        const char* kbase = (const char*)(PROJ + ((size_t)b * T_ + r0 * 64) * NP + h * 64);
#pragma unroll
        for (int kt = 0; kt < 4; ++kt) if (kt >= t_lo && kt <= t_hi) { kn[kt][0] = *(const bf16x8*)(kbase + koff[kt]); kn[kt][1] = *(const bf16x8*)(kbase + koff[kt] + 64); }
#pragma unroll
        for (int i = 0; i < 8; ++i) if (i < 4 ? pr0 : pr1) vn[i] = *(const u32x4*)(kbase + voff[i]);
#pragma unroll 1
        for (int kr = 0; kr < 8; ++kr) {
            const int krow = r0 + kr;
            int ln_ = lane; asm volatile("" : "+v"(ln_)); const int fr = ln_ & 15, fq = ln_ >> 4;
#pragma unroll
            for (int i = 0; i < 8; ++i) if (i < 4 ? pr0 : pr1) { const int q = ln_ + 64 * i, key = q >> 3, dc = (q & 7) * 8; LAS unsigned* d = (LAS unsigned*)(Vl + key * SSD_XS + dc);
                d[0] = vn[i].x; d[1] = vn[i].y; d[2] = vn[i].z; d[3] = vn[i].w; }
            f32x4 S[4];
            const LAS float* rpr = rpl + (krow - r + 7) * 31;
#pragma unroll
            for (int kt = 0; kt < 4; ++kt) if (kt >= t_lo && kt <= t_hi) { f32x4 t = MFMA16(kn[kt][0], qf[0], ((f32x4){0.f, 0.f, 0.f, 0.f})); S[kt] = MFMA16(kn[kt][1], qf[1], t); }
            kbase += (size_t)64 * NP * 2;
            if (kr < 7) {
#pragma unroll
                for (int kt = 0; kt < 4; ++kt) if (kt >= t_lo && kt <= t_hi) { kn[kt][0] = *(const bf16x8*)(kbase + koff[kt]); kn[kt][1] = *(const bf16x8*)(kbase + koff[kt] + 64); }
#pragma unroll
                for (int i = 0; i < 8; ++i) if (i < 4 ? pr0 : pr1) vn[i] = *(const u32x4*)(kbase + voff[i]); }
            float gm = -1e30f;
#pragma unroll
            for (int kt = 0; kt < 4; ++kt) {
                if (kt >= t_lo && kt <= t_hi) { f32x4 t = S[kt];
#pragma unroll
                    for (int e = 0; e < 4; ++e) { const int bi = bix[kt][e]; const float s = bi >= 0 ? t[e] * (0.125f * L2E) + rpr[bi] : -1e30f; t[e] = s; gm = fmaxf(gm, s); }
                    S[kt] = t; }
                else S[kt] = (f32x4){-1e30f, -1e30f, -1e30f, -1e30f}; }
            gm = fmaxf(gm, __shfl_xor(gm, 16)); gm = fmaxf(gm, __shfl_xor(gm, 32));
            const float mnew = fmaxf(mx, gm), al = __builtin_amdgcn_exp2f(mx - mnew); mx = mnew; lsum *= al;
#pragma unroll
            for (int mi = 0; mi < 4; ++mi) O[mi] = O[mi] * al;
#pragma unroll
            for (int kt = 0; kt < 4; ++kt) {
                if (kt >= t_lo && kt <= t_hi) {
#pragma unroll
                    for (int e = 0; e < 4; ++e) { const float p = __builtin_amdgcn_exp2f(S[kt][e] - mnew); S[kt][e] = p; lsum += p; } }
                else S[kt] = (f32x4){0.f, 0.f, 0.f, 0.f}; }
#pragma unroll
            for (int pr = 0; pr < 2; ++pr) if (pr == 0 ? pr0 : pr1) {
                const unsigned w0 = pk2hw(S[2 * pr][0], S[2 * pr][1]), w1 = pk2hw(S[2 * pr][2], S[2 * pr][3]), w2 = pk2hw(S[2 * pr + 1][0], S[2 * pr + 1][1]), w3 = pk2hw(S[2 * pr + 1][2], S[2 * pr + 1][3]);
                const u32x4 w = {w0, w1, w2, w3}; const bf16x8 pf = __builtin_bit_cast(bf16x8, w);
#pragma unroll
                for (int mi = 0; mi < 4; ++mi) { bf16x8 af;
#pragma unroll
                    for (int jj = 0; jj < 4; ++jj) { af[jj] = (short)Vl[(32 * pr + 4 * fq + jj) * SSD_XS + 16 * mi + fr]; af[4 + jj] = (short)Vl[(32 * pr + 16 + 4 * fq + jj) * SSD_XS + 16 * mi + fr]; }
                    O[mi] = MFMA16(af, pf, O[mi]); } }
        }
        { lsum += __shfl_xor(lsum, 16); lsum += __shfl_xor(lsum, 32); const float inv = 1.f / lsum;
          bf16_t* op = MIXED + (rowq0 + 16 * j + fr) * D_ + h * 64 + 4 * fq;
#pragma unroll
          for (int mi = 0; mi < 4; ++mi) { u32x2 w; w.x = pk2hw(O[mi][0] * inv, O[mi][1] * inv); w.y = pk2hw(O[mi][2] * inv, O[mi][3] * inv); *(u32x2*)(op + 16 * mi) = w; } }
    }
}
__device__ __forceinline__ void ln_phase(const Args& a, const float* gam, const float* bet, int G) {
    const int tid = ltid(), lane = tid & 63, gw = lbid() * 8 + (tid >> 6), NGW = G * 8;
    float* H = lptr(a.out); bf16_t* HB = (bf16_t*)(lptr(a.ws) + WS_HB);
    for (int m = gw; m < M_ / 2; m += NGW) { const size_t r0 = (size_t)m * D_, r1 = (size_t)(m + M_ / 2) * D_;
        ln_row2(H + r0, H + r1, H + r0, H + r1, (bf16_t*)nullptr, (bf16_t*)nullptr, gam, bet, lane); }
}
__device__ __forceinline__ void xsoftmax_phase(const Args& a, int G) {
    const float* S = (const float*)(lptr(a.ws) + WS_S); bf16_t* P = (bf16_t*)(lptr(a.ws) + WS_QB);
    const int tid = ltid(), lane = tid & 63, gw = lbid() * 8 + (tid >> 6), NGW = G * 8;
    for (int m = gw; m < M_; m += NGW) {
#pragma unroll
        for (int j = 0; j < 4; ++j) { const f32x4 v = ((const f32x4*)(S + (size_t)m * D_ + j * 256))[lane];
            const float mx = wave_max(fmaxf(fmaxf(v.x, v.y), fmaxf(v.z, v.w)));
            const float e0 = __expf(v.x - mx), e1 = __expf(v.y - mx), e2 = __expf(v.z - mx), e3 = __expf(v.w - mx);
            const float inv = 1.f / wave_sum((e0 + e1) + (e2 + e3));
            u32x2 w; w.x = pk2(e0 * inv, e1 * inv); w.y = pk2(e2 * inv, e3 * inv); ((u32x2*)(P + (size_t)m * D_ + j * 256))[lane] = w; } }
}

#define XB_TMO      128
#define XB_XCNT(j)  (256  + 64 * (j))
#define XB_XSUB(j)  (1280 + 64 * (j))
#define XB_XGEN(j)  (2304 + 64 * (j))
#define XB_TOP      3328
#define XB_TOPGEN   3392
#define XCD_BAR_WORDS 3456
#define XB_SPIN_CAP (1u << 18)

__device__ __forceinline__ unsigned xb_ld(unsigned* p)              { return __hip_atomic_load(p, __ATOMIC_RELAXED, __HIP_MEMORY_SCOPE_AGENT); }
__device__ __forceinline__ unsigned xb_add(unsigned* p, unsigned v) { return __hip_atomic_fetch_add(p, v, __ATOMIC_RELAXED, __HIP_MEMORY_SCOPE_AGENT); }
__device__ __forceinline__ unsigned xb_xcc_id() { return (unsigned)__builtin_amdgcn_s_getreg((3 << 11) | 20) & 0xFu; }
#define XB_SPIN(cond, bar) do { unsigned _sp = 0; while (cond) { __builtin_amdgcn_s_sleep(1); \
    if ((++_sp & 255u) == 0u) { if (xb_ld(&(bar)[XB_TMO])) break; if (_sp > XB_SPIN_CAP) { atomicAdd(&(bar)[XB_TMO], 1u); break; } } } } while (0)

struct XcdBarrier {
    unsigned* bar; unsigned x;
    volatile LAS unsigned* st;
};

__device__ __forceinline__ XcdBarrier xcd_barrier_post(unsigned* bar, volatile LAS unsigned* st) {
    XcdBarrier b; b.bar = bar; b.x = xb_xcc_id(); b.st = st;
    if (threadIdx.x == 0) (void)xb_add(&bar[XB_XCNT(b.x)], 1u);
    return b;
}
__device__ __forceinline__ void xcd_barrier_complete(unsigned* bar, unsigned x, unsigned& nloc, unsigned& nx) {
    const unsigned G = gridDim.x * gridDim.y * gridDim.z;
    unsigned sum, cnt, mine, sp = 0u;
    for (;;) {
        sum = 0u; cnt = 0u; mine = 0u;
#pragma unroll
        for (unsigned j = 0; j < 16; ++j) { const unsigned c = xb_ld(&bar[XB_XCNT(j)]); sum += c; cnt += (c > 0u) ? 1u : 0u; mine = (j == x) ? c : mine; }
        if (sum == G) break;
        __builtin_amdgcn_s_sleep(1);
        if ((++sp & 255u) == 0u) { if (xb_ld(&bar[XB_TMO])) break; if (sp > XB_SPIN_CAP) { atomicAdd(&bar[XB_TMO], 1u); break; } }
    }
    nloc = mine > 0u ? mine : 1u; nx = cnt > 0u ? cnt : 1u;
}

__device__ __forceinline__ void xcd_barrier(const XcdBarrier& b) {
    asm volatile("s_waitcnt vmcnt(0)" ::: "memory");
    __syncthreads();
    if (threadIdx.x == 0) {
        unsigned* bar = b.bar;
        __builtin_amdgcn_s_waitcnt(0);
        unsigned nloc = b.st[0], nx = b.st[1];
        if (nloc == 0u) { xcd_barrier_complete(bar, b.x, nloc, nx); b.st[0] = nloc; b.st[1] = nx; }
        const unsigned old = xb_add(&bar[XB_XSUB(b.x)], 1u);
        const unsigned gen = old / nloc;
        if (old + 1u == (gen + 1u) * nloc) {
            __builtin_amdgcn_fence(__ATOMIC_RELEASE, "agent");
            asm volatile("s_waitcnt vmcnt(0)" ::: "memory");
            const unsigned og = xb_add(&bar[XB_TOP], 1u);
            const unsigned tg = og / nx;
            if (og + 1u == (tg + 1u) * nx) xb_add(&bar[XB_TOPGEN], 1u);
            else XB_SPIN(xb_ld(&bar[XB_TOPGEN]) == tg, bar);
            __builtin_amdgcn_fence(__ATOMIC_ACQUIRE, "agent");
            xb_add(&bar[XB_XGEN(b.x)], 1u);
            asm volatile("s_waitcnt vmcnt(0)" ::: "memory");
        } else {
            XB_SPIN(xb_ld(&bar[XB_XGEN(b.x)]) == gen, bar);
            __builtin_amdgcn_fence(__ATOMIC_ACQUIRE, "agent");
            asm volatile("s_waitcnt vmcnt(0)" ::: "memory");
        }
    }
    __syncthreads();
}

__device__ __forceinline__ const LAS float* stage_gb(LAS unsigned char* lds, const float* gam, const float* bet) {
    LAS float* gl = (LAS float*)(lds + 139264); const int t = ltid();
    *(LAS f32x4*)(gl + 4 * t) = (t < 256) ? ((const f32x4*)gam)[t] : ((const f32x4*)bet)[t - 256];
    __syncthreads(); return gl;
}
#ifndef ONLY_S
#define ONLY_S -1
#endif
#define PHX(x) (ONLY_S == -1 || ONLY_S == (x))
__global__ void __launch_bounds__(512, 2) fwd(Args a) {
    extern __shared__ __attribute__((aligned(16))) unsigned char lds_raw[];
    LAS unsigned char* lds = (LAS unsigned char*)lds_raw;
    volatile LAS unsigned* bst = (volatile LAS unsigned*)(lds + 157696);
    if (threadIdx.x < 16) bst[threadIdx.x] = 0u;
    __syncthreads();
    XcdBarrier xbar; xbar.bar = (unsigned*)(a.ws + 4096); xbar.x = 0; xbar.st = bst;
    if (a.coop) xbar = xcd_barrier_post((unsigned*)(a.ws + 4096), bst);
    for (int ph = a.ph_lo; ph < a.ph_hi; ++ph) {
    int G = gridDim.x; asm volatile("" : "+s"(G)); const int bx = lbid();
    bf16_t* HB = (bf16_t*)(lptr(a.ws) + WS_HB); bf16_t* PROJ = (bf16_t*)(lptr(a.ws) + WS_PROJ); bf16_t* MIXED = (bf16_t*)(lptr(a.ws) + WS_MIXED); bf16_t* CONV = (bf16_t*)(lptr(a.ws) + WS_CONV);
    bf16_t* UX = (bf16_t*)(lptr(a.ws) + WS_UX); bf16_t* MEMB = (bf16_t*)(lptr(a.ws) + WS_MEMB); bf16_t* KM = (bf16_t*)(lptr(a.ws) + WS_KM); bf16_t* VMT = (bf16_t*)(lptr(a.ws) + WS_VMT);
    bf16_t* QB = (bf16_t*)(lptr(a.ws) + WS_QB); bf16_t* OB = (bf16_t*)(lptr(a.ws) + WS_OB); bf16_t* HID = (bf16_t*)(lptr(a.ws) + WS_HID);
    float* SL0 = (float*)(lptr(a.ws) + WS_SL); float* SL1 = SL0 + (size_t)M_ * 8;
        if (ph == 0) { if (PHX(100)) prologue(a, lds, G); }
        else {
            const int l = (ph - 1) / 17, s = (ph - 1) % 17;
            unsigned char* wb = lptr(a.ws) + WS_W + (size_t)l * LWB;
            pg8::Sched S;
            if (s == 0 && PHX(0)) {
                if (l == 0) {
                    { pg8::Gemm g{MEMB, (const bf16_t*)(lptr(a.ws) + WS_W + OW_K), D_, D_, D_, 0, 0, LWB / 2, 0}; S.init(8, 4, 2, 1, G, bx);
                      pg8::EpiStore<0> E{KM, D_, (size_t)B_ * MEMT * D_, 0, 1 << 30, 1.f}; pg8::gemm_phase(lds, g, S, E); }
                    { pg8::Gemm g{(const bf16_t*)(lptr(a.ws) + WS_W + OW_V), MEMB, D_, D_, D_, LWB / 2, 0, 0, (size_t)MEMT * D_}; S.init(4, 1, 2, 8, G, bx);
                      pg8::EpiStore<0> E{VMT, MEMT, (size_t)B_ * D_ * MEMT, (size_t)D_ * MEMT, 1 << 30, 1.f}; pg8::gemm_phase(lds, g, S, E); }
                }
                pg8::Gemm g{HB, (const bf16_t*)(wb + OW_IN), D_, D_, D_, 0, 0, 0, 0}; S.init(M_ / 256, NPP / 256, 1, 1, G, bx);
                if (l == 0) { pg8::EpiStore<0> E{PROJ, NP, 0, 0, NP, 1.f}; pg8::gemm_phase(lds, g, S, E); }
                else { float* cs = cs_ptr(lptr(a.ws), 1, 2); pg8::EpiStoreLN<0> E{PROJ, NP, NP, 1.f, SL0  , cs, cs + NPP}; pg8::gemm_phase(lds, g, S, E); }
            } else if (s == 1 && PHX(1)) {
                if (l == 0) colsum_phase(a, G);
                na_phase2(PROJ, MIXED, gp(a.in[I_RPB]) + l * 4 * 15 * 31, lds, G);
#ifndef NO_CONV
                conv_phase(PROJ, CONV, gp(a.in[I_CONVW]) + l * 5 * 768, gp(a.in[I_CONVB]) + l * 768, G);
#endif
                s5_gather_phase(PROJ, UX, G);
            } else if (s == 2 && PHX(2)) {
                ssd_passA2(a, l, lds, G);
                __syncthreads();
                pg8::Gemm g{UX, (const bf16_t*)(lptr(a.ws) + WS_SM) + (size_t)l * 16 * 256 * 256, 512, 256, 256, (size_t)4096 * 512, 0, (size_t)256 * 256, 0}; S.init(16, 1, 16, 1, G, bx);
                pg8::EpiStore<0> E{(bf16_t*)(lptr(a.ws) + WS_S5S), 256, (size_t)4096 * 256, 0, 1 << 30, 1.f}; pg8::gemm_phase(lds, g, S, E);
            } else if (s == 3 && PHX(3)) {
                ssd_scan2(a, G);
                s5_scan(a, l, G);
            } else if (s == 4 && PHX(4)) {
#ifndef NO_PC
                ssd_passC2(a, l, lds, G);
#endif
                pg8::Gemm g{UX, (const bf16_t*)(lptr(a.ws) + WS_TM) + (size_t)l * 16 * 256 * 512, 512, 512, 512, (size_t)4096 * 512, 0, (size_t)256 * 512, 0}; S.init(16, 1, 16, 1, G, bx);
#ifndef NO_G4
                pg8::EpiS5Y E{MIXED}; pg8::gemm_phase(lds, g, S, E);
#endif
            } else if (s == 5 && PHX(5)) {
                pg8::Gemm g{MIXED + 768, (const bf16_t*)(wb + OW_GLU), D_, 256, 256, 0, 0, 0, 0}; S.init(M_ / 256, 1, 1, 1, G, bx);
                pg8::EpiGLU E{MIXED, gp(a.in[I_GLUB]) + l * 256}; pg8::gemm_phase(lds, g, S, E);
            } else if (s == 6 && PHX(6)) {
                pg8::Gemm g{MIXED, (const bf16_t*)(wb + OW_OUT), D_, D_, D_, 0, 0, 0, 0}; S.init(M_ / 256, 4, 1, 1, G, bx);
                if (l == 0) { pg8::EpiResidLN<true, false> E{lptr(a.out), HB, SL1, SL0, nullptr, nullptr, (LAS float*)(lds + 131072), ALPHA}; pg8::gemm_phase(lds, g, S, E); }
                else { const LAS float* gl = stage_gb(lds, gp(a.in[I_LNMLP_G]), gp(a.in[I_LNMLP_B])); pg8::EpiResidLN<false, false> E{lptr(a.out), HB, SL0, SL1, gl, nullptr, (LAS float*)(lds + 131072), ALPHA}; pg8::gemm_phase(lds, g, S, E); }
            } else if (s == 7 && PHX(7)) {
            } else if (s == 8 && PHX(8)) {
                pg8::Gemm g{HB, (const bf16_t*)(wb + OW_Q), D_, D_, D_, 0, 0, 0, 0}; S.init(M_ / 256, 4, 1, 1, G, bx);
                float* cs = cs_ptr(lptr(a.ws), l, 0); pg8::EpiStoreLN<0> E{QB, D_, 1 << 30, 0.0625f, l == 0 ? SL0 : SL1, cs, cs + D_}; pg8::gemm_phase(lds, g, S, E);
            } else if (s == 9 && PHX(9)) {
                pg8::Gemm g{QB, KM + (size_t)l * B_ * MEMT * D_, D_, D_, 256, (size_t)T_ * D_, 256, (size_t)MEMT * D_, 256}; S.init(T_ / 256, 1, 8, 4, G, bx);
                pg8::EpiSoftmax E{(bf16_t*)(lptr(a.ws) + WS_S), D_, (size_t)T_ * D_, 256, (LAS float*)(lds + 131072)}; pg8::gemm_phase(lds, g, S, E);
            } else if (s == 10 && PHX(10)) {
            } else if (s == 11 && PHX(11)) {
                pg8::Gemm g{(const bf16_t*)(lptr(a.ws) + WS_S), VMT + (size_t)l * B_ * D_ * MEMT, D_, MEMT, 256, (size_t)T_ * D_, 256, (size_t)D_ * MEMT, (size_t)256 * MEMT}; S.init(T_ / 256, 1, 8, 4, G, bx);
                pg8::EpiStore<0> E{OB, D_, (size_t)T_ * D_, 256, 1 << 30, 1.f}; pg8::gemm_phase(lds, g, S, E);
            } else if (s == 12 && PHX(12)) {
                pg8::Gemm g{OB, (const bf16_t*)(wb + OW_O), D_, D_, D_, 0, 0, 0, 0}; S.init(M_ / 256, 4, 1, 1, G, bx);
                const LAS float* gl = stage_gb(lds, gp(a.in[I_LNMIX_G]) + l * D_, gp(a.in[I_LNMIX_B]) + l * D_); pg8::EpiResidLN<false, false> E{lptr(a.out), HB, l == 0 ? SL0 : SL1, l == 0 ? SL1 : SL0, gl, nullptr, (LAS float*)(lds + 131072), ALPHA}; pg8::gemm_phase(lds, g, S, E);
            } else if (s == 13 && PHX(13)) {
            } else if (s == 14 && PHX(14)) {
                pg8::Gemm g{HB, (const bf16_t*)(wb + OW_1), D_, D_, D_, 0, 0, 0, 0}; S.init(M_ / 256, FF_ / 256, 1, 1, G, bx);
                float* cs = cs_ptr(lptr(a.ws), l, 1); pg8::EpiStoreLN<1> E{HID, FF_, 1 << 30, 1.f, l == 0 ? SL1 : SL0, cs, cs + FF_}; pg8::gemm_phase(lds, g, S, E);
            } else if (s == 15 && PHX(15)) {
                pg8::Gemm g{HID, (const bf16_t*)(wb + OW_2), FF_, FF_, FF_, 0, 0, 0, 0}; S.init(M_ / 256, 4, 1, 1, G, bx);
                const LAS float* gl = stage_gb(lds, gp(a.in[I_LNXA_G]) + l * D_, gp(a.in[I_LNXA_B]) + l * D_); if (l == 0) { pg8::EpiResidLN<false, false> E{lptr(a.out), HB, SL1, SL0, gl, nullptr, (LAS float*)(lds + 131072), ALPHA}; pg8::gemm_phase(lds, g, S, E); }
                else { pg8::EpiResidLN<false, true> E{lptr(a.out), HB, SL0, SL1, gl, nullptr, (LAS float*)(lds + 131072), ALPHA}; pg8::gemm_phase(lds, g, S, E); }
            } else if (PHX(16)) {
                if (l == 1) ln_phase(a, gp(a.in[I_LNMLP_G]) + l * D_, gp(a.in[I_LNMLP_B]) + l * D_, G);
            }
        }
        if (ph + 1 < a.ph_hi) { const int s_ = (ph - 1) % 17; const bool empty_ = ph > 0 && (s_ == 7 || s_ == 10 || s_ == 13 || (s_ == 16 && ph < 18)); if (a.coop && !empty_) { if (a.ph_hi < 0) cg::this_grid().sync();   xcd_barrier(xbar); } }
    }
}

constexpr int NPHASES = 1 + 2 * 17;
#ifndef MULTI_LAUNCH
#define MULTI_LAUNCH 0
#endif

extern "C" void kernel_launch(void* const* d_in, const int* in_sizes, int n_in, void* d_out, int out_size, void* d_ws, size_t ws_size, hipStream_t stream) {
    static int grid = 0;
    if (grid == 0) {
        if (n_in != 35 || out_size != M_ * D_ || ws_size < WS_END) { fprintf(stderr, "kernel_launch: unexpected sizes n_in %d out %d ws %zu\n", n_in, out_size, ws_size); grid = -1; return; }
        int dev = 0, cus = 0, per_cu = 0;
        hipGetDevice(&dev); hipDeviceGetAttribute(&cus, hipDeviceAttributeMultiprocessorCount, dev);
        if (hipFuncSetAttribute((const void*)fwd, hipFuncAttributeMaxDynamicSharedMemorySize, LDS_BYTES) != hipSuccess) { fprintf(stderr, "kernel_launch: hipFuncSetAttribute failed\n"); grid = -1; return; }
        if (hipOccupancyMaxActiveBlocksPerMultiprocessor(&per_cu, (const void*)fwd, 512, LDS_BYTES) != hipSuccess || per_cu < 1) { fprintf(stderr, "kernel_launch: occupancy query says %d\n", per_cu); per_cu = 1; }
        (void)hipGetLastError();
        grid = cus * per_cu;
    }
    if (grid < 0) return;
    (void)hipMemsetAsync(d_ws, 0, 65536, stream);
    Args a{};
    for (int i = 0; i < 35; ++i) a.in[i] = (const float*)d_in[i];
    a.out = (float*)d_out; a.ws = (unsigned char*)d_ws;
#if MULTI_LAUNCH
    for (int ph = 0; ph < NPHASES; ++ph) { a.ph_lo = ph; a.ph_hi = ph + 1; a.coop = 0; hipLaunchKernelGGL(fwd, dim3(grid), dim3(512), LDS_BYTES, stream, a); }
#else
    a.ph_lo = 0; a.ph_hi = NPHASES; a.coop = 1;
    void* args[] = {&a};
    hipError_t e = hipLaunchCooperativeKernel((const void*)fwd, dim3(grid), dim3(512), args, LDS_BYTES, stream);
    if (e != hipSuccess) fprintf(stderr, "cooperative launch failed: %s (grid %d)\n", hipGetErrorString(e), grid);
#endif
}
```

```cpp
#include <hip/hip_runtime.h>
#include <hip/hip_cooperative_groups.h>
#include <cstdio>
#include <cstdint>
namespace cg = cooperative_groups;

#define LAS __attribute__((address_space(3)))
typedef unsigned short bf16_t;
typedef short bf16x8 __attribute__((ext_vector_type(8)));
typedef float f32x4 __attribute__((ext_vector_type(4)));
typedef float f32x2 __attribute__((ext_vector_type(2)));
typedef unsigned u32x4 __attribute__((ext_vector_type(4)));
typedef unsigned u32x2 __attribute__((ext_vector_type(2)));

constexpr int B_ = 8, T_ = 8192, D_ = 1024, M_ = B_ * T_, NP = 2320, NPP = 2560, FF_ = 4096, MEMT = 256;
constexpr float LN_EPS = 1e-5f;
constexpr float ALPHA = 1.41421356237f;
constexpr int PQ = 0, PK = 256, PV = 512, PZ = 768, PX = 1280, PDT = 2048, PU = 2064;

constexpr size_t MiB = 1u << 20;
constexpr size_t WS_W = 1 * MiB, LWB = 32 * MiB;
constexpr size_t OW_IN = 0, OW_OUT = 5 * MiB, OW_Q = 7 * MiB, OW_K = 9 * MiB, OW_V = 11 * MiB, OW_O = 13 * MiB, OW_1 = 15 * MiB, OW_2 = 23 * MiB, OW_GLU = 31 * MiB;
constexpr size_t WS_MEMB = 65 * MiB, WS_KM = 69 * MiB, WS_VMT = 77 * MiB, WS_TM = 85 * MiB, WS_SM = 93 * MiB, WS_MISC = 97 * MiB;
constexpr size_t WS_HB = 100 * MiB, WS_PROJ = 228 * MiB, WS_MIXED = 518 * MiB, WS_CONV = 646 * MiB, WS_HID = 228 * MiB;
constexpr size_t WS_S = 228 * MiB, WS_QB = 484 * MiB, WS_OB = 612 * MiB, WS_ST = 744 * MiB, WS_UX = 872 * MiB, WS_S5S = 936 * MiB, WS_SL = 1000 * MiB, WS_END = 1004 * MiB;
constexpr size_t MISC_CS = 262144;
constexpr int LDS_BYTES = 157696 + 64;

__device__ __forceinline__ float bf2f(unsigned u) { return __uint_as_float(u << 16); }
__device__ __forceinline__ float bflo(unsigned u) { return __uint_as_float(u << 16); }
__device__ __forceinline__ float bfhi(unsigned u) { return __uint_as_float(u & 0xffff0000u); }
__device__ __forceinline__ unsigned f2bf(float f) { unsigned u = __float_as_uint(f); return (u + 0x7fffu + ((u >> 16) & 1u)) >> 16; }
__device__ __forceinline__ unsigned pk2(float lo, float hi) { return f2bf(lo) | (f2bf(hi) << 16); }
__device__ __forceinline__ unsigned pk2hw(float lo, float hi) { unsigned r; asm volatile("v_cvt_pk_bf16_f32 %0, %1, %2" : "=v"(r) : "v"(lo), "v"(hi)); return r; }
__device__ __forceinline__ float wave_sum(float v) {
#pragma unroll
    for (int o = 1; o < 64; o <<= 1) v += __shfl_xor(v, o);
    return v;
}
__device__ __forceinline__ float wave_max(float v) {
#pragma unroll
    for (int o = 1; o < 64; o <<= 1) v = fmaxf(v, __shfl_xor(v, o));
    return v;
}
__device__ __forceinline__ float silu_f(float x) { return x * __builtin_amdgcn_rcpf(1.f + __expf(-x)); }
__device__ __forceinline__ float gelu_tanh(float x) { const float y = 0.7978845608f * (x + 0.044715f * x * x * x); const float t = 1.f - 2.f * __builtin_amdgcn_rcpf(1.f + __expf(2.f * y)); return 0.5f * x * (1.f + t); }
__device__ __forceinline__ int ltid() { int t = threadIdx.x; asm volatile("" : "+v"(t)); return t; }
__device__ __forceinline__ int lbid() { int t = blockIdx.x; asm volatile("" : "+s"(t)); return t; }
#define GAS __attribute__((address_space(1)))
__device__ __forceinline__ size_t zopq() { size_t z = 0; asm volatile("" : "+s"(z)); return z; }
template <class P> __device__ __forceinline__ P* gp(P* p) { return (P*)((char*)p + zopq()); }
template <class P> __device__ __forceinline__ P* lptr(P* p) { return (P*)((char*)p + zopq()); }
#define LDS_WAIT() asm volatile("s_waitcnt lgkmcnt(0)" ::: "memory")

namespace pg8 {
constexpr int BM = 256, BK = 64, HALF = 128, HTB = HALF * BK * 2, STAGE_BYTES = 8 * HTB;
__host__ __device__ __forceinline__ int lds_byte(int r, int c) { const int st = (r >> 4) * 2 + (c >> 5), rr = r & 15, cc = c & 31, ob = rr * 64 + cc * 2; return st * 1024 + (ob ^ (((ob >> 9) & 1) << 5)); }
__host__ __device__ __forceinline__ void stage_rc(int b, int& R, int& C) { const int st = b / 1024, sb = b % 1024, swz = sb ^ (((sb >> 9) & 1) << 5); R = (st >> 1) * 16 + swz / 64; C = (st & 1) * 32 + (swz % 64) / 2; }
__host__ __device__ __forceinline__ int perm32(int rho) { const int n = rho >> 4, i = rho & 15; return 8 * (i >> 2) + 4 * n + (i & 3); }

struct Unit { int pm, pn, b1, b2; };
struct Gemm { const bf16_t* A; const bf16_t* Bt; int lda, ldb, K; size_t aS1, aS2, bS1, bS2; };

struct Sched {
    int nM, nN, nB2, total, G, c;
    __device__ __forceinline__ void init(int nM_, int nN_, int nB1_, int nB2_, int G_, int c_) { nM = nM_; nN = nN_; nB2 = nB2_; total = nM_ * nN_ * nB1_ * nB2_; G = G_; c = c_; }
    __device__ __forceinline__ bool next(int i, Unit& u) const {
        const long L = (long)i * G + c; if (L >= total) return false;
        int w = (int)L;
        { const int q = total / 8, r = total % 8, xcd = w % 8, off = w / 8; w = (xcd < r ? xcd * (q + 1) : r * (q + 1) + (xcd - r) * q) + off; }
        const int per = nM * nN; const int bt = w / per; w -= bt * per;
        const int nig = 8 * nN, gid = w / nig, fm = gid * 8, gsz = (nM - fm) < 8 ? (nM - fm) : 8;
        u.pm = fm + ((w % nig) % gsz); u.pn = (w % nig) / gsz; u.b1 = bt / nB2; u.b2 = bt % nB2; return true;
    }
};

typedef f32x4 Acc[2][2][4][2];

template <int ACT> struct EpiStore {
    static constexpr bool PERM = true;
    bf16_t* C; int ldc; size_t cS1, cS2; int ncols; float scale;
    __device__ __forceinline__ void operator()(const Acc& acc, const Unit& u, int wr, int wc, int fr, int fq) const {
        asm volatile("" : "+v"(fr), "+v"(fq));
        bf16_t* base = C + u.b1 * cS1 + u.b2 * cS2;
        const int row0 = u.pm * BM + wr * 64 + fr, col0 = u.pn * BM + wc * 32 + 8 * fq;
#pragma unroll
        for (int ai = 0; ai < 2; ++ai)
#pragma unroll
            for (int m = 0; m < 4; ++m) { bf16_t* rowp = base + (size_t)(row0 + ai * HALF + m * 16) * ldc + col0;
#pragma unroll
                for (int bj = 0; bj < 2; ++bj) { f32x4 v0 = acc[ai][bj][m][0], v1 = acc[ai][bj][m][1];
                    if (ACT == 1) {
#pragma unroll
                        for (int e = 0; e < 4; ++e) { float a0 = fmaxf(v0[e], 0.f), a1 = fmaxf(v1[e], 0.f); v0[e] = a0 * a0; v1[e] = a1 * a1; } }
                    v0 = v0 * scale; v1 = v1 * scale;
                    u32x4 w; w.x = pk2(v0[0], v0[1]); w.y = pk2(v0[2], v0[3]); w.z = pk2(v1[0], v1[1]); w.w = pk2(v1[2], v1[3]);
                    if (col0 + bj * HALF < ncols) *(u32x4*)(rowp + bj * HALF) = w; }
                asm volatile("" ::: "memory"); }
    }
};
struct EpiF32 {
    static constexpr bool PERM = false;
    float* C; int ldc; size_t cS1, cS2;
    __device__ __forceinline__ void operator()(const Acc& acc, const Unit& u, int wr, int wc, int fr, int fq) const {
        asm volatile("" : "+v"(fr), "+v"(fq));
        float* base = C + u.b1 * cS1 + u.b2 * cS2;
        const int row0 = u.pm * BM + wr * 64 + fr, col0 = u.pn * BM + wc * 32 + 4 * fq;
#pragma unroll
        for (int ai = 0; ai < 2; ++ai)
#pragma unroll
            for (int m = 0; m < 4; ++m) { float* rowp = base + (size_t)(row0 + ai * HALF + m * 16) * ldc + col0;
#pragma unroll
                for (int bj = 0; bj < 2; ++bj)
#pragma unroll
                    for (int n = 0; n < 2; ++n) *(f32x4*)(rowp + bj * HALF + n * 16) = acc[ai][bj][m][n];
                asm volatile("" ::: "memory"); }
    }
};
struct EpiResid {
    static constexpr bool PERM = false;
    float* H; float alpha;
    __device__ __forceinline__ void operator()(const Acc& acc, const Unit& u, int wr, int wc, int fr, int fq) const {
        asm volatile("" : "+v"(fr), "+v"(fq));
        const int row0 = u.pm * BM + wr * 64 + fr, col0 = u.pn * BM + wc * 32 + 4 * fq;
#pragma unroll
        for (int ai = 0; ai < 2; ++ai)
#pragma unroll
            for (int m = 0; m < 4; ++m) { float* rowp = H + (size_t)(row0 + ai * HALF + m * 16) * D_ + col0;
#pragma unroll
                for (int bj = 0; bj < 2; ++bj)
#pragma unroll
                    for (int n = 0; n < 2; ++n) { f32x4* p = (f32x4*)(rowp + bj * HALF + n * 16); const f32x4 h = *p; *p = h * alpha + acc[ai][bj][m][n]; }
                asm volatile("" ::: "memory"); }
    }
};
struct EpiS5Y {
    static constexpr bool PERM = true;
    bf16_t* MIXED;
    __device__ __forceinline__ void operator()(const Acc& acc, const Unit& u, int wr, int wc, int fr, int fq) const {
        asm volatile("" : "+v"(fr), "+v"(fq));
        const int row0 = u.pm * BM + wr * 64 + fr, col0 = wc * 32 + 8 * fq;
#pragma unroll
        for (int ai = 0; ai < 2; ++ai)
#pragma unroll
            for (int m = 0; m < 4; ++m) { const int row = row0 + ai * HALF + m * 16;
#pragma unroll
                for (int bj = 0; bj < 2; ++bj) { const int col = col0 + bj * HALF, j = col >> 4, ho = col & 15;
                    const f32x4 v0 = acc[ai][bj][m][0], v1 = acc[ai][bj][m][1];
                    u32x4 w; w.x = pk2(gelu_tanh(v0[0]), gelu_tanh(v0[1])); w.y = pk2(gelu_tanh(v0[2]), gelu_tanh(v0[3])); w.z = pk2(gelu_tanh(v1[0]), gelu_tanh(v1[1])); w.w = pk2(gelu_tanh(v1[2]), gelu_tanh(v1[3]));
                    *(u32x4*)(MIXED + ((size_t)row * 16 + j) * D_ + 768 + u.b1 * 16 + ho) = w; asm volatile("" ::: "memory"); } }
    }
};
struct EpiGLU {
    static constexpr bool PERM = true;
    bf16_t* MIXED; const float* bias;
    __device__ __forceinline__ void operator()(const Acc& acc, const Unit& u, int wr, int wc, int fr, int fq) const {
        asm volatile("" : "+v"(fr), "+v"(fq));
        const int row0 = u.pm * BM + wr * 64 + fr, col0 = wc * 32 + 8 * fq;
#pragma unroll
        for (int ai = 0; ai < 2; ++ai)
#pragma unroll
            for (int m = 0; m < 4; ++m) { const int row = row0 + ai * HALF + m * 16;
#pragma unroll
                for (int bj = 0; bj < 2; ++bj) { const int col = col0 + bj * HALF;
                    u32x4* gp = (u32x4*)(MIXED + (size_t)row * D_ + 768 + col); const u32x4 gv = *gp;
                    const f32x4 b0 = *(const f32x4*)(bias + col), b1 = *(const f32x4*)(bias + col + 4);
                    const f32x4 v0 = acc[ai][bj][m][0] + b0, v1 = acc[ai][bj][m][1] + b1;
                    float o[8]; const unsigned gw[4] = {gv.x, gv.y, gv.z, gv.w};
#pragma unroll
                    for (int e = 0; e < 4; ++e) { const float a = e < 2 ? v0[2 * e] : v1[2 * e - 4], b = e < 2 ? v0[2 * e + 1] : v1[2 * e - 3];
                        o[2 * e] = bflo(gw[e]) * __builtin_amdgcn_rcpf(1.f + __expf(-a)); o[2 * e + 1] = bfhi(gw[e]) * __builtin_amdgcn_rcpf(1.f + __expf(-b)); }
                    u32x4 w; w.x = pk2(o[0], o[1]); w.y = pk2(o[2], o[3]); w.z = pk2(o[4], o[5]); w.w = pk2(o[6], o[7]);
                    *gp = w; asm volatile("" ::: "memory"); } }
    }
};

struct EpiSoftmax {
    static constexpr bool PERM = true;
    bf16_t* C; int ldc; size_t cS1, cS2; LAS float* red;
    __device__ __forceinline__ void operator()(const Acc& acc, const Unit& u, int wr, int wc, int fr, int fq) const {
        asm volatile("" : "+v"(fr), "+v"(fq));
        LAS float* red2 = red + 1024;
        float mx[2][4];
#pragma unroll
        for (int ai = 0; ai < 2; ++ai)
#pragma unroll
            for (int m = 0; m < 4; ++m) { float v = -1e30f;
#pragma unroll
                for (int bj = 0; bj < 2; ++bj)
#pragma unroll
                    for (int n = 0; n < 2; ++n) { const f32x4 x = acc[ai][bj][m][n]; v = fmaxf(v, fmaxf(fmaxf(x[0], x[1]), fmaxf(x[2], x[3]))); }
                v = fmaxf(v, __shfl_xor(v, 16)); v = fmaxf(v, __shfl_xor(v, 32));
                if (fq == 0) red[(ai * HALF + wr * 64 + m * 16 + fr) * 4 + wc] = v; }
        asm volatile("s_waitcnt lgkmcnt(0)" ::: "memory"); __builtin_amdgcn_s_barrier(); asm volatile("" ::: "memory");
        float sm[2][4];
#pragma unroll
        for (int ai = 0; ai < 2; ++ai)
#pragma unroll
            for (int m = 0; m < 4; ++m) { const f32x4 r4 = *(const LAS f32x4*)(red + (ai * HALF + wr * 64 + m * 16 + fr) * 4);
                const float M = fmaxf(fmaxf(r4[0], r4[1]), fmaxf(r4[2], r4[3])); mx[ai][m] = M; float s = 0.f;
#pragma unroll
                for (int bj = 0; bj < 2; ++bj)
#pragma unroll
                    for (int n = 0; n < 2; ++n) { const f32x4 x = acc[ai][bj][m][n]; s += (__expf(x[0] - M) + __expf(x[1] - M)) + (__expf(x[2] - M) + __expf(x[3] - M)); }
                s += __shfl_xor(s, 16); s += __shfl_xor(s, 32);
                if (fq == 0) red2[(ai * HALF + wr * 64 + m * 16 + fr) * 4 + wc] = s; }
        asm volatile("s_waitcnt lgkmcnt(0)" ::: "memory"); __builtin_amdgcn_s_barrier(); asm volatile("" ::: "memory");
        bf16_t* base = C + u.b1 * cS1 + u.b2 * cS2;
        const int row0 = u.pm * BM + wr * 64 + fr, col0 = wc * 32 + 8 * fq;
#pragma unroll
        for (int ai = 0; ai < 2; ++ai)
#pragma unroll
            for (int m = 0; m < 4; ++m) { const f32x4 r4 = *(const LAS f32x4*)(red2 + (ai * HALF + wr * 64 + m * 16 + fr) * 4);
                const float inv = 1.f / ((r4[0] + r4[1]) + (r4[2] + r4[3])), M = mx[ai][m];
                bf16_t* rowp = base + (size_t)(row0 + ai * HALF + m * 16) * ldc + col0;
#pragma unroll
                for (int bj = 0; bj < 2; ++bj) { const f32x4 v0 = acc[ai][bj][m][0], v1 = acc[ai][bj][m][1];
                    u32x4 w; w.x = pk2(__expf(v0[0] - M) * inv, __expf(v0[1] - M) * inv); w.y = pk2(__expf(v0[2] - M) * inv, __expf(v0[3] - M) * inv);
                    w.z = pk2(__expf(v1[0] - M) * inv, __expf(v1[1] - M) * inv); w.w = pk2(__expf(v1[2] - M) * inv, __expf(v1[3] - M) * inv);
                    *(u32x4*)(rowp + bj * HALF) = w; }
                asm volatile("" ::: "memory"); }
    }
};


__device__ __forceinline__ void row_stats(const float* SL, size_t row, float& mu, float& rs) {
    const f32x4 a = *(const f32x4*)(SL + row * 8), b = *(const f32x4*)(SL + row * 8 + 4);
    const float S = (a[0] + a[2]) + (b[0] + b[2]), Q = (a[1] + a[3]) + (b[1] + b[3]);
    mu = S * (1.f / D_); rs = rsqrtf(fmaxf(Q * (1.f / D_) - mu * mu, 0.f) + LN_EPS);
}
template <bool FIRST, bool LAST> struct EpiResidLN {
    static constexpr bool PERM = false;
    float* H; bf16_t* HB; const float* SLr; float* SLw; const LAS float* gl; const float* unused_; LAS float* red; float alpha;
    __device__ __forceinline__ void operator()(const Acc& acc, const Unit& u, int wr, int wc, int fr, int fq) const {
        asm volatile("" : "+v"(fr), "+v"(fq));
        const int col0 = u.pn * BM + wc * 32 + 4 * fq;
        const size_t rowb = (size_t)u.pm * BM + wr * 64 + fr;
        u32x2 hA[4], hB[4]; f32x4 sna = (f32x4){0.f, 0.f, 0.f, 0.f}, snb = (f32x4){0.f, 0.f, 0.f, 0.f};
        if (!FIRST) { sna = *(const f32x4*)(SLr + rowb * 8); snb = *(const f32x4*)(SLr + rowb * 8 + 4); }
#pragma unroll
        for (int q = 0; q < 4; ++q) { hA[q] = *(const u32x2*)(HB + rowb * D_ + col0 + (q >> 1) * HALF + (q & 1) * 16); hB[q] = *(const u32x2*)(HB + (rowb + 16) * D_ + col0 + (q >> 1) * HALF + (q & 1) * 16); }
#pragma unroll
        for (int i = 0; i < 8; ++i) { const int ai = i >> 2, m = i & 3; const int rl = ai * HALF + wr * 64 + m * 16 + fr; const size_t row = (size_t)u.pm * BM + rl;
                float mu = 0.f, rs = 1.f;
                if (!FIRST) { const float S = (sna[0] + sna[2]) + (snb[0] + snb[2]), Q = (sna[1] + sna[3]) + (snb[1] + snb[3]); mu = S * (1.f / D_); rs = rsqrtf(fmaxf(Q * (1.f / D_) - mu * mu, 0.f) + LN_EPS); }
                u32x2 hc[4];
#pragma unroll
                for (int q = 0; q < 4; ++q) { hc[q] = hA[q]; hA[q] = hB[q]; }
                if (i < 7) { const size_t rown = rowb + ((i + 1) >> 2) * HALF + ((i + 1) & 3) * 16;
                    if (!FIRST) { sna = *(const f32x4*)(SLr + rown * 8); snb = *(const f32x4*)(SLr + rown * 8 + 4); } }
                if (i < 6) { const size_t rown = rowb + ((i + 2) >> 2) * HALF + ((i + 2) & 3) * 16;
#pragma unroll
                    for (int q = 0; q < 4; ++q) hB[q] = *(const u32x2*)(HB + rown * D_ + col0 + (q >> 1) * HALF + (q & 1) * 16); }
                float sm = 0.f, sq = 0.f; float* hp = H + row * D_ + col0; bf16_t* bp = HB + row * D_ + col0;
#pragma unroll
                for (int q = 0; q < 4; ++q) { const int bj = q >> 1, n = q & 1, co = bj * HALF + n * 16; f32x4 h = (f32x4){bflo(hc[q].x), bfhi(hc[q].x), bflo(hc[q].y), bfhi(hc[q].y)};
                        if (!FIRST) { const f32x4 g = *(const LAS f32x4*)(gl + col0 + co), b = *(const LAS f32x4*)(gl + D_ + col0 + co); h = (h - mu) * rs * g + b; }
                        const f32x4 pre = h * alpha + acc[ai][bj][m][n];
                        if (LAST) *(f32x4*)(hp + co) = pre;
                        else { u32x2 w; w.x = pk2(pre[0], pre[1]); w.y = pk2(pre[2], pre[3]); *(u32x2*)(bp + co) = w; }
                        sm += (pre[0] + pre[1]) + (pre[2] + pre[3]); sq += (pre[0] * pre[0] + pre[1] * pre[1]) + (pre[2] * pre[2] + pre[3] * pre[3]); }
                sm += __shfl_xor(sm, 16); sm += __shfl_xor(sm, 32); sq += __shfl_xor(sq, 16); sq += __shfl_xor(sq, 32);
                if (fq == 0) *(LAS f32x2*)(red + (rl * 4 + wc) * 2) = (f32x2){sm, sq};
                asm volatile("" ::: "memory"); }
        asm volatile("s_waitcnt lgkmcnt(0)" ::: "memory"); __builtin_amdgcn_s_barrier(); asm volatile("" ::: "memory");
        const int t = (wr * 4 + wc) * 64 + fq * 16 + fr;
        if (t < 256) { const f32x4 p0 = *(const LAS f32x4*)(red + t * 8), p1 = *(const LAS f32x4*)(red + t * 8 + 4);
            *(f32x2*)(SLw + ((size_t)u.pm * BM + t) * 8 + u.pn * 2) = (f32x2){(p0[0] + p0[2]) + (p1[0] + p1[2]), (p0[1] + p0[3]) + (p1[1] + p1[3])}; }
    }
};
template <int ACT> struct EpiStoreLN {
    static constexpr bool PERM = true;
    bf16_t* C; int ldc; int ncols; float scale; const float* SLr; const float* CS; const float* CB;
    __device__ __forceinline__ void operator()(const Acc& acc, const Unit& u, int wr, int wc, int fr, int fq) const {
        asm volatile("" : "+v"(fr), "+v"(fq));
        const int row0 = u.pm * BM + wr * 64 + fr, col0 = u.pn * BM + wc * 32 + 8 * fq;
        f32x4 cs[2][2], cbv[2][2];
#pragma unroll
        for (int bj = 0; bj < 2; ++bj) { const int c = col0 + bj * HALF; cs[bj][0] = *(const f32x4*)(CS + c); cs[bj][1] = *(const f32x4*)(CS + c + 4); cbv[bj][0] = *(const f32x4*)(CB + c); cbv[bj][1] = *(const f32x4*)(CB + c + 4); }
        f32x4 sna = *(const f32x4*)(SLr + (size_t)row0 * 8), snb = *(const f32x4*)(SLr + (size_t)row0 * 8 + 4);
#pragma unroll
        for (int i = 0; i < 8; ++i) { const int ai = i >> 2, m = i & 3; const size_t row = (size_t)(row0 + ai * HALF + m * 16);
            const float S = (sna[0] + sna[2]) + (snb[0] + snb[2]), Q = (sna[1] + sna[3]) + (snb[1] + snb[3]); const float mu = S * (1.f / D_), rs = rsqrtf(fmaxf(Q * (1.f / D_) - mu * mu, 0.f) + LN_EPS);
            if (i < 7) { const size_t rown = (size_t)(row0 + ((i + 1) >> 2) * HALF + ((i + 1) & 3) * 16); sna = *(const f32x4*)(SLr + rown * 8); snb = *(const f32x4*)(SLr + rown * 8 + 4); }
            bf16_t* rowp = C + row * ldc + col0;
#pragma unroll
            for (int bj = 0; bj < 2; ++bj) { const int c = col0 + bj * HALF;
                f32x4 v0 = (acc[ai][bj][m][0] - cs[bj][0] * mu) * rs + cbv[bj][0], v1 = (acc[ai][bj][m][1] - cs[bj][1] * mu) * rs + cbv[bj][1];
                if (ACT == 1) {
#pragma unroll
                    for (int e = 0; e < 4; ++e) { float a0 = fmaxf(v0[e], 0.f), a1 = fmaxf(v1[e], 0.f); v0[e] = a0 * a0; v1[e] = a1 * a1; } }
                v0 = v0 * scale; v1 = v1 * scale;
                u32x4 w; w.x = pk2(v0[0], v0[1]); w.y = pk2(v0[2], v0[3]); w.z = pk2(v1[0], v1[1]); w.w = pk2(v1[2], v1[3]);
                if (c < ncols) *(u32x4*)(rowp + bj * HALF) = w; }
            asm volatile("" ::: "memory"); }
    }
};

template <class Epi>
__device__ __forceinline__ void gemm_phase(LAS unsigned char* lds, const Gemm g, const Sched& S, const Epi& E) {
    constexpr bool ALIGN_EPI = true;
    const int tid = ltid(), wid = __builtin_amdgcn_readfirstlane(tid >> 6), lane = tid & 63, wr = wid >> 2, wc = wid & 3, fr = lane & 15, fq = lane >> 4;
    int K_ = g.K; asm volatile("" : "+s"(K_)); const int K = K_, nt = K / BK;
    unsigned voffA[2], voffB[2];
#pragma unroll
    for (int i = 0; i < 2; ++i) { int R, C; stage_rc(tid * 16 + i * 8192, R, C); const int Rb = Epi::PERM ? ((R & ~31) + perm32(R & 31)) : R;
        voffA[i] = (unsigned)(R * g.lda + C) * 2u; voffB[i] = (unsigned)(Rb * g.ldb + C) * 2u; }
    const size_t kstep = (size_t)(BK * 2);
    const size_t hstepA = (size_t)HALF * g.lda * 2, hstepB = (size_t)HALF * g.ldb * 2;
    const unsigned ldsw = (unsigned)wid * 1024u;
    const int aoff = lds_byte(wr * 64 + fr, fq * 8), boff = lds_byte(wc * 32 + fr, fq * 8);
#define PG8_UA(u) ((const char*)g.A + ((size_t)(u).b1 * g.aS1 + (size_t)(u).b2 * g.aS2 + (size_t)(u).pm * BM * g.lda) * 2)
#define PG8_UB(u) ((const char*)g.Bt + ((size_t)(u).b1 * g.bS1 + (size_t)(u).b2 * g.bS2 + (size_t)(u).pn * BM * g.ldb) * 2)
#define PG8_SA(b, h) (((b) * 2 + (h)) * HTB)
#define PG8_SB(b, h) ((4 + (b) * 2 + (h)) * HTB)
#define PG8_STAGE(bufoff, gbase, voff) do { _Pragma("unroll") for (int _i = 0; _i < 2; ++_i) \
        __builtin_amdgcn_global_load_lds((const unsigned*)((const char*)(gbase) + (voff)[_i]), (LAS unsigned*)(lds + (bufoff) + ldsw + _i * 8192), 16, 0, 0); } while (0)
#define PG8_LDA(dst, b, h) do { _Pragma("unroll") for (int m = 0; m < 4; ++m) _Pragma("unroll") for (int k = 0; k < 2; ++k) dst[m][k] = *(const LAS bf16x8*)(lds + PG8_SA(b, h) + aoff + m * 2048 + k * 1024); } while (0)
#define PG8_LDB(dst, b, h) do { _Pragma("unroll") for (int n = 0; n < 2; ++n) _Pragma("unroll") for (int k = 0; k < 2; ++k) dst[n][k] = *(const LAS bf16x8*)(lds + PG8_SB(b, h) + boff + n * 2048 + k * 1024); } while (0)
#define PG8_MMA(ai, bj, At, Bt) do { __builtin_amdgcn_s_setprio(1); _Pragma("unroll") for (int m = 0; m < 4; ++m) _Pragma("unroll") for (int n = 0; n < 2; ++n) _Pragma("unroll") for (int k = 0; k < 2; ++k) \
        acc[ai][bj][m][n] = __builtin_amdgcn_mfma_f32_16x16x32_bf16(Bt[n][k], At[m][k], acc[ai][bj][m][n], 0, 0, 0); __builtin_amdgcn_s_setprio(0); } while (0)
#define PG8_WAIT_V(n) asm volatile("s_waitcnt vmcnt(" #n ")" ::: "memory")
#define PG8_WAIT_L(n) asm volatile("s_waitcnt lgkmcnt(" #n ")" ::: "memory")
#define PG8_BAR __builtin_amdgcn_s_barrier()
#define PG8_SCHED __builtin_amdgcn_sched_barrier(0)
    Unit cur, nxt; int ui = 0;
    if (!S.next(0, cur)) return;
    Acc acc;
#pragma unroll
    for (int a = 0; a < 2; ++a)
#pragma unroll
        for (int b = 0; b < 2; ++b)
#pragma unroll
            for (int m = 0; m < 4; ++m)
#pragma unroll
                for (int n = 0; n < 2; ++n) acc[a][b][m][n] = (f32x4){0.f, 0.f, 0.f, 0.f};
    bf16x8 At[4][2], B0[2][2], B1[2][2];
    const char* cA = PG8_UA(cur); const char* cB = PG8_UB(cur);
    PG8_STAGE(PG8_SB(0, 0), cB, voffB); PG8_STAGE(PG8_SB(0, 1), cB + hstepB, voffB); PG8_STAGE(PG8_SA(0, 0), cA, voffA); PG8_STAGE(PG8_SA(0, 1), cA + hstepA, voffA);
    if (wr == 1) PG8_BAR;
    PG8_WAIT_V(2); PG8_BAR;
    PG8_STAGE(PG8_SB(1, 0), cB + kstep, voffB); PG8_STAGE(PG8_SA(1, 0), cA + kstep, voffA); PG8_STAGE(PG8_SB(1, 1), cB + hstepB + kstep, voffB);
    PG8_WAIT_V(6); PG8_BAR;
    for (;;) {
        const bool has_next = S.next(ui + 1, nxt);
        const char* nA = has_next ? PG8_UA(nxt) : cA; const char* nB = has_next ? PG8_UB(nxt) : cB;
        for (int t = 0; t < nt; t += 2) {
            const bool last = (t == nt - 2);
            const char* a1 = cA + (size_t)(t + 1) * kstep;
            const char* a2 = last ? nA : cA + (size_t)(t + 2) * kstep; const char* b2 = last ? nB : cB + (size_t)(t + 2) * kstep;
            const char* a3 = a2 + kstep; const char* b3 = b2 + kstep;
            PG8_LDB(B0, 0, 0); PG8_LDB(B1, 0, 1); PG8_SCHED; PG8_LDA(At, 0, 0); PG8_STAGE(PG8_SA(1, 1), a1 + hstepA, voffA);
            PG8_WAIT_V(8); PG8_WAIT_L(0); PG8_BAR; PG8_MMA(0, 0, At, B0); PG8_MMA(0, 1, At, B1); PG8_BAR; PG8_SCHED;
            PG8_LDA(At, 0, 1); PG8_STAGE(PG8_SB(0, 0), b2, voffB); PG8_STAGE(PG8_SB(0, 1), b2 + hstepB, voffB); PG8_STAGE(PG8_SA(0, 0), a2, voffA);
            PG8_WAIT_V(8); PG8_WAIT_L(0); PG8_BAR; PG8_MMA(1, 0, At, B0); PG8_MMA(1, 1, At, B1); PG8_BAR; PG8_SCHED;
            PG8_LDB(B0, 1, 0); PG8_LDB(B1, 1, 1); PG8_SCHED; PG8_LDA(At, 1, 0); PG8_STAGE(PG8_SA(0, 1), a2 + hstepA, voffA);
            PG8_WAIT_V(8); PG8_WAIT_L(0); PG8_BAR; PG8_MMA(0, 0, At, B0); PG8_MMA(0, 1, At, B1); PG8_BAR; PG8_SCHED;
            PG8_LDA(At, 1, 1); PG8_STAGE(PG8_SB(1, 0), b3, voffB); PG8_STAGE(PG8_SB(1, 1), b3 + hstepB, voffB); PG8_STAGE(PG8_SA(1, 0), a3, voffA);
            PG8_WAIT_V(8); PG8_WAIT_L(0); PG8_BAR; PG8_MMA(1, 0, At, B0); PG8_MMA(1, 1, At, B1); PG8_BAR; PG8_SCHED;
        }
        if constexpr (ALIGN_EPI) { if (wr == 0) PG8_BAR; }
        E(acc, cur, wr, wc, fr, fq);
        if (!has_next) break;
#pragma unroll
        for (int a = 0; a < 2; ++a)
#pragma unroll
            for (int b = 0; b < 2; ++b)
#pragma unroll
                for (int m = 0; m < 4; ++m)
#pragma unroll
                    for (int n = 0; n < 2; ++n) acc[a][b][m][n] = (f32x4){0.f, 0.f, 0.f, 0.f};
        cur = nxt; cA = nA; cB = nB; ++ui;
        if constexpr (ALIGN_EPI) { if (wr == 1) PG8_BAR; }
    }
    PG8_WAIT_V(0);
    if constexpr (!ALIGN_EPI) { if (wr == 0) PG8_BAR; }
    PG8_BAR;
#undef PG8_UA
#undef PG8_UB
#undef PG8_SA
#undef PG8_SB
#undef PG8_STAGE
#undef PG8_LDA
#undef PG8_LDB
#undef PG8_MMA
#undef PG8_WAIT_V
#undef PG8_WAIT_L
#undef PG8_BAR
#undef PG8_SCHED
}
}

struct Args { const float* in[35]; float* out; unsigned char* ws; int ph_lo, ph_hi, coop, pad; };
enum { I_X = 0, I_MEM, I_LNIN_G, I_LNIN_B, I_WIN, I_RPB, I_CONVW, I_CONVB, I_DTB, I_ALOG, I_SSDD, I_SSDNW, I_LRE, I_LIM, I_LOGDT, I_BRE, I_BIM, I_CRE, I_CIM, I_S5D, I_GLUW, I_GLUB,
       I_WOUT, I_LNMIX_G, I_LNMIX_B, I_WQ, I_WK, I_WV, I_WO, I_LNXA_G, I_LNXA_B, I_W1, I_W2, I_LNMLP_G, I_LNMLP_B };

__device__ __forceinline__ int opq(int i) { asm volatile("" : "+s"(i)); return i; }
__device__ __forceinline__ void transpose_item(const float* W, int K, int N, bf16_t* WT, LAS float* scr, int item, int nblk, int lane, const float* rs) {
    const int kb = item / nblk, nb = item % nblk, k0 = 64 * kb, n0 = 32 * nb;
    const int nn = n0 + (lane & 31);
#pragma unroll
    for (int i = 0; i < 32; ++i) { const int kk = 2 * i + (lane >> 5); scr[kk * 33 + (lane & 31)] = (nn < N) ? W[(size_t)(k0 + kk) * N + nn] * (rs ? rs[k0 + kk] : 1.f) : 0.f; }
    LDS_WAIT();
    const int c = lane & 7;
#pragma unroll
    for (int j = 0; j < 4; ++j) { const int n = (lane >> 3) + 8 * j; const LAS float* s = scr + (8 * c) * 33 + n;
        u32x4 o; o.x = pk2(s[0 * 33], s[1 * 33]); o.y = pk2(s[2 * 33], s[3 * 33]); o.z = pk2(s[4 * 33], s[5 * 33]); o.w = pk2(s[6 * 33], s[7 * 33]);
        *(u32x4*)(WT + (size_t)(n0 + n) * K + k0 + 8 * c) = o; }
    LDS_WAIT();
}
__device__ __forceinline__ void tr_matrix(const float* W, int K, int N, int nblk, bf16_t* WT, LAS float* scr, int gw, int NGW, int lane, const float* rs = nullptr) {
    const int nitems = (K / 64) * nblk;
    for (int it = gw; it < nitems; it += NGW) transpose_item(W, K, N, WT, scr, it, nblk, lane, rs);
}
__device__ __forceinline__ void ln_row(const float* xrow, float* hrow, bf16_t* brow, const float* gam, const float* bet, int lane) {
    const f32x4* xr = (const f32x4*)xrow + lane;
    f32x4 v[4]; float s = 0.f;
#pragma unroll
    for (int j = 0; j < 4; ++j) { v[j] = xr[64 * j]; s += (v[j].x + v[j].y) + (v[j].z + v[j].w); }
    const float mean = wave_sum(s) * (1.f / D_); float s2 = 0.f;
#pragma unroll
    for (int j = 0; j < 4; ++j) { v[j] = v[j] - mean; s2 += (v[j].x * v[j].x + v[j].y * v[j].y) + (v[j].z * v[j].z + v[j].w * v[j].w); }
    const float rstd = rsqrtf(wave_sum(s2) * (1.f / D_) + LN_EPS);
    f32x4* ho = (f32x4*)hrow + lane; u32x2* bo = (u32x2*)brow + lane;
#pragma unroll
    for (int j = 0; j < 4; ++j) { const f32x4 g = ((const f32x4*)gam)[lane + 64 * j], b = ((const f32x4*)bet)[lane + 64 * j];
        const f32x4 y = v[j] * rstd * g + b; ho[64 * j] = y; u32x2 w; w.x = pk2(y.x, y.y); w.y = pk2(y.z, y.w); bo[64 * j] = w; }
}

__device__ __forceinline__ void ln_row2(const float* x0, const float* x1, float* h0, float* h1, bf16_t* b0, bf16_t* b1, const float* gam, const float* bet, int lane) {
    const f32x4* xr0 = (const f32x4*)x0 + lane; const f32x4* xr1 = (const f32x4*)x1 + lane;
    f32x4 v[4], w[4]; float s = 0.f, t = 0.f;
#pragma unroll
    for (int j = 0; j < 4; ++j) { v[j] = xr0[64 * j]; w[j] = xr1[64 * j]; }
#pragma unroll
    for (int j = 0; j < 4; ++j) { s += (v[j].x + v[j].y) + (v[j].z + v[j].w); t += (w[j].x + w[j].y) + (w[j].z + w[j].w); }
#pragma unroll
    for (int o = 1; o < 64; o <<= 1) { s += __shfl_xor(s, o); t += __shfl_xor(t, o); }
    const float m0 = s * (1.f / D_), m1 = t * (1.f / D_); float s2 = 0.f, t2 = 0.f;
#pragma unroll
    for (int j = 0; j < 4; ++j) { v[j] = v[j] - m0; w[j] = w[j] - m1; s2 += (v[j].x * v[j].x + v[j].y * v[j].y) + (v[j].z * v[j].z + v[j].w * v[j].w); t2 += (w[j].x * w[j].x + w[j].y * w[j].y) + (w[j].z * w[j].z + w[j].w * w[j].w); }
#pragma unroll
    for (int o = 1; o < 64; o <<= 1) { s2 += __shfl_xor(s2, o); t2 += __shfl_xor(t2, o); }
    const float r0 = rsqrtf(s2 * (1.f / D_) + LN_EPS), r1 = rsqrtf(t2 * (1.f / D_) + LN_EPS);
    f32x4* ho0 = (f32x4*)h0 + lane; f32x4* ho1 = (f32x4*)h1 + lane; u32x2* bo0 = (u32x2*)b0 + lane; u32x2* bo1 = (u32x2*)b1 + lane;
#pragma unroll
    for (int j = 0; j < 4; ++j) { const f32x4 g = ((const f32x4*)gam)[lane + 64 * j], b = ((const f32x4*)bet)[lane + 64 * j];
        const f32x4 y0 = v[j] * r0 * g + b, y1 = w[j] * r1 * g + b; if (h0) { ho0[64 * j] = y0; ho1[64 * j] = y1; }
        if (b0) { u32x2 p; p.x = pk2(y0.x, y0.y); p.y = pk2(y0.z, y0.w); bo0[64 * j] = p; p.x = pk2(y1.x, y1.y); p.y = pk2(y1.z, y1.w); bo1[64 * j] = p; } }
}
__device__ __forceinline__ void s5_item(const Args& a, LAS unsigned char* lds, int item, int tid) {
    const int j = item & 15, g = (item >> 4) & 15, l = item >> 8;
    LAS f32x2* Ap = (LAS f32x2*)(lds + 73728);
    LAS f32x2* Bb = (LAS f32x2*)(lds + 73728 + 17408);
    LAS f32x2* Cc = (LAS f32x2*)(lds + 73728 + 17408 + 16384);
    for (int e = tid; e < 2 * 17 * 64; e += 512) { const int p = e & 63, d = (e >> 6) % 17, dir = e / (17 * 64);
        const int gi = (l * 2 + dir) * 16 + g; const float dt = expf(gp(a.in[I_LOGDT])[gi]); const float lr = gp(a.in[I_LRE])[gi * 64 + p], li = gp(a.in[I_LIM])[gi * 64 + p];
        const float mag = expf((float)d * lr * dt); const float th = (float)d * (li * dt); Ap[e] = (f32x2){mag * cosf(th), mag * sinf(th)}; }
    for (int e = tid; e < 2 * 64 * 16; e += 512) { const int h = e & 15, p = (e >> 4) & 63, dir = e >> 10;
        const int gi = (l * 2 + dir) * 16 + g; const float dt = expf(gp(a.in[I_LOGDT])[gi]); const float lr = gp(a.in[I_LRE])[gi * 64 + p], li = gp(a.in[I_LIM])[gi * 64 + p];
        const float mag = expf(lr * dt); const float ar = mag * cosf(li * dt), ai = mag * sinf(li * dt); const float den = lr * lr + li * li;
        const float fr = ((ar - 1.f) * lr + ai * li) / den, fi = (ai * lr - (ar - 1.f) * li) / den;
        const float br = gp(a.in[I_BRE])[((size_t)gi * 64 + p) * 16 + h], bi = gp(a.in[I_BIM])[((size_t)gi * 64 + p) * 16 + h];
        Bb[e] = (f32x2){fr * br - fi * bi, fr * bi + fi * br}; }
    for (int e = tid; e < 2 * 16 * 64; e += 512) { const int p = e & 63, h = (e >> 6) & 15, dir = e >> 10;
        const int gi = (l * 2 + dir) * 16 + g; Cc[e] = (f32x2){gp(a.in[I_CRE])[((size_t)gi * 16 + h) * 64 + p], gp(a.in[I_CIM])[((size_t)gi * 16 + h) * 64 + p]}; }
    __syncthreads();
    bf16_t* TM = (bf16_t*)(lptr(a.ws) + WS_TM) + ((size_t)(l * 16 + g) * 256 + j * 16) * 512;
    for (int e = tid; e < 16 * 512; e += 512) { const int k = e & 511, ho = e >> 9; float v = 0.f;
        if (k < 256) { const int i = k >> 4, hi = k & 15;
            if (i <= j) { const int dd = j - i; float s = 0.f;
                for (int p = 0; p < 64; ++p) { const f32x2 c = Cc[(0 * 16 + ho) * 64 + p], ap = Ap[(0 * 17 + dd) * 64 + p], bb = Bb[(0 * 64 + p) * 16 + hi];
                    const float wr_ = c.x * ap.x - c.y * ap.y, wi_ = c.x * ap.y + c.y * ap.x; s += wr_ * bb.x - wi_ * bb.y; }
                v += s; }
            if (i >= j) { const int dd = i - j; float s = 0.f;
                for (int p = 0; p < 64; ++p) { const f32x2 c = Cc[(1 * 16 + ho) * 64 + p], ap = Ap[(1 * 17 + dd) * 64 + p], bb = Bb[(1 * 64 + p) * 16 + hi];
                    const float wr_ = c.x * ap.x - c.y * ap.y, wi_ = c.x * ap.y + c.y * ap.x; s += wr_ * bb.x - wi_ * bb.y; }
                v += s; }
            if (i == j && hi == ho) v += gp(a.in[I_S5D])[l * 256 + g * 16 + ho];
        } else { const int dir = (k >= 384), p = ((k - 256) & 127) >> 1, ri = k & 1; const int dd = dir ? 16 - j : j + 1;
            const f32x2 c = Cc[(dir * 16 + ho) * 64 + p], ap = Ap[(dir * 17 + dd) * 64 + p];
            v = ri ? -(c.x * ap.y + c.y * ap.x) : (c.x * ap.x - c.y * ap.y); }
        TM[(size_t)ho * 512 + k] = (bf16_t)f2bf(v); }
    bf16_t* SM = (bf16_t*)(lptr(a.ws) + WS_SM) + ((size_t)(l * 16 + g) * 256 + j * 16) * 256;
    for (int e = tid; e < 16 * 256; e += 512) { const int k = e & 255, nn = e >> 8, n = j * 16 + nn; const int dir = n >> 7, p = (n & 127) >> 1, ri = n & 1, i = k >> 4, hi = k & 15;
        const int dd = dir ? i : 15 - i; const f32x2 ap = Ap[(dir * 17 + dd) * 64 + p], bb = Bb[(dir * 64 + p) * 16 + hi];
        const float v = ri ? (ap.x * bb.y + ap.y * bb.x) : (ap.x * bb.x - ap.y * bb.y);
        SM[(size_t)nn * 256 + k] = (bf16_t)f2bf(v); }
    if (j == 0 && tid < 128) { const int dir = tid >> 6, p = tid & 63; ((f32x2*)(lptr(a.ws) + WS_MISC))[((l * 2 + dir) * 16 + g) * 64 + p] = Ap[(dir * 17 + 16) * 64 + p]; }
    __syncthreads();
}

__device__ __forceinline__ void prologue(const Args& a, LAS unsigned char* lds, int G) {
    const int tid = ltid(), lane = tid & 63, wave = tid >> 6;
    const int gw = lbid() * 8 + wave, NGW = G * 8;
    LAS float* scr = (LAS float*)(lds + wave * 8448);
    for (int l = 0; l < 2; ++l) {
        unsigned char* wb = lptr(a.ws) + WS_W + l * LWB;
        tr_matrix(gp(a.in[I_WIN]) + (size_t)l * D_ * NP, D_, NP, NPP / 32, (bf16_t*)(wb + OW_IN), scr, gw, NGW, lane, l == 1 ? gp(a.in[I_LNMLP_G]) : nullptr);
        tr_matrix(gp(a.in[I_WOUT]) + (size_t)l * D_ * D_, D_, D_, 32, (bf16_t*)(wb + OW_OUT), scr, gw, NGW, lane);
        tr_matrix(gp(a.in[I_WQ]) + (size_t)l * D_ * D_, D_, D_, 32, (bf16_t*)(wb + OW_Q), scr, gw, NGW, lane, gp(a.in[I_LNMIX_G]) + l * D_);
        tr_matrix(gp(a.in[I_WK]) + (size_t)l * D_ * D_, D_, D_, 32, (bf16_t*)(wb + OW_K), scr, gw, NGW, lane);
        tr_matrix(gp(a.in[I_WV]) + (size_t)l * D_ * D_, D_, D_, 32, (bf16_t*)(wb + OW_V), scr, gw, NGW, lane);
        tr_matrix(gp(a.in[I_WO]) + (size_t)l * D_ * D_, D_, D_, 32, (bf16_t*)(wb + OW_O), scr, gw, NGW, lane);
        tr_matrix(gp(a.in[I_W1]) + (size_t)l * D_ * FF_, D_, FF_, 128, (bf16_t*)(wb + OW_1), scr, gw, NGW, lane, gp(a.in[I_LNXA_G]) + l * D_);
        tr_matrix(gp(a.in[I_W2]) + (size_t)l * FF_ * D_, FF_, D_, 32, (bf16_t*)(wb + OW_2), scr, gw, NGW, lane);
        tr_matrix(gp(a.in[I_GLUW]) + (size_t)l * 256 * 256, 256, 256, 8, (bf16_t*)(wb + OW_GLU), scr, gw, NGW, lane);
    }
    { const int gt = lbid() * 512 + tid, NT = G * 512; const f32x4* src = (const f32x4*)gp(a.in[I_MEM]); u32x2* dst = (u32x2*)(lptr(a.ws) + WS_MEMB);
      for (int i = gt; i < B_ * MEMT * D_ / 4; i += NT) { const f32x4 v = src[i]; u32x2 w; w.x = pk2(v.x, v.y); w.y = pk2(v.z, v.w); dst[i] = w; } }
    __syncthreads();
    for (int it = lbid(); it < 512; it += G) s5_item(a, lds, it, tid);
    { const float* X = gp(a.in[I_X]); float* H = lptr(a.out); bf16_t* HBp = (bf16_t*)(lptr(a.ws) + WS_HB);
      for (int m = gw; m < M_ / 2; m += NGW) { const size_t r0 = (size_t)m * D_, r1 = (size_t)(m + M_ / 2) * D_;
          ln_row2(X + r0, X + r1, (float*)nullptr, (float*)nullptr, HBp + r0, HBp + r1, gp(a.in[I_LNIN_G]), gp(a.in[I_LNIN_B]), lane); } }
}


__device__ __forceinline__ float* cs_ptr(unsigned char* ws, int l, int set) {
    float* base = (float*)(ws + WS_MISC + MISC_CS) + (size_t)l * 16384;
    return base + (set == 0 ? 0 : set == 1 ? 2048 : 10240);
}
__device__ __forceinline__ void colsum_set(const bf16_t* WT, int N, const float* gam, const float* bet, float* CS, int gw, int NGW, int lane) {
    for (int n = gw; n < N; n += NGW) { const bf16_t* r = WT + (size_t)n * D_; float s = 0.f, c = 0.f;
#pragma unroll
        for (int j = 0; j < 2; ++j) { const int k = (lane + 64 * j) * 8; const u32x4 v = *(const u32x4*)(r + k);
            const f32x4 g0 = *(const f32x4*)(gam + k), g1 = *(const f32x4*)(gam + k + 4), b0 = *(const f32x4*)(bet + k), b1 = *(const f32x4*)(bet + k + 4);
            const float w[8] = {bflo(v.x), bfhi(v.x), bflo(v.y), bfhi(v.y), bflo(v.z), bfhi(v.z), bflo(v.w), bfhi(v.w)};
            s += ((w[0] + w[1]) + (w[2] + w[3])) + ((w[4] + w[5]) + (w[6] + w[7]));
            c += w[0] * (b0[0] / g0[0]) + w[1] * (b0[1] / g0[1]) + w[2] * (b0[2] / g0[2]) + w[3] * (b0[3] / g0[3]) + w[4] * (b1[0] / g1[0]) + w[5] * (b1[1] / g1[1]) + w[6] * (b1[2] / g1[2]) + w[7] * (b1[3] / g1[3]); }
        s = wave_sum(s); c = wave_sum(c);
        if (lane == 0) { CS[n] = s; CS[N + n] = c; } }
}
__device__ __forceinline__ void colsum_phase(const Args& a, int G) {
    const int tid = ltid(), lane = tid & 63, gw = lbid() * 8 + (tid >> 6), NGW = G * 8;
    unsigned char* ws = lptr(a.ws);
    for (int l = 0; l < 2; ++l) { unsigned char* wb = ws + WS_W + (size_t)l * LWB;
        colsum_set((const bf16_t*)(wb + OW_Q), D_, gp(a.in[I_LNMIX_G]) + l * D_, gp(a.in[I_LNMIX_B]) + l * D_, cs_ptr(ws, l, 0), gw, NGW, lane);
        colsum_set((const bf16_t*)(wb + OW_1), FF_, gp(a.in[I_LNXA_G]) + l * D_, gp(a.in[I_LNXA_B]) + l * D_, cs_ptr(ws, l, 1), gw, NGW, lane);
        if (l == 1) colsum_set((const bf16_t*)(wb + OW_IN), NPP, gp(a.in[I_LNMLP_G]), gp(a.in[I_LNMLP_B]), cs_ptr(ws, l, 2), gw, NGW, lane); }
}
__device__ __forceinline__ void na_phase(const bf16_t* PROJ, bf16_t* MIXED, const float* rpb, int G) {
    const int tid = ltid();
    for (int it = lbid(); it < 512; it += G) {
        const int h = it & 3, rg = (it >> 2) & 15, b = it >> 6;
        const int r = rg * 8 + (tid >> 6), c = tid & 63;
        const size_t row = (size_t)b * T_ + r * 64 + c;
        float q[64], o[64];
        { const u32x4* qp = (const u32x4*)(PROJ + row * NP + PQ + h * 64);
#pragma unroll
          for (int i = 0; i < 8; ++i) { const u32x4 v = qp[i]; q[8 * i + 0] = bflo(v.x) * 0.125f; q[8 * i + 1] = bfhi(v.x) * 0.125f; q[8 * i + 2] = bflo(v.y) * 0.125f; q[8 * i + 3] = bfhi(v.y) * 0.125f;
              q[8 * i + 4] = bflo(v.z) * 0.125f; q[8 * i + 5] = bfhi(v.z) * 0.125f; q[8 * i + 6] = bflo(v.w) * 0.125f; q[8 * i + 7] = bfhi(v.w) * 0.125f; } }
#pragma unroll
        for (int d = 0; d < 64; ++d) o[d] = 0.f;
        const int r0 = min(max(r - 4, 0), 120), c0 = min(max(c - 8, 0), 48);
        float mx = -1e30f, lsum = 0.f;
        const float* rp = rpb + h * 15 * 31;
#pragma unroll 1
        for (int kk = 0; kk < 128; ++kk) {
            const int kr = kk >> 4, kc = kk & 15;
            const int krow = r0 + kr;
            const bf16_t* kptr = PROJ + ((size_t)b * T_ + krow * 64 + c0 + kc) * NP + PK + h * 64;
            const u32x4* kp = (const u32x4*)kptr; float acc = 0.f;
#pragma unroll
            for (int i = 0; i < 8; ++i) { const u32x4 v = kp[i];
                acc += q[8 * i + 0] * bflo(v.x) + q[8 * i + 1] * bfhi(v.x) + q[8 * i + 2] * bflo(v.y) + q[8 * i + 3] * bfhi(v.y)
                     + q[8 * i + 4] * bflo(v.z) + q[8 * i + 5] * bfhi(v.z) + q[8 * i + 6] * bflo(v.w) + q[8 * i + 7] * bfhi(v.w); }
            int dc = c0 + kc - c; dc = min(max(dc, -15), 15);
            const float sc = acc + rp[(krow - r + 7) * 31 + dc + 15];
            if (sc > mx) { const float al = __expf(mx - sc); mx = sc; lsum *= al;
#pragma unroll
                for (int d = 0; d < 64; ++d) o[d] *= al; }
            const float p = __expf(sc - mx); lsum += p; const u32x4* vp = (const u32x4*)(kptr + (PV - PK));
#pragma unroll
            for (int i = 0; i < 8; ++i) { const u32x4 v = vp[i];
                o[8 * i + 0] += p * bflo(v.x); o[8 * i + 1] += p * bfhi(v.x); o[8 * i + 2] += p * bflo(v.y); o[8 * i + 3] += p * bfhi(v.y);
                o[8 * i + 4] += p * bflo(v.z); o[8 * i + 5] += p * bfhi(v.z); o[8 * i + 6] += p * bflo(v.w); o[8 * i + 7] += p * bfhi(v.w); }
        }
        const float inv = 1.f / lsum; u32x4* op = (u32x4*)(MIXED + row * D_ + h * 64);
#pragma unroll
        for (int i = 0; i < 8; ++i) { u32x4 w; w.x = pk2(o[8 * i] * inv, o[8 * i + 1] * inv); w.y = pk2(o[8 * i + 2] * inv, o[8 * i + 3] * inv); w.z = pk2(o[8 * i + 4] * inv, o[8 * i + 5] * inv); w.w = pk2(o[8 * i + 6] * inv, o[8 * i + 7] * inv); op[i] = w; }
    }
}

__device__ __forceinline__ void conv_phase(const bf16_t* PROJ, bf16_t* CONV, const float* cw, const float* cb, int G) {
    const int gt = lbid() * 512 + ltid(), NT = G * 512;
    for (int idx = gt; idx < (M_ / 8) * 96; idx += NT) { const int rb = idx / 96, ch = (idx - rb * 96) * 8, row0 = rb * 8, t0 = row0 & (T_ - 1);
        u32x4 x[12];
#pragma unroll
        for (int i = 0; i < 12; ++i) { const int tt = t0 + i - 2; x[i] = (tt >= 0 && tt < T_) ? *(const u32x4*)(PROJ + (size_t)(row0 + i - 2) * NP + PX + ch) : (u32x4){0u, 0u, 0u, 0u}; }
        float w[5][8], bias[8];
#pragma unroll
        for (int jj = 0; jj < 5; ++jj) { const f32x4 w0 = *(const f32x4*)(cw + jj * 768 + ch), w1 = *(const f32x4*)(cw + jj * 768 + ch + 4);
            w[jj][0] = w0[0]; w[jj][1] = w0[1]; w[jj][2] = w0[2]; w[jj][3] = w0[3]; w[jj][4] = w1[0]; w[jj][5] = w1[1]; w[jj][6] = w1[2]; w[jj][7] = w1[3]; }
        { const f32x4 b0 = *(const f32x4*)(cb + ch), b1 = *(const f32x4*)(cb + ch + 4); bias[0] = b0[0]; bias[1] = b0[1]; bias[2] = b0[2]; bias[3] = b0[3]; bias[4] = b1[0]; bias[5] = b1[1]; bias[6] = b1[2]; bias[7] = b1[3]; }
#pragma unroll
        for (int o = 0; o < 8; ++o) { float acc[8];
#pragma unroll
            for (int e = 0; e < 8; ++e) acc[e] = bias[e];
#pragma unroll
            for (int jj = 0; jj < 5; ++jj) { const u32x4 v = x[o + jj];
                acc[0] += w[jj][0] * bflo(v.x); acc[1] += w[jj][1] * bfhi(v.x); acc[2] += w[jj][2] * bflo(v.y); acc[3] += w[jj][3] * bfhi(v.y);
                acc[4] += w[jj][4] * bflo(v.z); acc[5] += w[jj][5] * bfhi(v.z); acc[6] += w[jj][6] * bflo(v.w); acc[7] += w[jj][7] * bfhi(v.w); }
            u32x4 r; r.x = pk2(silu_f(acc[0]), silu_f(acc[1])); r.y = pk2(silu_f(acc[2]), silu_f(acc[3])); r.z = pk2(silu_f(acc[4]), silu_f(acc[5])); r.w = pk2(silu_f(acc[6]), silu_f(acc[7]));
            *(u32x4*)(CONV + (size_t)(row0 + o) * 768 + ch) = r; } }
}
__device__ __forceinline__ void s5_gather_phase(const bf16_t* PROJ, bf16_t* UX, int G) {
    const int gt = lbid() * 512 + ltid(), NT = G * 512;
    for (int idx = gt; idx < M_ * 32; idx += NT) { const int row = idx >> 5, part = idx & 31, g = part >> 1, hf = part & 1, b = row >> 13, t = row & (T_ - 1), c = t >> 4, i = t & 15;
        const u32x4 v = *(const u32x4*)(PROJ + (size_t)row * NP + PU + g * 16 + hf * 8);
        *(u32x4*)(UX + ((size_t)g * 4096 + b * 512 + c) * 512 + i * 16 + hf * 8) = v; }
}

__device__ __forceinline__ float softplus_f(float x) { return x > 20.f ? x : log1pf(expf(x)); }

__device__ __forceinline__ void ssd_passA(const Args& a, int l, LAS unsigned char* lds, int G) {
    const bf16_t* PROJ = (const bf16_t*)(lptr(a.ws) + WS_PROJ); const bf16_t* CONV = (const bf16_t*)(lptr(a.ws) + WS_CONV);
    float* ST = (float*)(lptr(a.ws) + WS_ST); float* CD = (float*)(lptr(a.ws) + WS_MISC + 65536);
    const int tid = ltid(), sub = tid & 255, dir = tid >> 8, p = sub >> 2, nq = sub & 3;
    LAS float* dts = (LAS float*)lds; LAS float* dAs = dts + 256;
    for (int it = lbid(); it < 4096; it += G) {
        const int hd = it & 7, c = (it >> 3) & 63, b = it >> 9, g = hd >> 2;
        if (sub < 128) { const int s = sub; const size_t row = (size_t)b * T_ + c * 128 + s;
            const float raw = bf2f(PROJ[row * NP + PDT + dir * 8 + hd]); const float dt = softplus_f(raw + gp(a.in[I_DTB])[(l * 2 + dir) * 8 + hd]);
            const float av = -expf(gp(a.in[I_ALOG])[(l * 2 + dir) * 8 + hd]); dts[dir * 128 + s] = dt; dAs[dir * 128 + s] = expf(dt * av); }
        __syncthreads();
        float h[16];
#pragma unroll
        for (int j = 0; j < 16; ++j) h[j] = 0.f;
        float cdp = 1.f;
        for (int ss = 0; ss < 128; ++ss) { const int s = dir ? 127 - ss : ss; const size_t row = (size_t)b * T_ + c * 128 + s;
            const float dA = dAs[dir * 128 + s], dtv = dts[dir * 128 + s];
            const float xv = bf2f(CONV[row * 768 + hd * 64 + p]) * dtv;
            const u32x4* bp = (const u32x4*)(CONV + row * 768 + 512 + g * 64 + nq * 16); const u32x4 b0 = bp[0], b1 = bp[1];
            const unsigned bw[8] = {b0.x, b0.y, b0.z, b0.w, b1.x, b1.y, b1.z, b1.w};
#pragma unroll
            for (int j = 0; j < 8; ++j) { h[2 * j] = h[2 * j] * dA + xv * bflo(bw[j]); h[2 * j + 1] = h[2 * j + 1] * dA + xv * bfhi(bw[j]); }
            cdp *= dA; }
        float* sp = ST + ((((size_t)(b * 64 + c) * 8 + hd) * 2 + dir) * 64 + p) * 64 + nq * 16;
#pragma unroll
        for (int j = 0; j < 4; ++j) ((f32x4*)sp)[j] = (f32x4){h[4 * j], h[4 * j + 1], h[4 * j + 2], h[4 * j + 3]};
        if (sub == 0) CD[((b * 64 + c) * 8 + hd) * 2 + dir] = cdp;
        __syncthreads();
    }
}
__device__ __forceinline__ void ssd_scan(const Args& a, int G) {
    float* ST = (float*)(lptr(a.ws) + WS_ST); const float* CD = (const float*)(lptr(a.ws) + WS_MISC + 65536);
    const int gt = lbid() * 512 + ltid(), NT = G * 512;
    for (int e = gt; e < 8 * 8 * 2 * 4096; e += NT) { const int pn = e & 4095, dir = (e >> 12) & 1, hd = (e >> 13) & 7, b = e >> 16;
        float H = 0.f;
#pragma unroll 8
        for (int cc = 0; cc < 64; ++cc) { const int c = dir ? 63 - cc : cc; const size_t idx = (((size_t)(b * 64 + c) * 8 + hd) * 2 + dir);
            const float tmp = ST[idx * 4096 + pn]; ST[idx * 4096 + pn] = H; H = H * CD[idx] + tmp; } }
}
__device__ __forceinline__ void ssd_passC(const Args& a, int l, LAS unsigned char* lds, int G) {
    const bf16_t* PROJ = (const bf16_t*)(lptr(a.ws) + WS_PROJ); const bf16_t* CONV = (const bf16_t*)(lptr(a.ws) + WS_CONV); bf16_t* MIXED = (bf16_t*)(lptr(a.ws) + WS_MIXED);
    const float* ST = (const float*)(lptr(a.ws) + WS_ST);
    const int tid = ltid(), sub = tid & 255, half = tid >> 8, p = sub >> 2, nq = sub & 3;
    LAS float* dts = (LAS float*)lds + half * 512; LAS float* dAs = dts + 256;
    LAS float* yl = (LAS float*)(lds + 8192) + half * 8192;
    for (int it = lbid(); it < 2048; it += G) {
        const int hp = it & 3, c = (it >> 2) & 63, b = it >> 8, hd = hp * 2 + half, g = hd >> 2;
        { const int dir = sub >> 7, s = sub & 127; const size_t row = (size_t)b * T_ + c * 128 + s;
          const float raw = bf2f(PROJ[row * NP + PDT + dir * 8 + hd]); const float dt = softplus_f(raw + gp(a.in[I_DTB])[(l * 2 + dir) * 8 + hd]);
          const float av = -expf(gp(a.in[I_ALOG])[(l * 2 + dir) * 8 + hd]); dts[dir * 128 + s] = dt; dAs[dir * 128 + s] = expf(dt * av); }
        __syncthreads();
#pragma unroll 1
        for (int dir = 0; dir < 2; ++dir) {
            float h[16];
            const float* sp = ST + ((((size_t)(b * 64 + c) * 8 + hd) * 2 + dir) * 64 + p) * 64 + nq * 16;
#pragma unroll
            for (int j = 0; j < 4; ++j) { const f32x4 v = ((const f32x4*)sp)[j]; h[4 * j] = v.x; h[4 * j + 1] = v.y; h[4 * j + 2] = v.z; h[4 * j + 3] = v.w; }
#pragma unroll 2
            for (int ss = 0; ss < 128; ++ss) { const int s = dir ? 127 - ss : ss; const size_t row = (size_t)b * T_ + c * 128 + s;
                const float dA = dAs[dir * 128 + s], dtv = dts[dir * 128 + s];
                const float xv = bf2f(CONV[row * 768 + hd * 64 + p]) * dtv;
                const u32x4* bp = (const u32x4*)(CONV + row * 768 + 512 + g * 64 + nq * 16); const u32x4 b0 = bp[0], b1 = bp[1];
                const u32x4* cp = (const u32x4*)(CONV + row * 768 + 640 + g * 64 + nq * 16); const u32x4 c0 = cp[0], c1 = cp[1];
                const unsigned bw[8] = {b0.x, b0.y, b0.z, b0.w, b1.x, b1.y, b1.z, b1.w}; const unsigned cw[8] = {c0.x, c0.y, c0.z, c0.w, c1.x, c1.y, c1.z, c1.w};
                float y = 0.f;
#pragma unroll
                for (int j = 0; j < 8; ++j) { h[2 * j] = h[2 * j] * dA + xv * bflo(bw[j]); h[2 * j + 1] = h[2 * j + 1] * dA + xv * bfhi(bw[j]);
                    y += h[2 * j] * bflo(cw[j]) + h[2 * j + 1] * bfhi(cw[j]); }
                y += __shfl_xor(y, 1); y += __shfl_xor(y, 2);
                if (nq == 0) { if (dir == 0) yl[s * 64 + p] = y; else yl[s * 64 + p] += y; } }
        }
        __syncthreads();
        const float dsk = gp(a.in[I_SSDD])[l * 8 + hd];
        for (int e = sub; e < 128 * 64; e += 256) { const int s = e >> 6, pp = e & 63; const size_t row = (size_t)b * T_ + c * 128 + s;
            const float xs = bf2f(CONV[row * 768 + hd * 64 + pp]), z = bf2f(PROJ[row * NP + PZ + hd * 64 + pp]);
            const float yv = (yl[e] + dsk * xs) * silu_f(z);
            MIXED[row * D_ + 256 + hd * 64 + pp] = (bf16_t)f2bf(yv); }
        __syncthreads();
    }
}
__device__ __forceinline__ void ssd_norm(const Args& a, int l, int G) {
    bf16_t* MIXED = (bf16_t*)(lptr(a.ws) + WS_MIXED); const float* nw = gp(a.in[I_SSDNW]) + l * 512;
    const int tid = ltid(), lane = tid & 63, gw = lbid() * 8 + (tid >> 6), NGW = G * 8;
    for (int m = gw; m < M_; m += NGW) { u32x4* p = (u32x4*)(MIXED + (size_t)m * D_ + 256) + lane; const u32x4 v = *p;
        float x[8] = {bflo(v.x), bfhi(v.x), bflo(v.y), bfhi(v.y), bflo(v.z), bfhi(v.z), bflo(v.w), bfhi(v.w)}; float s = 0.f;
#pragma unroll
        for (int e = 0; e < 8; ++e) s += x[e] * x[e];
        const float r = rsqrtf(wave_sum(s) * (1.f / 512.f) + LN_EPS); const f32x4 w0 = ((const f32x4*)nw)[2 * lane], w1 = ((const f32x4*)nw)[2 * lane + 1];
        u32x4 o; o.x = pk2(x[0] * r * w0.x, x[1] * r * w0.y); o.y = pk2(x[2] * r * w0.z, x[3] * r * w0.w); o.z = pk2(x[4] * r * w1.x, x[5] * r * w1.y); o.w = pk2(x[6] * r * w1.z, x[7] * r * w1.w);
        *p = o; }
}
__device__ __forceinline__ void s5_scan(const Args& a, int l, int G) {
    const int tid = ltid(); if (tid >= 64) return;
    const int p = tid; const bf16_t* S5S = (const bf16_t*)(lptr(a.ws) + WS_S5S); bf16_t* UX = (bf16_t*)(lptr(a.ws) + WS_UX);
    for (int it = lbid(); it < 256; it += G) { const int g = it & 15, b = (it >> 4) & 7, dir = it >> 7;
        const f32x2 A16 = ((const f32x2*)(lptr(a.ws) + WS_MISC))[((l * 2 + dir) * 16 + g) * 64 + p];
        float xr = 0.f, xi = 0.f;
#pragma unroll 1
        for (int cb = 0; cb < 512; cb += 16) { f32x2 s[16];
#pragma unroll
            for (int k = 0; k < 16; ++k) { const int cc = cb + k, c = dir ? 511 - cc : cc; const size_t row = (size_t)g * 4096 + b * 512 + c; const unsigned sv = *(const unsigned*)(S5S + row * 256 + dir * 128 + 2 * p); s[k] = (f32x2){bflo(sv), bfhi(sv)}; }
#pragma unroll
            for (int k = 0; k < 16; ++k) { const int cc = cb + k, c = dir ? 511 - cc : cc; const size_t row = (size_t)g * 4096 + b * 512 + c;
                *(unsigned*)(UX + row * 512 + 256 + dir * 128 + 2 * p) = pk2(xr, xi);
                const float nr = A16.x * xr - A16.y * xi + s[k].x, ni = A16.x * xi + A16.y * xr + s[k].y; xr = nr; xi = ni; } } }
}

#define MFMA16(A, B, C) __builtin_amdgcn_mfma_f32_16x16x32_bf16(A, B, C, 0, 0, 0)
constexpr int SSD_WAVE_LDS = 19456, SSD_XS = 66, SSD_MS = 72;
__device__ __forceinline__ bf16x8 ld_frag_strided(const LAS bf16_t* T, int LS, int s0, int x) {
    bf16x8 f;
#pragma unroll
    for (int j = 0; j < 8; ++j) f[j] = (short)T[(s0 + j) * LS + x];
    return f;
}
__device__ __forceinline__ void ssd_tables(const Args& a, int l, const bf16_t* PROJ, size_t row0, int hd, int dir, int lane, float& dt, float& cum, float& tot) {
    const float raw = bf2f(PROJ[(row0 + lane) * NP + PDT + dir * 8 + hd]);
    dt = softplus_f(raw + gp(a.in[I_DTB])[(l * 2 + dir) * 8 + hd]);
    const float av = -expf(gp(a.in[I_ALOG])[(l * 2 + dir) * 8 + hd]);
    const float e = dt * av; float ps = e;
#pragma unroll
    for (int o = 1; o < 64; o <<= 1) { const float t = __shfl_up(ps, o); if (lane >= o) ps += t; }
    tot = __shfl(ps, 63);
    cum = dir ? (tot - ps + e) : ps;
}
__device__ __forceinline__ void ssd_passA2(const Args& a, int l, LAS unsigned char* lds, int G) {
    const bf16_t* PROJ = (const bf16_t*)(lptr(a.ws) + WS_PROJ); const bf16_t* CONV = (const bf16_t*)(lptr(a.ws) + WS_CONV);
    bf16_t* ST = (bf16_t*)(lptr(a.ws) + WS_ST); float* CD = (float*)(lptr(a.ws) + WS_MISC + 65536);
    const int tid = ltid(), lane = tid & 63, wave = tid >> 6, fr = lane & 15, fq = lane >> 4, hd = wave, g4 = hd >> 2;
    LAS bf16_t* Xl = (LAS bf16_t*)(lds + wave * SSD_WAVE_LDS); LAS bf16_t* Bl = Xl + 64 * SSD_XS; LAS float* tab = (LAS float*)(lds + wave * SSD_WAVE_LDS + 17664);
    for (int it = lbid(); it < 8 * 128 * 2; it += G) { const int dir = it & 1, c = (it >> 1) & 127, b = it >> 8;
        const size_t row0 = (size_t)b * T_ + c * 64;
        u32x4 xv[8], bv[8];
#pragma unroll
        for (int i = 0; i < 8; ++i) { const int q = lane + 64 * i, s = q >> 3, pc = (q & 7) * 8;
            xv[i] = *(const u32x4*)(CONV + (row0 + s) * 768 + hd * 64 + pc); bv[i] = *(const u32x4*)(CONV + (row0 + s) * 768 + 512 + g4 * 64 + pc); }
        float dt, cum, tot; ssd_tables(a, l, PROJ, row0, hd, dir, lane, dt, cum, tot);
        tab[lane] = dt * __expf(tot - cum);
        LDS_WAIT();
#pragma unroll
        for (int i = 0; i < 8; ++i) { const int q = lane + 64 * i, s = q >> 3, pc = (q & 7) * 8; const float w = tab[s];
            const u32x4 v = xv[i]; LAS unsigned* d = (LAS unsigned*)(Xl + s * SSD_XS + pc);
            d[0] = pk2(bflo(v.x) * w, bfhi(v.x) * w); d[1] = pk2(bflo(v.y) * w, bfhi(v.y) * w); d[2] = pk2(bflo(v.z) * w, bfhi(v.z) * w); d[3] = pk2(bflo(v.w) * w, bfhi(v.w) * w);
            const u32x4 vb = bv[i]; LAS unsigned* db = (LAS unsigned*)(Bl + s * SSD_XS + pc);
            db[0] = vb.x; db[1] = vb.y; db[2] = vb.z; db[3] = vb.w; }
        LDS_WAIT();
        f32x4 acc[4][4];
#pragma unroll
        for (int mi = 0; mi < 4; ++mi)
#pragma unroll
            for (int nj = 0; nj < 4; ++nj) acc[mi][nj] = (f32x4){0.f, 0.f, 0.f, 0.f};
#pragma unroll
        for (int ks = 0; ks < 2; ++ks) { bf16x8 af[4], bg[4];
#pragma unroll
            for (int mi = 0; mi < 4; ++mi) af[mi] = ld_frag_strided(Bl, SSD_XS, 32 * ks + 8 * fq, 16 * mi + fr);
#pragma unroll
            for (int nj = 0; nj < 4; ++nj) bg[nj] = ld_frag_strided(Xl, SSD_XS, 32 * ks + 8 * fq, 16 * nj + fr);
#pragma unroll
            for (int mi = 0; mi < 4; ++mi)
#pragma unroll
                for (int nj = 0; nj < 4; ++nj) acc[mi][nj] = MFMA16(af[mi], bg[nj], acc[mi][nj]); }
        const size_t idx = ((size_t)(b * 128 + c) * 8 + hd) * 2 + dir; bf16_t* sp = ST + idx * 4096;
#pragma unroll
        for (int mi = 0; mi < 4; ++mi)
#pragma unroll
            for (int nj = 0; nj < 4; ++nj) { u32x2 w; w.x = pk2(acc[mi][nj][0], acc[mi][nj][1]); w.y = pk2(acc[mi][nj][2], acc[mi][nj][3]); *(u32x2*)(sp + (16 * nj + fr) * 64 + 16 * mi + 4 * fq) = w; }
        if (lane == 0) CD[idx] = __expf(tot);
        LDS_WAIT();
    }
}
__device__ __forceinline__ void ssd_scan2(const Args& a, int G) {
    unsigned* ST32 = (unsigned*)(lptr(a.ws) + WS_ST); const float* CD = (const float*)(lptr(a.ws) + WS_MISC + 65536);
    const int gt = lbid() * 512 + ltid(), NT = G * 512;
    for (int e = gt; e < 8 * 8 * 2 * 2048; e += NT) { const int pn2 = e & 2047, dir = (e >> 11) & 1, hd = (e >> 12) & 7, b = e >> 15;
        float H0 = 0.f, H1 = 0.f;
#pragma unroll 1
        for (int cb = 0; cb < 128; cb += 16) { unsigned v[16]; float cd[16];
#pragma unroll
            for (int k = 0; k < 16; ++k) { const int cc = cb + k, c = dir ? 127 - cc : cc; const size_t idx = ((size_t)(b * 128 + c) * 8 + hd) * 2 + dir; v[k] = ST32[idx * 2048 + pn2]; cd[k] = CD[idx]; }
#pragma unroll
            for (int k = 0; k < 16; ++k) { const int cc = cb + k, c = dir ? 127 - cc : cc; const size_t idx = ((size_t)(b * 128 + c) * 8 + hd) * 2 + dir;
                ST32[idx * 2048 + pn2] = pk2(H0, H1); H0 = H0 * cd[k] + bflo(v[k]); H1 = H1 * cd[k] + bfhi(v[k]); } } }
}
__device__ __forceinline__ void ssd_passC2(const Args& a, int l, LAS unsigned char* lds, int G) {
    const bf16_t* PROJ = (const bf16_t*)(lptr(a.ws) + WS_PROJ); const bf16_t* CONV = (const bf16_t*)(lptr(a.ws) + WS_CONV); bf16_t* MIXED = (bf16_t*)(lptr(a.ws) + WS_MIXED);
    const bf16_t* ST = (const bf16_t*)(lptr(a.ws) + WS_ST);
    const int tid = ltid(), lane = tid & 63, wave = tid >> 6, hd = wave, g4 = hd >> 2;
    LAS bf16_t* Xl = (LAS bf16_t*)(lds + wave * SSD_WAVE_LDS); LAS bf16_t* Ml = (LAS bf16_t*)(lds + wave * SSD_WAVE_LDS + 8448); LAS float* tab = (LAS float*)(lds + wave * SSD_WAVE_LDS + 17664);
    LAS float* ssq = (LAS float*)(lds + 8 * SSD_WAVE_LDS);
    const float dsk = gp(a.in[I_SSDD])[l * 8 + hd];
    for (int it = lbid(); it < 8 * 128; it += G) { const int c = it & 127, b = it >> 7;
        const size_t row0 = (size_t)b * T_ + c * 64;
        f32x4 Y[4][4];
#pragma unroll
        for (int mi = 0; mi < 4; ++mi)
#pragma unroll
            for (int nj = 0; nj < 4; ++nj) Y[mi][nj] = (f32x4){0.f, 0.f, 0.f, 0.f};
        bf16x8 cfr[4][2];
        { int ln_ = lane; asm volatile("" : "+v"(ln_)); const int fr = ln_ & 15, fq = ln_ >> 4;
          u32x4 xv[8]; bf16x8 h0[4][2], h1[4][2];
#pragma unroll
          for (int i = 0; i < 8; ++i) { const int q = ln_ + 64 * i, s = q >> 3, pc = (q & 7) * 8; xv[i] = *(const u32x4*)(CONV + (row0 + s) * 768 + hd * 64 + pc); }
          const bf16_t* hp = ST + (((size_t)(b * 128 + c) * 8 + hd) * 2) * 4096;
#pragma unroll
          for (int t4 = 0; t4 < 4; ++t4) { const bf16_t* cp = CONV + (row0 + 16 * t4 + fr) * 768 + 640 + g4 * 64 + 8 * fq; cfr[t4][0] = *(const bf16x8*)cp; cfr[t4][1] = *(const bf16x8*)(cp + 32);
              const bf16_t* ap = hp + (16 * t4 + fr) * 64 + 8 * fq; h0[t4][0] = *(const bf16x8*)ap; h0[t4][1] = *(const bf16x8*)(ap + 32); h1[t4][0] = *(const bf16x8*)(ap + 4096); h1[t4][1] = *(const bf16x8*)(ap + 4096 + 32); }
          { float dt, cum, tot; ssd_tables(a, l, PROJ, row0, hd, 0, lane, dt, cum, tot); tab[lane] = dt; tab[64 + lane] = cum;
            ssd_tables(a, l, PROJ, row0, hd, 1, lane, dt, cum, tot); tab[128 + lane] = dt; tab[192 + lane] = cum; }
#pragma unroll
          for (int i = 0; i < 8; ++i) { const int q = ln_ + 64 * i, s = q >> 3, pc = (q & 7) * 8; LAS unsigned* d = (LAS unsigned*)(Xl + s * SSD_XS + pc);
              d[0] = xv[i].x; d[1] = xv[i].y; d[2] = xv[i].z; d[3] = xv[i].w; }
          LDS_WAIT();
#pragma unroll
          for (int nj = 0; nj < 4; ++nj) { const float sc0 = __expf(tab[64 + 16 * nj + fr]), sc1 = __expf(tab[192 + 16 * nj + fr]);
#pragma unroll
              for (int mi = 0; mi < 4; ++mi) { f32x4 t = MFMA16(h0[mi][0], cfr[nj][0], ((f32x4){0.f, 0.f, 0.f, 0.f})); t = MFMA16(h0[mi][1], cfr[nj][1], t);
                  f32x4 u = MFMA16(h1[mi][0], cfr[nj][0], ((f32x4){0.f, 0.f, 0.f, 0.f})); u = MFMA16(h1[mi][1], cfr[nj][1], u);
                  Y[mi][nj] += t * sc0 + u * sc1; } } }
        f32x4 Gt[4][4];
#pragma unroll
        for (int mi = 0; mi < 4; ++mi)
#pragma unroll
            for (int nj = 0; nj < 4; ++nj) Gt[mi][nj] = (f32x4){0.f, 0.f, 0.f, 0.f};
        { int ln_ = lane; asm volatile("" : "+v"(ln_)); const int fr = ln_ & 15, fq = ln_ >> 4;
          bf16x8 bfr[4][2];
#pragma unroll
          for (int mi = 0; mi < 4; ++mi) { const bf16_t* bp = CONV + (row0 + 16 * mi + fr) * 768 + 512 + g4 * 64 + 8 * fq; bfr[mi][0] = *(const bf16x8*)bp; bfr[mi][1] = *(const bf16x8*)(bp + 32); }
#pragma unroll
          for (int ks = 0; ks < 2; ++ks)
#pragma unroll
            for (int mi = 0; mi < 4; ++mi)
#pragma unroll
                for (int nj = 0; nj < 4; ++nj) Gt[mi][nj] = MFMA16(bfr[mi][ks], cfr[nj][ks], Gt[mi][nj]); }
        u32x2 ez[4][4];
#pragma unroll
        for (int dir = 0; dir < 2; ++dir) { int ln_ = lane; asm volatile("" : "+v"(ln_)); const int fr = ln_ & 15, fq = ln_ >> 4;
            if (dir == 1) {
#pragma unroll
                for (int nj = 0; nj < 4; ++nj) { const size_t row = row0 + 16 * nj + fr;
#pragma unroll
                    for (int mi = 0; mi < 4; ++mi) { const int p0 = 16 * mi + 4 * fq; ez[mi][nj] = *(const u32x2*)(PROJ + row * NP + PZ + hd * 64 + p0); } } }
#pragma unroll
            for (int nj = 0; nj < 4; ++nj) { const int lq = 16 * nj + fr; const float cl = tab[dir * 128 + 64 + lq];
#pragma unroll
                for (int mi = 0; mi < 4; ++mi) { const f32x4 cs = *(const LAS f32x4*)(tab + dir * 128 + 64 + 16 * mi + 4 * fq), ds = *(const LAS f32x4*)(tab + dir * 128 + 16 * mi + 4 * fq);
                    float v[4];
#pragma unroll
                    for (int r = 0; r < 4; ++r) { const int s = 16 * mi + 4 * fq + r; const bool valid = dir ? (s >= lq) : (s <= lq);
                        v[r] = valid ? Gt[mi][nj][r] * __expf(cl - cs[r]) * ds[r] : 0.f; }
                    u32x2 w; w.x = pk2(v[0], v[1]); w.y = pk2(v[2], v[3]); *(LAS u32x2*)(Ml + lq * SSD_MS + 16 * mi + 4 * fq) = w; } }
            asm volatile("s_waitcnt lgkmcnt(0)" ::: );
#pragma unroll
            for (int ks = 0; ks < 2; ++ks) { bf16x8 af[4], bg[4];
#pragma unroll
                for (int mi = 0; mi < 4; ++mi) af[mi] = ld_frag_strided(Xl, SSD_XS, 32 * ks + 8 * fq, 16 * mi + fr);
#pragma unroll
                for (int nj = 0; nj < 4; ++nj) bg[nj] = *(const LAS bf16x8*)(Ml + (16 * nj + fr) * SSD_MS + 32 * ks + 8 * fq);
#pragma unroll
                for (int mi = 0; mi < 4; ++mi)
#pragma unroll
                    for (int nj = 0; nj < 4; ++nj) Y[mi][nj] = MFMA16(af[mi], bg[nj], Y[mi][nj]); }
            asm volatile("s_waitcnt lgkmcnt(0)" ::: );
        }
        float part[4];
        { int ln_ = lane; asm volatile("" : "+v"(ln_)); const int fr = ln_ & 15, fq = ln_ >> 4;
#pragma unroll
        for (int nj = 0; nj < 4; ++nj) { float ps = 0.f;
#pragma unroll
            for (int mi = 0; mi < 4; ++mi) { const LAS unsigned* xp = (const LAS unsigned*)(Xl + (16 * nj + fr) * SSD_XS + 16 * mi + 4 * fq); u32x2 xs; xs.x = xp[0]; xs.y = xp[1]; const u32x2 zz = ez[mi][nj];
                f32x4 y = Y[mi][nj];
                y[0] = (y[0] + dsk * bflo(xs.x)) * silu_f(bflo(zz.x)); y[1] = (y[1] + dsk * bfhi(xs.x)) * silu_f(bfhi(zz.x));
                y[2] = (y[2] + dsk * bflo(xs.y)) * silu_f(bflo(zz.y)); y[3] = (y[3] + dsk * bfhi(xs.y)) * silu_f(bfhi(zz.y));
                Y[mi][nj] = y; ps += (y[0] * y[0] + y[1] * y[1]) + (y[2] * y[2] + y[3] * y[3]); }
            ps += __shfl_xor(ps, 16); ps += __shfl_xor(ps, 32); part[nj] = ps; }
        if (fq == 0) {
#pragma unroll
            for (int nj = 0; nj < 4; ++nj) ssq[wave * 64 + 16 * nj + fr] = part[nj]; } }
        __syncthreads();
        const float* nw = gp(a.in[I_SSDNW]) + l * 512 + hd * 64;
        { int ln_ = lane; asm volatile("" : "+v"(ln_)); const int fr = ln_ & 15, fq = ln_ >> 4;
#pragma unroll
        for (int nj = 0; nj < 4; ++nj) { const int lq = 16 * nj + fr; float tot = 0.f;
#pragma unroll
            for (int w = 0; w < 8; ++w) tot += ssq[w * 64 + lq];
            const float rs = rsqrtf(tot * (1.f / 512.f) + LN_EPS); const size_t row = row0 + lq;
#pragma unroll
            for (int mi = 0; mi < 4; ++mi) { const int p0 = 16 * mi + 4 * fq; const f32x4 wv = *(const f32x4*)(nw + p0); const f32x4 y = Y[mi][nj];
                u32x2 w; w.x = pk2(y[0] * rs * wv[0], y[1] * rs * wv[1]); w.y = pk2(y[2] * rs * wv[2], y[3] * rs * wv[3]);
                *(u32x2*)(MIXED + row * D_ + 256 + hd * 64 + p0) = w; } } }
        __syncthreads();
    }
}

__device__ __forceinline__ void na_phase2(const bf16_t* PROJ, bf16_t* MIXED, const float* rpb, LAS unsigned char* lds, int G) {
    const int tid = ltid(), lane = tid & 63, wave = __builtin_amdgcn_readfirstlane(tid >> 6), j = wave & 3;
    LAS bf16_t* Vl = (LAS bf16_t*)(lds + wave * SSD_WAVE_LDS);
    LAS float* rpl = (LAS float*)(lds + wave * SSD_WAVE_LDS + 8448);
    const int t_lo = j < 2 ? 0 : j - 1, t_hi = j == 0 ? 1 : (j == 3 ? 3 : j + 1);
    const bool pr0 = t_lo <= 1, pr1 = t_hi >= 2;
    const int fr = lane & 15, fq = lane >> 4;
    int bix[4][4];
    { const int c = 16 * j + fr, c0 = min(max(c - 8, 0), 48);
#pragma unroll
      for (int kt = 0; kt < 4; ++kt)
#pragma unroll
          for (int e = 0; e < 4; ++e) { const int kc = 16 * kt + 4 * fq + e; bix[kt][e] = (kc >= c0 && kc < c0 + 16) ? min(max(kc - c, -15), 15) + 15 : -1; } }
    unsigned koff[4], voff[8];
#pragma unroll
    for (int kt = 0; kt < 4; ++kt) koff[kt] = (unsigned)((16 * kt + fr) * NP + PK + 8 * fq) * 2u;
#pragma unroll
    for (int i = 0; i < 8; ++i) { const int q = lane + 64 * i; voff[i] = (unsigned)((q >> 3) * NP + PV + (q & 7) * 8) * 2u; }
    constexpr float L2E = 1.44269504089f;
    const int per_ = (8 * 128 * 2 + G - 1) / G, it0_ = lbid() * per_, it1_ = min(it0_ + per_, 8 * 128 * 2);
    for (int it = it0_; it < it1_; ++it) {
        const int r = it & 127, hp = (it >> 7) & 1, b = it >> 8, h = hp * 2 + (wave >> 2);
        const int r0 = min(max(r - 4, 0), 120);
        const size_t rowq0 = (size_t)b * T_ + r * 64;
        { const float* rph = rpb + h * 15 * 31;
#pragma unroll
          for (int i = 0; i < 8; ++i) { const int e = lane + 64 * i; if (e < 465) rpl[e] = rph[e] * L2E; } }
        bf16x8 qf[2];
        { const bf16_t* qp = PROJ + (rowq0 + 16 * j + fr) * NP + PQ + h * 64 + 8 * fq; qf[0] = *(const bf16x8*)qp; qf[1] = *(const bf16x8*)(qp + 32); }
        f32x4 O[4];
#pragma unroll
        for (int mi = 0; mi < 4; ++mi) O[mi] = (f32x4){0.f, 0.f, 0.f, 0.f};
        float mx = -1e30f, lsum = 0.f;
        bf16x8 kn[4][2]; u32x4 vn[8];
        const char* kbase = (const char*)(PROJ + ((size_t)b * T_ + r0 * 64) * NP + h * 64);
#pragma unroll
        for (int kt = 0; kt < 4; ++kt) if (kt >= t_lo && kt <= t_hi) { kn[kt][0] = *(const bf16x8*)(kbase + koff[kt]); kn[kt][1] = *(const bf16x8*)(kbase + koff[kt] + 64); }
#pragma unroll
        for (int i = 0; i < 8; ++i) if (i < 4 ? pr0 : pr1) vn[i] = *(const u32x4*)(kbase + voff[i]);
#pragma unroll 1
        for (int kr = 0; kr < 8; ++kr) {
            const int krow = r0 + kr;
            int ln_ = lane; asm volatile("" : "+v"(ln_)); const int fr = ln_ & 15, fq = ln_ >> 4;
#pragma unroll
            for (int i = 0; i < 8; ++i) if (i < 4 ? pr0 : pr1) { const int q = ln_ + 64 * i, key = q >> 3, dc = (q & 7) * 8; LAS unsigned* d = (LAS unsigned*)(Vl + key * SSD_XS + dc);
                d[0] = vn[i].x; d[1] = vn[i].y; d[2] = vn[i].z; d[3] = vn[i].w; }
            f32x4 S[4];
            const LAS float* rpr = rpl + (krow - r + 7) * 31;
#pragma unroll
            for (int kt = 0; kt < 4; ++kt) if (kt >= t_lo && kt <= t_hi) { f32x4 t = MFMA16(kn[kt][0], qf[0], ((f32x4){0.f, 0.f, 0.f, 0.f})); S[kt] = MFMA16(kn[kt][1], qf[1], t); }
            kbase += (size_t)64 * NP * 2;
            if (kr < 7) {
#pragma unroll
                for (int kt = 0; kt < 4; ++kt) if (kt >= t_lo && kt <= t_hi) { kn[kt][0] = *(const bf16x8*)(kbase + koff[kt]); kn[kt][1] = *(const bf16x8*)(kbase + koff[kt] + 64); }
#pragma unroll
                for (int i = 0; i < 8; ++i) if (i < 4 ? pr0 : pr1) vn[i] = *(const u32x4*)(kbase + voff[i]); }
            float gm = -1e30f;
#pragma unroll
            for (int kt = 0; kt < 4; ++kt) {
                if (kt >= t_lo && kt <= t_hi) { f32x4 t = S[kt];
#pragma unroll
                    for (int e = 0; e < 4; ++e) { const int bi = bix[kt][e]; const float s = bi >= 0 ? t[e] * (0.125f * L2E) + rpr[bi] : -1e30f; t[e] = s; gm = fmaxf(gm, s); }
                    S[kt] = t; }
                else S[kt] = (f32x4){-1e30f, -1e30f, -1e30f, -1e30f}; }
            gm = fmaxf(gm, __shfl_xor(gm, 16)); gm = fmaxf(gm, __shfl_xor(gm, 32));
            const float mnew = fmaxf(mx, gm), al = __builtin_amdgcn_exp2f(mx - mnew); mx = mnew; lsum *= al;
#pragma unroll
            for (int mi = 0; mi < 4; ++mi) O[mi] = O[mi] * al;
#pragma unroll
            for (int kt = 0; kt < 4; ++kt) {
                if (kt >= t_lo && kt <= t_hi) {
#pragma unroll
                    for (int e = 0; e < 4; ++e) { const float p = __builtin_amdgcn_exp2f(S[kt][e] - mnew); S[kt][e] = p; lsum += p; } }
                else S[kt] = (f32x4){0.f, 0.f, 0.f, 0.f}; }
#pragma unroll
            for (int pr = 0; pr < 2; ++pr) if (pr == 0 ? pr0 : pr1) {
                const unsigned w0 = pk2hw(S[2 * pr][0], S[2 * pr][1]), w1 = pk2hw(S[2 * pr][2], S[2 * pr][3]), w2 = pk2hw(S[2 * pr + 1][0], S[2 * pr + 1][1]), w3 = pk2hw(S[2 * pr + 1][2], S[2 * pr + 1][3]);
                const u32x4 w = {w0, w1, w2, w3}; const bf16x8 pf = __builtin_bit_cast(bf16x8, w);
#pragma unroll
                for (int mi = 0; mi < 4; ++mi) { bf16x8 af;
#pragma unroll
                    for (int jj = 0; jj < 4; ++jj) { af[jj] = (short)Vl[(32 * pr + 4 * fq + jj) * SSD_XS + 16 * mi + fr]; af[4 + jj] = (short)Vl[(32 * pr + 16 + 4 * fq + jj) * SSD_XS + 16 * mi + fr]; }
                    O[mi] = MFMA16(af, pf, O[mi]); } }
        }
        { lsum += __shfl_xor(lsum, 16); lsum += __shfl_xor(lsum, 32); const float inv = 1.f / lsum;
          bf16_t* op = MIXED + (rowq0 + 16 * j + fr) * D_ + h * 64 + 4 * fq;
#pragma unroll
          for (int mi = 0; mi < 4; ++mi) { u32x2 w; w.x = pk2hw(O[mi][0] * inv, O[mi][1] * inv); w.y = pk2hw(O[mi][2] * inv, O[mi][3] * inv); *(u32x2*)(op + 16 * mi) = w; } }
    }
}
__device__ __forceinline__ void ln_phase(const Args& a, const float* gam, const float* bet, int G) {
    const int tid = ltid(), lane = tid & 63, gw = lbid() * 8 + (tid >> 6), NGW = G * 8;
    float* H = lptr(a.out); bf16_t* HB = (bf16_t*)(lptr(a.ws) + WS_HB);
    for (int m = gw; m < M_ / 2; m += NGW) { const size_t r0 = (size_t)m * D_, r1 = (size_t)(m + M_ / 2) * D_;
        ln_row2(H + r0, H + r1, H + r0, H + r1, (bf16_t*)nullptr, (bf16_t*)nullptr, gam, bet, lane); }
}
__device__ __forceinline__ void xsoftmax_phase(const Args& a, int G) {
    const float* S = (const float*)(lptr(a.ws) + WS_S); bf16_t* P = (bf16_t*)(lptr(a.ws) + WS_QB);
    const int tid = ltid(), lane = tid & 63, gw = lbid() * 8 + (tid >> 6), NGW = G * 8;
    for (int m = gw; m < M_; m += NGW) {
#pragma unroll
        for (int j = 0; j < 4; ++j) { const f32x4 v = ((const f32x4*)(S + (size_t)m * D_ + j * 256))[lane];
            const float mx = wave_max(fmaxf(fmaxf(v.x, v.y), fmaxf(v.z, v.w)));
            const float e0 = __expf(v.x - mx), e1 = __expf(v.y - mx), e2 = __expf(v.z - mx), e3 = __expf(v.w - mx);
            const float inv = 1.f / wave_sum((e0 + e1) + (e2 + e3));
            u32x2 w; w.x = pk2(e0 * inv, e1 * inv); w.y = pk2(e2 * inv, e3 * inv); ((u32x2*)(P + (size_t)m * D_ + j * 256))[lane] = w; } }
}

#define XB_TMO      128
#define XB_XCNT(j)  (256  + 64 * (j))
#define XB_XSUB(j)  (1280 + 64 * (j))
#define XB_XGEN(j)  (2304 + 64 * (j))
#define XB_TOP      3328
#define XB_TOPGEN   3392
#define XCD_BAR_WORDS 3456
#define XB_SPIN_CAP (1u << 18)

__device__ __forceinline__ unsigned xb_ld(unsigned* p)              { return __hip_atomic_load(p, __ATOMIC_RELAXED, __HIP_MEMORY_SCOPE_AGENT); }
__device__ __forceinline__ unsigned xb_add(unsigned* p, unsigned v) { return __hip_atomic_fetch_add(p, v, __ATOMIC_RELAXED, __HIP_MEMORY_SCOPE_AGENT); }
__device__ __forceinline__ unsigned xb_xcc_id() { return (unsigned)__builtin_amdgcn_s_getreg((3 << 11) | 20) & 0xFu; }
#define XB_SPIN(cond, bar) do { unsigned _sp = 0; while (cond) { __builtin_amdgcn_s_sleep(1); \
    if ((++_sp & 255u) == 0u) { if (xb_ld(&(bar)[XB_TMO])) break; if (_sp > XB_SPIN_CAP) { atomicAdd(&(bar)[XB_TMO], 1u); break; } } } } while (0)

struct XcdBarrier {
    unsigned* bar; unsigned x;
    volatile LAS unsigned* st;
};

__device__ __forceinline__ XcdBarrier xcd_barrier_post(unsigned* bar, volatile LAS unsigned* st) {
    XcdBarrier b; b.bar = bar; b.x = xb_xcc_id(); b.st = st;
    if (threadIdx.x == 0) (void)xb_add(&bar[XB_XCNT(b.x)], 1u);
    return b;
}
__device__ __forceinline__ void xcd_barrier_complete(unsigned* bar, unsigned x, unsigned& nloc, unsigned& nx) {
    const unsigned G = gridDim.x * gridDim.y * gridDim.z;
    unsigned sum, cnt, mine, sp = 0u;
    for (;;) {
        sum = 0u; cnt = 0u; mine = 0u;
#pragma unroll
        for (unsigned j = 0; j < 16; ++j) { const unsigned c = xb_ld(&bar[XB_XCNT(j)]); sum += c; cnt += (c > 0u) ? 1u : 0u; mine = (j == x) ? c : mine; }
        if (sum == G) break;
        __builtin_amdgcn_s_sleep(1);
        if ((++sp & 255u) == 0u) { if (xb_ld(&bar[XB_TMO])) break; if (sp > XB_SPIN_CAP) { atomicAdd(&bar[XB_TMO], 1u); break; } }
    }
    nloc = mine > 0u ? mine : 1u; nx = cnt > 0u ? cnt : 1u;
}

__device__ __forceinline__ void xcd_barrier(const XcdBarrier& b) {
    asm volatile("s_waitcnt vmcnt(0)" ::: "memory");
    __syncthreads();
    if (threadIdx.x == 0) {
        unsigned* bar = b.bar;
        __builtin_amdgcn_s_waitcnt(0);
        unsigned nloc = b.st[0], nx = b.st[1];
        if (nloc == 0u) { xcd_barrier_complete(bar, b.x, nloc, nx); b.st[0] = nloc; b.st[1] = nx; }
        const unsigned old = xb_add(&bar[XB_XSUB(b.x)], 1u);
        const unsigned gen = old / nloc;
        if (old + 1u == (gen + 1u) * nloc) {
            __builtin_amdgcn_fence(__ATOMIC_RELEASE, "agent");
            asm volatile("s_waitcnt vmcnt(0)" ::: "memory");
            const unsigned og = xb_add(&bar[XB_TOP], 1u);
            const unsigned tg = og / nx;
            if (og + 1u == (tg + 1u) * nx) xb_add(&bar[XB_TOPGEN], 1u);
            else XB_SPIN(xb_ld(&bar[XB_TOPGEN]) == tg, bar);
            __builtin_amdgcn_fence(__ATOMIC_ACQUIRE, "agent");
            xb_add(&bar[XB_XGEN(b.x)], 1u);
            asm volatile("s_waitcnt vmcnt(0)" ::: "memory");
        } else {
            XB_SPIN(xb_ld(&bar[XB_XGEN(b.x)]) == gen, bar);
            __builtin_amdgcn_fence(__ATOMIC_ACQUIRE, "agent");
            asm volatile("s_waitcnt vmcnt(0)" ::: "memory");
        }
    }
    __syncthreads();
}

__device__ __forceinline__ const LAS float* stage_gb(LAS unsigned char* lds, const float* gam, const float* bet) {
    LAS float* gl = (LAS float*)(lds + 139264); const int t = ltid();
    *(LAS f32x4*)(gl + 4 * t) = (t < 256) ? ((const f32x4*)gam)[t] : ((const f32x4*)bet)[t - 256];
    __syncthreads(); return gl;
}
#ifndef ONLY_S
#define ONLY_S -1
#endif
#define PHX(x) (ONLY_S == -1 || ONLY_S == (x))
__global__ void __launch_bounds__(512, 2) fwd(Args a) {
    extern __shared__ __attribute__((aligned(16))) unsigned char lds_raw[];
    LAS unsigned char* lds = (LAS unsigned char*)lds_raw;
    volatile LAS unsigned* bst = (volatile LAS unsigned*)(lds + 157696);
    if (threadIdx.x < 16) bst[threadIdx.x] = 0u;
    __syncthreads();
    XcdBarrier xbar; xbar.bar = (unsigned*)(a.ws + 4096); xbar.x = 0; xbar.st = bst;
    if (a.coop) xbar = xcd_barrier_post((unsigned*)(a.ws + 4096), bst);
    for (int ph = a.ph_lo; ph < a.ph_hi; ++ph) {
    int G = gridDim.x; asm volatile("" : "+s"(G)); const int bx = lbid();
    bf16_t* HB = (bf16_t*)(lptr(a.ws) + WS_HB); bf16_t* PROJ = (bf16_t*)(lptr(a.ws) + WS_PROJ); bf16_t* MIXED = (bf16_t*)(lptr(a.ws) + WS_MIXED); bf16_t* CONV = (bf16_t*)(lptr(a.ws) + WS_CONV);
    bf16_t* UX = (bf16_t*)(lptr(a.ws) + WS_UX); bf16_t* MEMB = (bf16_t*)(lptr(a.ws) + WS_MEMB); bf16_t* KM = (bf16_t*)(lptr(a.ws) + WS_KM); bf16_t* VMT = (bf16_t*)(lptr(a.ws) + WS_VMT);
    bf16_t* QB = (bf16_t*)(lptr(a.ws) + WS_QB); bf16_t* OB = (bf16_t*)(lptr(a.ws) + WS_OB); bf16_t* HID = (bf16_t*)(lptr(a.ws) + WS_HID);
    float* SL0 = (float*)(lptr(a.ws) + WS_SL); float* SL1 = SL0 + (size_t)M_ * 8;
        if (ph == 0) { if (PHX(100)) prologue(a, lds, G); }
        else {
            const int l = (ph - 1) / 17, s = (ph - 1) % 17;
            unsigned char* wb = lptr(a.ws) + WS_W + (size_t)l * LWB;
            pg8::Sched S;
            if (s == 0 && PHX(0)) {
                if (l == 0) {
                    { pg8::Gemm g{MEMB, (const bf16_t*)(lptr(a.ws) + WS_W + OW_K), D_, D_, D_, 0, 0, LWB / 2, 0}; S.init(8, 4, 2, 1, G, bx);
                      pg8::EpiStore<0> E{KM, D_, (size_t)B_ * MEMT * D_, 0, 1 << 30, 1.f}; pg8::gemm_phase(lds, g, S, E); }
                    { pg8::Gemm g{(const bf16_t*)(lptr(a.ws) + WS_W + OW_V), MEMB, D_, D_, D_, LWB / 2, 0, 0, (size_t)MEMT * D_}; S.init(4, 1, 2, 8, G, bx);
                      pg8::EpiStore<0> E{VMT, MEMT, (size_t)B_ * D_ * MEMT, (size_t)D_ * MEMT, 1 << 30, 1.f}; pg8::gemm_phase(lds, g, S, E); }
                }
                pg8::Gemm g{HB, (const bf16_t*)(wb + OW_IN), D_, D_, D_, 0, 0, 0, 0}; S.init(M_ / 256, NPP / 256, 1, 1, G, bx);
                if (l == 0) { pg8::EpiStore<0> E{PROJ, NP, 0, 0, NP, 1.f}; pg8::gemm_phase(lds, g, S, E); }
                else { float* cs = cs_ptr(lptr(a.ws), 1, 2); pg8::EpiStoreLN<0> E{PROJ, NP, NP, 1.f, SL0  , cs, cs + NPP}; pg8::gemm_phase(lds, g, S, E); }
            } else if (s == 1 && PHX(1)) {
                if (l == 0) colsum_phase(a, G);
                na_phase2(PROJ, MIXED, gp(a.in[I_RPB]) + l * 4 * 15 * 31, lds, G);
#ifndef NO_CONV
                conv_phase(PROJ, CONV, gp(a.in[I_CONVW]) + l * 5 * 768, gp(a.in[I_CONVB]) + l * 768, G);
#endif
                s5_gather_phase(PROJ, UX, G);
            } else if (s == 2 && PHX(2)) {
                ssd_passA2(a, l, lds, G);
                __syncthreads();
                pg8::Gemm g{UX, (const bf16_t*)(lptr(a.ws) + WS_SM) + (size_t)l * 16 * 256 * 256, 512, 256, 256, (size_t)4096 * 512, 0, (size_t)256 * 256, 0}; S.init(16, 1, 16, 1, G, bx);
                pg8::EpiStore<0> E{(bf16_t*)(lptr(a.ws) + WS_S5S), 256, (size_t)4096 * 256, 0, 1 << 30, 1.f}; pg8::gemm_phase(lds, g, S, E);
            } else if (s == 3 && PHX(3)) {
                ssd_scan2(a, G);
                s5_scan(a, l, G);
            } else if (s == 4 && PHX(4)) {
#ifndef NO_PC
                ssd_passC2(a, l, lds, G);
#endif
                pg8::Gemm g{UX, (const bf16_t*)(lptr(a.ws) + WS_TM) + (size_t)l * 16 * 256 * 512, 512, 512, 512, (size_t)4096 * 512, 0, (size_t)256 * 512, 0}; S.init(16, 1, 16, 1, G, bx);
#ifndef NO_G4
                pg8::EpiS5Y E{MIXED}; pg8::gemm_phase(lds, g, S, E);
#endif
            } else if (s == 5 && PHX(5)) {
                pg8::Gemm g{MIXED + 768, (const bf16_t*)(wb + OW_GLU), D_, 256, 256, 0, 0, 0, 0}; S.init(M_ / 256, 1, 1, 1, G, bx);
                pg8::EpiGLU E{MIXED, gp(a.in[I_GLUB]) + l * 256}; pg8::gemm_phase(lds, g, S, E);
            } else if (s == 6 && PHX(6)) {
                pg8::Gemm g{MIXED, (const bf16_t*)(wb + OW_OUT), D_, D_, D_, 0, 0, 0, 0}; S.init(M_ / 256, 4, 1, 1, G, bx);
                if (l == 0) { pg8::EpiResidLN<true, false> E{lptr(a.out), HB, SL1, SL0, nullptr, nullptr, (LAS float*)(lds + 131072), ALPHA}; pg8::gemm_phase(lds, g, S, E); }
                else { const LAS float* gl = stage_gb(lds, gp(a.in[I_LNMLP_G]), gp(a.in[I_LNMLP_B])); pg8::EpiResidLN<false, false> E{lptr(a.out), HB, SL0, SL1, gl, nullptr, (LAS float*)(lds + 131072), ALPHA}; pg8::gemm_phase(lds, g, S, E); }
            } else if (s == 7 && PHX(7)) {
            } else if (s == 8 && PHX(8)) {
                pg8::Gemm g{HB, (const bf16_t*)(wb + OW_Q), D_, D_, D_, 0, 0, 0, 0}; S.init(M_ / 256, 4, 1, 1, G, bx);
                float* cs = cs_ptr(lptr(a.ws), l, 0); pg8::EpiStoreLN<0> E{QB, D_, 1 << 30, 0.0625f, l == 0 ? SL0 : SL1, cs, cs + D_}; pg8::gemm_phase(lds, g, S, E);
            } else if (s == 9 && PHX(9)) {
                pg8::Gemm g{QB, KM + (size_t)l * B_ * MEMT * D_, D_, D_, 256, (size_t)T_ * D_, 256, (size_t)MEMT * D_, 256}; S.init(T_ / 256, 1, 8, 4, G, bx);
                pg8::EpiSoftmax E{(bf16_t*)(lptr(a.ws) + WS_S), D_, (size_t)T_ * D_, 256, (LAS float*)(lds + 131072)}; pg8::gemm_phase(lds, g, S, E);
                __builtin_amdgcn_fence(__ATOMIC_ACQUIRE, "agent"); asm volatile("s_waitcnt vmcnt(0)" ::: "memory"); __syncthreads();
                {
                pg8::Gemm g{(const bf16_t*)(lptr(a.ws) + WS_S), VMT + (size_t)l * B_ * D_ * MEMT, D_, MEMT, 256, (size_t)T_ * D_, 256, (size_t)D_ * MEMT, (size_t)256 * MEMT}; S.init(T_ / 256, 1, 8, 4, G, bx);
                pg8::EpiStore<0> E{OB, D_, (size_t)T_ * D_, 256, 1 << 30, 1.f}; pg8::gemm_phase(lds, g, S, E); }
            } else if (s == 10 && PHX(10)) {
            } else if (s == 11 && PHX(11)) {
            } else if (s == 12 && PHX(12)) {
                pg8::Gemm g{OB, (const bf16_t*)(wb + OW_O), D_, D_, D_, 0, 0, 0, 0}; S.init(M_ / 256, 4, 1, 1, G, bx);
                const LAS float* gl = stage_gb(lds, gp(a.in[I_LNMIX_G]) + l * D_, gp(a.in[I_LNMIX_B]) + l * D_); pg8::EpiResidLN<false, false> E{lptr(a.out), HB, l == 0 ? SL0 : SL1, l == 0 ? SL1 : SL0, gl, nullptr, (LAS float*)(lds + 131072), ALPHA}; pg8::gemm_phase(lds, g, S, E);
            } else if (s == 13 && PHX(13)) {
            } else if (s == 14 && PHX(14)) {
                pg8::Gemm g{HB, (const bf16_t*)(wb + OW_1), D_, D_, D_, 0, 0, 0, 0}; S.init(M_ / 256, FF_ / 256, 1, 1, G, bx);
                float* cs = cs_ptr(lptr(a.ws), l, 1); pg8::EpiStoreLN<1> E{HID, FF_, 1 << 30, 1.f, l == 0 ? SL1 : SL0, cs, cs + FF_}; pg8::gemm_phase(lds, g, S, E);
            } else if (s == 15 && PHX(15)) {
                pg8::Gemm g{HID, (const bf16_t*)(wb + OW_2), FF_, FF_, FF_, 0, 0, 0, 0}; S.init(M_ / 256, 4, 1, 1, G, bx);
                const LAS float* gl = stage_gb(lds, gp(a.in[I_LNXA_G]) + l * D_, gp(a.in[I_LNXA_B]) + l * D_); if (l == 0) { pg8::EpiResidLN<false, false> E{lptr(a.out), HB, SL1, SL0, gl, nullptr, (LAS float*)(lds + 131072), ALPHA}; pg8::gemm_phase(lds, g, S, E); }
                else { pg8::EpiResidLN<false, true> E{lptr(a.out), HB, SL0, SL1, gl, nullptr, (LAS float*)(lds + 131072), ALPHA}; pg8::gemm_phase(lds, g, S, E); }
            } else if (PHX(16)) {
                if (l == 1) ln_phase(a, gp(a.in[I_LNMLP_G]) + l * D_, gp(a.in[I_LNMLP_B]) + l * D_, G);
            }
        }
        if (ph + 1 < a.ph_hi) { const int s_ = (ph - 1) % 17; const bool empty_ = ph > 0 && (s_ == 7 || s_ == 10 || s_ == 11 || s_ == 13 || (s_ == 16 && ph < 18)); if (a.coop && !empty_) { if (a.ph_hi < 0) cg::this_grid().sync();   xcd_barrier(xbar); } }
    }
}

constexpr int NPHASES = 1 + 2 * 17;
#ifndef MULTI_LAUNCH
#define MULTI_LAUNCH 0
#endif

extern "C" void kernel_launch(void* const* d_in, const int* in_sizes, int n_in, void* d_out, int out_size, void* d_ws, size_t ws_size, hipStream_t stream) {
    static int grid = 0;
    if (grid == 0) {
        if (n_in != 35 || out_size != M_ * D_ || ws_size < WS_END) { fprintf(stderr, "kernel_launch: unexpected sizes n_in %d out %d ws %zu\n", n_in, out_size, ws_size); grid = -1; return; }
        int dev = 0, cus = 0, per_cu = 0;
        hipGetDevice(&dev); hipDeviceGetAttribute(&cus, hipDeviceAttributeMultiprocessorCount, dev);
        if (hipFuncSetAttribute((const void*)fwd, hipFuncAttributeMaxDynamicSharedMemorySize, LDS_BYTES) != hipSuccess) { fprintf(stderr, "kernel_launch: hipFuncSetAttribute failed\n"); grid = -1; return; }
        if (hipOccupancyMaxActiveBlocksPerMultiprocessor(&per_cu, (const void*)fwd, 512, LDS_BYTES) != hipSuccess || per_cu < 1) { fprintf(stderr, "kernel_launch: occupancy query says %d\n", per_cu); per_cu = 1; }
        (void)hipGetLastError();
        grid = cus * per_cu;
    }
    if (grid < 0) return;
    (void)hipMemsetAsync(d_ws, 0, 65536, stream);
    Args a{};
    for (int i = 0; i < 35; ++i) a.in[i] = (const float*)d_in[i];
    a.out = (float*)d_out; a.ws = (unsigned char*)d_ws;
#if MULTI_LAUNCH
    for (int ph = 0; ph < NPHASES; ++ph) { a.ph_lo = ph; a.ph_hi = ph + 1; a.coop = 0; hipLaunchKernelGGL(fwd, dim3(grid), dim3(512), LDS_BYTES, stream, a); }
#else
    a.ph_lo = 0; a.ph_hi = NPHASES; a.coop = 1;
    void* args[] = {&a};
    hipError_t e = hipLaunchCooperativeKernel((const void*)fwd, dim3(grid), dim3(512), args, LDS_BYTES, stream);
    if (e != hipSuccess) fprintf(stderr, "cooperative launch failed: %s (grid %d)\n", hipGetErrorString(e), grid);
#endif
}
```

```cpp
#include <hip/hip_runtime.h>
#include <hip/hip_cooperative_groups.h>
#include <cstdio>
#include <cstdint>
namespace cg = cooperative_groups;

#define LAS __attribute__((address_space(3)))
typedef unsigned short bf16_t;
typedef short bf16x8 __attribute__((ext_vector_type(8)));
typedef float f32x4 __attribute__((ext_vector_type(4)));
typedef float f32x2 __attribute__((ext_vector_type(2)));
typedef unsigned u32x4 __attribute__((ext_vector_type(4)));
typedef unsigned u32x2 __attribute__((ext_vector_type(2)));

constexpr int B_ = 8, T_ = 8192, D_ = 1024, M_ = B_ * T_, NP = 2320, NPP = 2560, FF_ = 4096, MEMT = 256;
constexpr float LN_EPS = 1e-5f;
constexpr float ALPHA = 1.41421356237f;
constexpr int PQ = 0, PK = 256, PV = 512, PZ = 768, PX = 1280, PDT = 2048, PU = 2064;

constexpr size_t MiB = 1u << 20;
constexpr size_t WS_W = 1 * MiB, LWB = 32 * MiB;
constexpr size_t OW_IN = 0, OW_OUT = 5 * MiB, OW_Q = 7 * MiB, OW_K = 9 * MiB, OW_V = 11 * MiB, OW_O = 13 * MiB, OW_1 = 15 * MiB, OW_2 = 23 * MiB, OW_GLU = 31 * MiB;
constexpr size_t WS_MEMB = 65 * MiB, WS_KM = 69 * MiB, WS_VMT = 77 * MiB, WS_TM = 85 * MiB, WS_SM = 93 * MiB, WS_MISC = 97 * MiB;
constexpr size_t WS_HB = 100 * MiB, WS_PROJ = 228 * MiB, WS_MIXED = 518 * MiB, WS_CONV = 646 * MiB, WS_HID = 228 * MiB;
constexpr size_t WS_S = 228 * MiB, WS_QB = 484 * MiB, WS_OB = 612 * MiB, WS_ST = 744 * MiB, WS_UX = 872 * MiB, WS_S5S = 936 * MiB, WS_SL = 1000 * MiB, WS_END = 1004 * MiB;
constexpr size_t MISC_CS = 262144;
constexpr int LDS_BYTES = 157696 + 64;

__device__ __forceinline__ float bf2f(unsigned u) { return __uint_as_float(u << 16); }
__device__ __forceinline__ float bflo(unsigned u) { return __uint_as_float(u << 16); }
__device__ __forceinline__ float bfhi(unsigned u) { return __uint_as_float(u & 0xffff0000u); }
__device__ __forceinline__ unsigned f2bf(float f) { unsigned u = __float_as_uint(f); return (u + 0x7fffu + ((u >> 16) & 1u)) >> 16; }
__device__ __forceinline__ unsigned pk2(float lo, float hi) { return f2bf(lo) | (f2bf(hi) << 16); }
__device__ __forceinline__ unsigned pk2hw(float lo, float hi) { unsigned r; asm volatile("v_cvt_pk_bf16_f32 %0, %1, %2" : "=v"(r) : "v"(lo), "v"(hi)); return r; }
__device__ __forceinline__ float wave_sum(float v) {
#pragma unroll
    for (int o = 1; o < 64; o <<= 1) v += __shfl_xor(v, o);
    return v;
}
__device__ __forceinline__ float wave_max(float v) {
#pragma unroll
    for (int o = 1; o < 64; o <<= 1) v = fmaxf(v, __shfl_xor(v, o));
    return v;
}
__device__ __forceinline__ float silu_f(float x) { return x * __builtin_amdgcn_rcpf(1.f + __expf(-x)); }
__device__ __forceinline__ float gelu_tanh(float x) { const float y = 0.7978845608f * (x + 0.044715f * x * x * x); const float t = 1.f - 2.f * __builtin_amdgcn_rcpf(1.f + __expf(2.f * y)); return 0.5f * x * (1.f + t); }
__device__ __forceinline__ int ltid() { int t = threadIdx.x; asm volatile("" : "+v"(t)); return t; }
__device__ __forceinline__ int lbid() { int t = blockIdx.x; asm volatile("" : "+s"(t)); return t; }
#define GAS __attribute__((address_space(1)))
__device__ __forceinline__ size_t zopq() { size_t z = 0; asm volatile("" : "+s"(z)); return z; }
template <class P> __device__ __forceinline__ P* gp(P* p) { return (P*)((char*)p + zopq()); }
template <class P> __device__ __forceinline__ P* lptr(P* p) { return (P*)((char*)p + zopq()); }
#define LDS_WAIT() asm volatile("s_waitcnt lgkmcnt(0)" ::: "memory")

namespace pg8 {
constexpr int BM = 256, BK = 64, HALF = 128, HTB = HALF * BK * 2, STAGE_BYTES = 8 * HTB;
__host__ __device__ __forceinline__ int lds_byte(int r, int c) { const int st = (r >> 4) * 2 + (c >> 5), rr = r & 15, cc = c & 31, ob = rr * 64 + cc * 2; return st * 1024 + (ob ^ (((ob >> 9) & 1) << 5)); }
__host__ __device__ __forceinline__ void stage_rc(int b, int& R, int& C) { const int st = b / 1024, sb = b % 1024, swz = sb ^ (((sb >> 9) & 1) << 5); R = (st >> 1) * 16 + swz / 64; C = (st & 1) * 32 + (swz % 64) / 2; }
__host__ __device__ __forceinline__ int perm32(int rho) { const int n = rho >> 4, i = rho & 15; return 8 * (i >> 2) + 4 * n + (i & 3); }

struct Unit { int pm, pn, b1, b2; };
struct Gemm { const bf16_t* A; const bf16_t* Bt; int lda, ldb, K; size_t aS1, aS2, bS1, bS2; };

struct Sched {
    int nM, nN, nB2, total, G, c;
    __device__ __forceinline__ void init(int nM_, int nN_, int nB1_, int nB2_, int G_, int c_) { nM = nM_; nN = nN_; nB2 = nB2_; total = nM_ * nN_ * nB1_ * nB2_; G = G_; c = c_; }
    __device__ __forceinline__ bool next(int i, Unit& u) const {
        const long L = (long)i * G + c; if (L >= total) return false;
        int w = (int)L;
        { const int q = total / 8, r = total % 8, xcd = w % 8, off = w / 8; w = (xcd < r ? xcd * (q + 1) : r * (q + 1) + (xcd - r) * q) + off; }
        const int per = nM * nN; const int bt = w / per; w -= bt * per;
        const int nig = 8 * nN, gid = w / nig, fm = gid * 8, gsz = (nM - fm) < 8 ? (nM - fm) : 8;
        u.pm = fm + ((w % nig) % gsz); u.pn = (w % nig) / gsz; u.b1 = bt / nB2; u.b2 = bt % nB2; return true;
    }
};

typedef f32x4 Acc[2][2][4][2];

template <int ACT> struct EpiStore {
    static constexpr bool PERM = true;
    bf16_t* C; int ldc; size_t cS1, cS2; int ncols; float scale;
    __device__ __forceinline__ void operator()(const Acc& acc, const Unit& u, int wr, int wc, int fr, int fq) const {
        asm volatile("" : "+v"(fr), "+v"(fq));
        bf16_t* base = C + u.b1 * cS1 + u.b2 * cS2;
        const int row0 = u.pm * BM + wr * 64 + fr, col0 = u.pn * BM + wc * 32 + 8 * fq;
#pragma unroll
        for (int ai = 0; ai < 2; ++ai)
#pragma unroll
            for (int m = 0; m < 4; ++m) { bf16_t* rowp = base + (size_t)(row0 + ai * HALF + m * 16) * ldc + col0;
#pragma unroll
                for (int bj = 0; bj < 2; ++bj) { f32x4 v0 = acc[ai][bj][m][0], v1 = acc[ai][bj][m][1];
                    if (ACT == 1) {
#pragma unroll
                        for (int e = 0; e < 4; ++e) { float a0 = fmaxf(v0[e], 0.f), a1 = fmaxf(v1[e], 0.f); v0[e] = a0 * a0; v1[e] = a1 * a1; } }
                    v0 = v0 * scale; v1 = v1 * scale;
                    u32x4 w; w.x = pk2(v0[0], v0[1]); w.y = pk2(v0[2], v0[3]); w.z = pk2(v1[0], v1[1]); w.w = pk2(v1[2], v1[3]);
                    if (col0 + bj * HALF < ncols) *(u32x4*)(rowp + bj * HALF) = w; }
                asm volatile("" ::: "memory"); }
    }
};
struct EpiF32 {
    static constexpr bool PERM = false;
    float* C; int ldc; size_t cS1, cS2;
    __device__ __forceinline__ void operator()(const Acc& acc, const Unit& u, int wr, int wc, int fr, int fq) const {
        asm volatile("" : "+v"(fr), "+v"(fq));
        float* base = C + u.b1 * cS1 + u.b2 * cS2;
        const int row0 = u.pm * BM + wr * 64 + fr, col0 = u.pn * BM + wc * 32 + 4 * fq;
#pragma unroll
        for (int ai = 0; ai < 2; ++ai)
#pragma unroll
            for (int m = 0; m < 4; ++m) { float* rowp = base + (size_t)(row0 + ai * HALF + m * 16) * ldc + col0;
#pragma unroll
                for (int bj = 0; bj < 2; ++bj)
#pragma unroll
                    for (int n = 0; n < 2; ++n) *(f32x4*)(rowp + bj * HALF + n * 16) = acc[ai][bj][m][n];
                asm volatile("" ::: "memory"); }
    }
};
struct EpiResid {
    static constexpr bool PERM = false;
    float* H; float alpha;
    __device__ __forceinline__ void operator()(const Acc& acc, const Unit& u, int wr, int wc, int fr, int fq) const {
        asm volatile("" : "+v"(fr), "+v"(fq));
        const int row0 = u.pm * BM + wr * 64 + fr, col0 = u.pn * BM + wc * 32 + 4 * fq;
#pragma unroll
        for (int ai = 0; ai < 2; ++ai)
#pragma unroll
            for (int m = 0; m < 4; ++m) { float* rowp = H + (size_t)(row0 + ai * HALF + m * 16) * D_ + col0;
#pragma unroll
                for (int bj = 0; bj < 2; ++bj)
#pragma unroll
                    for (int n = 0; n < 2; ++n) { f32x4* p = (f32x4*)(rowp + bj * HALF + n * 16); const f32x4 h = *p; *p = h * alpha + acc[ai][bj][m][n]; }
                asm volatile("" ::: "memory"); }
    }
};
struct EpiS5Y {
    static constexpr bool PERM = true;
    bf16_t* MIXED;
    __device__ __forceinline__ void operator()(const Acc& acc, const Unit& u, int wr, int wc, int fr, int fq) const {
        asm volatile("" : "+v"(fr), "+v"(fq));
        const int row0 = u.pm * BM + wr * 64 + fr, col0 = wc * 32 + 8 * fq;
#pragma unroll
        for (int ai = 0; ai < 2; ++ai)
#pragma unroll
            for (int m = 0; m < 4; ++m) { const int row = row0 + ai * HALF + m * 16;
#pragma unroll
                for (int bj = 0; bj < 2; ++bj) { const int col = col0 + bj * HALF, j = col >> 4, ho = col & 15;
                    const f32x4 v0 = acc[ai][bj][m][0], v1 = acc[ai][bj][m][1];
                    u32x4 w; w.x = pk2(gelu_tanh(v0[0]), gelu_tanh(v0[1])); w.y = pk2(gelu_tanh(v0[2]), gelu_tanh(v0[3])); w.z = pk2(gelu_tanh(v1[0]), gelu_tanh(v1[1])); w.w = pk2(gelu_tanh(v1[2]), gelu_tanh(v1[3]));
                    *(u32x4*)(MIXED + ((size_t)row * 16 + j) * D_ + 768 + u.b1 * 16 + ho) = w; asm volatile("" ::: "memory"); } }
    }
};
struct EpiGLU {
    static constexpr bool PERM = true;
    bf16_t* MIXED; const float* bias;
    __device__ __forceinline__ void operator()(const Acc& acc, const Unit& u, int wr, int wc, int fr, int fq) const {
        asm volatile("" : "+v"(fr), "+v"(fq));
        const int row0 = u.pm * BM + wr * 64 + fr, col0 = wc * 32 + 8 * fq;
#pragma unroll
        for (int ai = 0; ai < 2; ++ai)
#pragma unroll
            for (int m = 0; m < 4; ++m) { const int row = row0 + ai * HALF + m * 16;
#pragma unroll
                for (int bj = 0; bj < 2; ++bj) { const int col = col0 + bj * HALF;
                    u32x4* gp = (u32x4*)(MIXED + (size_t)row * D_ + 768 + col); const u32x4 gv = *gp;
                    const f32x4 b0 = *(const f32x4*)(bias + col), b1 = *(const f32x4*)(bias + col + 4);
                    const f32x4 v0 = acc[ai][bj][m][0] + b0, v1 = acc[ai][bj][m][1] + b1;
                    float o[8]; const unsigned gw[4] = {gv.x, gv.y, gv.z, gv.w};
#pragma unroll
                    for (int e = 0; e < 4; ++e) { const float a = e < 2 ? v0[2 * e] : v1[2 * e - 4], b = e < 2 ? v0[2 * e + 1] : v1[2 * e - 3];
                        o[2 * e] = bflo(gw[e]) * __builtin_amdgcn_rcpf(1.f + __expf(-a)); o[2 * e + 1] = bfhi(gw[e]) * __builtin_amdgcn_rcpf(1.f + __expf(-b)); }
                    u32x4 w; w.x = pk2(o[0], o[1]); w.y = pk2(o[2], o[3]); w.z = pk2(o[4], o[5]); w.w = pk2(o[6], o[7]);
                    *gp = w; asm volatile("" ::: "memory"); } }
    }
};

struct EpiSoftmax {
    static constexpr bool PERM = true;
    bf16_t* C; int ldc; size_t cS1, cS2; LAS float* red;
    __device__ __forceinline__ void operator()(const Acc& acc, const Unit& u, int wr, int wc, int fr, int fq) const {
        asm volatile("" : "+v"(fr), "+v"(fq));
        LAS float* red2 = red + 1024;
        float mx[2][4];
#pragma unroll
        for (int ai = 0; ai < 2; ++ai)
#pragma unroll
            for (int m = 0; m < 4; ++m) { float v = -1e30f;
#pragma unroll
                for (int bj = 0; bj < 2; ++bj)
#pragma unroll
                    for (int n = 0; n < 2; ++n) { const f32x4 x = acc[ai][bj][m][n]; v = fmaxf(v, fmaxf(fmaxf(x[0], x[1]), fmaxf(x[2], x[3]))); }
                v = fmaxf(v, __shfl_xor(v, 16)); v = fmaxf(v, __shfl_xor(v, 32));
                if (fq == 0) red[(ai * HALF + wr * 64 + m * 16 + fr) * 4 + wc] = v; }
        asm volatile("s_waitcnt lgkmcnt(0)" ::: "memory"); __builtin_amdgcn_s_barrier(); asm volatile("" ::: "memory");
        float sm[2][4];
#pragma unroll
        for (int ai = 0; ai < 2; ++ai)
#pragma unroll
            for (int m = 0; m < 4; ++m) { const f32x4 r4 = *(const LAS f32x4*)(red + (ai * HALF + wr * 64 + m * 16 + fr) * 4);
                const float M = fmaxf(fmaxf(r4[0], r4[1]), fmaxf(r4[2], r4[3])); mx[ai][m] = M; float s = 0.f;
#pragma unroll
                for (int bj = 0; bj < 2; ++bj)
#pragma unroll
                    for (int n = 0; n < 2; ++n) { const f32x4 x = acc[ai][bj][m][n]; s += (__expf(x[0] - M) + __expf(x[1] - M)) + (__expf(x[2] - M) + __expf(x[3] - M)); }
                s += __shfl_xor(s, 16); s += __shfl_xor(s, 32);
                if (fq == 0) red2[(ai * HALF + wr * 64 + m * 16 + fr) * 4 + wc] = s; }
        asm volatile("s_waitcnt lgkmcnt(0)" ::: "memory"); __builtin_amdgcn_s_barrier(); asm volatile("" ::: "memory");
        bf16_t* base = C + u.b1 * cS1 + u.b2 * cS2;
        const int row0 = u.pm * BM + wr * 64 + fr, col0 = wc * 32 + 8 * fq;
#pragma unroll
        for (int ai = 0; ai < 2; ++ai)
#pragma unroll
            for (int m = 0; m < 4; ++m) { const f32x4 r4 = *(const LAS f32x4*)(red2 + (ai * HALF + wr * 64 + m * 16 + fr) * 4);
                const float inv = 1.f / ((r4[0] + r4[1]) + (r4[2] + r4[3])), M = mx[ai][m];
                bf16_t* rowp = base + (size_t)(row0 + ai * HALF + m * 16) * ldc + col0;
#pragma unroll
                for (int bj = 0; bj < 2; ++bj) { const f32x4 v0 = acc[ai][bj][m][0], v1 = acc[ai][bj][m][1];
                    u32x4 w; w.x = pk2(__expf(v0[0] - M) * inv, __expf(v0[1] - M) * inv); w.y = pk2(__expf(v0[2] - M) * inv, __expf(v0[3] - M) * inv);
                    w.z = pk2(__expf(v1[0] - M) * inv, __expf(v1[1] - M) * inv); w.w = pk2(__expf(v1[2] - M) * inv, __expf(v1[3] - M) * inv);
                    *(u32x4*)(rowp + bj * HALF) = w; }
                asm volatile("" ::: "memory"); }
    }
};


__device__ __forceinline__ void row_stats(const float* SL, size_t row, float& mu, float& rs) {
    const f32x4 a = *(const f32x4*)(SL + row * 8), b = *(const f32x4*)(SL + row * 8 + 4);
    const float S = (a[0] + a[2]) + (b[0] + b[2]), Q = (a[1] + a[3]) + (b[1] + b[3]);
    mu = S * (1.f / D_); rs = rsqrtf(fmaxf(Q * (1.f / D_) - mu * mu, 0.f) + LN_EPS);
}
template <bool FIRST, bool LAST> struct EpiResidLN {
    static constexpr bool PERM = false;
    float* H; bf16_t* HB; const float* SLr; float* SLw; const LAS float* gl; const float* unused_; LAS float* red; float alpha;
    __device__ __forceinline__ void operator()(const Acc& acc, const Unit& u, int wr, int wc, int fr, int fq) const {
        asm volatile("" : "+v"(fr), "+v"(fq));
        const int col0 = u.pn * BM + wc * 32 + 4 * fq;
        const size_t rowb = (size_t)u.pm * BM + wr * 64 + fr;
        u32x2 hA[4], hB[4]; f32x4 sna = (f32x4){0.f, 0.f, 0.f, 0.f}, snb = (f32x4){0.f, 0.f, 0.f, 0.f};
        if (!FIRST) { sna = *(const f32x4*)(SLr + rowb * 8); snb = *(const f32x4*)(SLr + rowb * 8 + 4); }
#pragma unroll
        for (int q = 0; q < 4; ++q) { hA[q] = *(const u32x2*)(HB + rowb * D_ + col0 + (q >> 1) * HALF + (q & 1) * 16); hB[q] = *(const u32x2*)(HB + (rowb + 16) * D_ + col0 + (q >> 1) * HALF + (q & 1) * 16); }
#pragma unroll
        for (int i = 0; i < 8; ++i) { const int ai = i >> 2, m = i & 3; const int rl = ai * HALF + wr * 64 + m * 16 + fr; const size_t row = (size_t)u.pm * BM + rl;
                float mu = 0.f, rs = 1.f;
                if (!FIRST) { const float S = (sna[0] + sna[2]) + (snb[0] + snb[2]), Q = (sna[1] + sna[3]) + (snb[1] + snb[3]); mu = S * (1.f / D_); rs = rsqrtf(fmaxf(Q * (1.f / D_) - mu * mu, 0.f) + LN_EPS); }
                u32x2 hc[4];
#pragma unroll
                for (int q = 0; q < 4; ++q) { hc[q] = hA[q]; hA[q] = hB[q]; }
                if (i < 7) { const size_t rown = rowb + ((i + 1) >> 2) * HALF + ((i + 1) & 3) * 16;
                    if (!FIRST) { sna = *(const f32x4*)(SLr + rown * 8); snb = *(const f32x4*)(SLr + rown * 8 + 4); } }
                if (i < 6) { const size_t rown = rowb + ((i + 2) >> 2) * HALF + ((i + 2) & 3) * 16;
#pragma unroll
                    for (int q = 0; q < 4; ++q) hB[q] = *(const u32x2*)(HB + rown * D_ + col0 + (q >> 1) * HALF + (q & 1) * 16); }
                float sm = 0.f, sq = 0.f; float* hp = H + row * D_ + col0; bf16_t* bp = HB + row * D_ + col0;
#pragma unroll
                for (int q = 0; q < 4; ++q) { const int bj = q >> 1, n = q & 1, co = bj * HALF + n * 16; f32x4 h = (f32x4){bflo(hc[q].x), bfhi(hc[q].x), bflo(hc[q].y), bfhi(hc[q].y)};
                        if (!FIRST) { const f32x4 g = *(const LAS f32x4*)(gl + col0 + co), b = *(const LAS f32x4*)(gl + D_ + col0 + co); h = (h - mu) * rs * g + b; }
                        const f32x4 pre = h * alpha + acc[ai][bj][m][n];
                        if (LAST) *(f32x4*)(hp + co) = pre;
                        else { u32x2 w; w.x = pk2(pre[0], pre[1]); w.y = pk2(pre[2], pre[3]); *(u32x2*)(bp + co) = w; }
                        sm += (pre[0] + pre[1]) + (pre[2] + pre[3]); sq += (pre[0] * pre[0] + pre[1] * pre[1]) + (pre[2] * pre[2] + pre[3] * pre[3]); }
                sm += __shfl_xor(sm, 16); sm += __shfl_xor(sm, 32); sq += __shfl_xor(sq, 16); sq += __shfl_xor(sq, 32);
                if (fq == 0) *(LAS f32x2*)(red + (rl * 4 + wc) * 2) = (f32x2){sm, sq};
                asm volatile("" ::: "memory"); }
        asm volatile("s_waitcnt lgkmcnt(0)" ::: "memory"); __builtin_amdgcn_s_barrier(); asm volatile("" ::: "memory");
        const int t = (wr * 4 + wc) * 64 + fq * 16 + fr;
        if (t < 256) { const f32x4 p0 = *(const LAS f32x4*)(red + t * 8), p1 = *(const LAS f32x4*)(red + t * 8 + 4);
            *(f32x2*)(SLw + ((size_t)u.pm * BM + t) * 8 + u.pn * 2) = (f32x2){(p0[0] + p0[2]) + (p1[0] + p1[2]), (p0[1] + p0[3]) + (p1[1] + p1[3])}; }
    }
};
template <int ACT> struct EpiStoreLN {
    static constexpr bool PERM = true;
    bf16_t* C; int ldc; int ncols; float scale; const float* SLr; const float* CS; const float* CB;
    __device__ __forceinline__ void operator()(const Acc& acc, const Unit& u, int wr, int wc, int fr, int fq) const {
        asm volatile("" : "+v"(fr), "+v"(fq));
        const int row0 = u.pm * BM + wr * 64 + fr, col0 = u.pn * BM + wc * 32 + 8 * fq;
        f32x4 cs[2][2], cbv[2][2];
#pragma unroll
        for (int bj = 0; bj < 2; ++bj) { const int c = col0 + bj * HALF; cs[bj][0] = *(const f32x4*)(CS + c); cs[bj][1] = *(const f32x4*)(CS + c + 4); cbv[bj][0] = *(const f32x4*)(CB + c); cbv[bj][1] = *(const f32x4*)(CB + c + 4); }
        f32x4 sna = *(const f32x4*)(SLr + (size_t)row0 * 8), snb = *(const f32x4*)(SLr + (size_t)row0 * 8 + 4);
#pragma unroll
        for (int i = 0; i < 8; ++i) { const int ai = i >> 2, m = i & 3; const size_t row = (size_t)(row0 + ai * HALF + m * 16);
            const float S = (sna[0] + sna[2]) + (snb[0] + snb[2]), Q = (sna[1] + sna[3]) + (snb[1] + snb[3]); const float mu = S * (1.f / D_), rs = rsqrtf(fmaxf(Q * (1.f / D_) - mu * mu, 0.f) + LN_EPS);
            if (i < 7) { const size_t rown = (size_t)(row0 + ((i + 1) >> 2) * HALF + ((i + 1) & 3) * 16); sna = *(const f32x4*)(SLr + rown * 8); snb = *(const f32x4*)(SLr + rown * 8 + 4); }
            bf16_t* rowp = C + row * ldc + col0;
#pragma unroll
            for (int bj = 0; bj < 2; ++bj) { const int c = col0 + bj * HALF;
                f32x4 v0 = (acc[ai][bj][m][0] - cs[bj][0] * mu) * rs + cbv[bj][0], v1 = (acc[ai][bj][m][1] - cs[bj][1] * mu) * rs + cbv[bj][1];
                if (ACT == 1) {
#pragma unroll
                    for (int e = 0; e < 4; ++e) { float a0 = fmaxf(v0[e], 0.f), a1 = fmaxf(v1[e], 0.f); v0[e] = a0 * a0; v1[e] = a1 * a1; } }
                v0 = v0 * scale; v1 = v1 * scale;
                u32x4 w; w.x = pk2(v0[0], v0[1]); w.y = pk2(v0[2], v0[3]); w.z = pk2(v1[0], v1[1]); w.w = pk2(v1[2], v1[3]);
                if (c < ncols) *(u32x4*)(rowp + bj * HALF) = w; }
            asm volatile("" ::: "memory"); }
    }
};

template <class Epi>
__device__ __forceinline__ void gemm_phase(LAS unsigned char* lds, const Gemm g, const Sched& S, const Epi& E) {
    constexpr bool ALIGN_EPI = true;
    const int tid = ltid(), wid = __builtin_amdgcn_readfirstlane(tid >> 6), lane = tid & 63, wr = wid >> 2, wc = wid & 3, fr = lane & 15, fq = lane >> 4;
    int K_ = g.K; asm volatile("" : "+s"(K_)); const int K = K_, nt = K / BK;
    unsigned voffA[2], voffB[2];
#pragma unroll
    for (int i = 0; i < 2; ++i) { int R, C; stage_rc(tid * 16 + i * 8192, R, C); const int Rb = Epi::PERM ? ((R & ~31) + perm32(R & 31)) : R;
        voffA[i] = (unsigned)(R * g.lda + C) * 2u; voffB[i] = (unsigned)(Rb * g.ldb + C) * 2u; }
    const size_t kstep = (size_t)(BK * 2);
    const size_t hstepA = (size_t)HALF * g.lda * 2, hstepB = (size_t)HALF * g.ldb * 2;
    const unsigned ldsw = (unsigned)wid * 1024u;
    const int aoff = lds_byte(wr * 64 + fr, fq * 8), boff = lds_byte(wc * 32 + fr, fq * 8);
#define PG8_UA(u) ((const char*)g.A + ((size_t)(u).b1 * g.aS1 + (size_t)(u).b2 * g.aS2 + (size_t)(u).pm * BM * g.lda) * 2)
#define PG8_UB(u) ((const char*)g.Bt + ((size_t)(u).b1 * g.bS1 + (size_t)(u).b2 * g.bS2 + (size_t)(u).pn * BM * g.ldb) * 2)
#define PG8_SA(b, h) (((b) * 2 + (h)) * HTB)
#define PG8_SB(b, h) ((4 + (b) * 2 + (h)) * HTB)
#define PG8_STAGE(bufoff, gbase, voff) do { _Pragma("unroll") for (int _i = 0; _i < 2; ++_i) \
        __builtin_amdgcn_global_load_lds((const unsigned*)((const char*)(gbase) + (voff)[_i]), (LAS unsigned*)(lds + (bufoff) + ldsw + _i * 8192), 16, 0, 0); } while (0)
#define PG8_LDA(dst, b, h) do { _Pragma("unroll") for (int m = 0; m < 4; ++m) _Pragma("unroll") for (int k = 0; k < 2; ++k) dst[m][k] = *(const LAS bf16x8*)(lds + PG8_SA(b, h) + aoff + m * 2048 + k * 1024); } while (0)
#define PG8_LDB(dst, b, h) do { _Pragma("unroll") for (int n = 0; n < 2; ++n) _Pragma("unroll") for (int k = 0; k < 2; ++k) dst[n][k] = *(const LAS bf16x8*)(lds + PG8_SB(b, h) + boff + n * 2048 + k * 1024); } while (0)
#define PG8_MMA(ai, bj, At, Bt) do { __builtin_amdgcn_s_setprio(1); _Pragma("unroll") for (int m = 0; m < 4; ++m) _Pragma("unroll") for (int n = 0; n < 2; ++n) _Pragma("unroll") for (int k = 0; k < 2; ++k) \
        acc[ai][bj][m][n] = __builtin_amdgcn_mfma_f32_16x16x32_bf16(Bt[n][k], At[m][k], acc[ai][bj][m][n], 0, 0, 0); __builtin_amdgcn_s_setprio(0); } while (0)
#define PG8_WAIT_V(n) asm volatile("s_waitcnt vmcnt(" #n ")" ::: "memory")
#define PG8_WAIT_L(n) asm volatile("s_waitcnt lgkmcnt(" #n ")" ::: "memory")
#define PG8_BAR __builtin_amdgcn_s_barrier()
#define PG8_SCHED __builtin_amdgcn_sched_barrier(0)
    Unit cur, nxt; int ui = 0;
    if (!S.next(0, cur)) return;
    Acc acc;
#pragma unroll
    for (int a = 0; a < 2; ++a)
#pragma unroll
        for (int b = 0; b < 2; ++b)
#pragma unroll
            for (int m = 0; m < 4; ++m)
#pragma unroll
                for (int n = 0; n < 2; ++n) acc[a][b][m][n] = (f32x4){0.f, 0.f, 0.f, 0.f};
    bf16x8 At[4][2], B0[2][2], B1[2][2];
    const char* cA = PG8_UA(cur); const char* cB = PG8_UB(cur);
    PG8_STAGE(PG8_SB(0, 0), cB, voffB); PG8_STAGE(PG8_SB(0, 1), cB + hstepB, voffB); PG8_STAGE(PG8_SA(0, 0), cA, voffA); PG8_STAGE(PG8_SA(0, 1), cA + hstepA, voffA);
    if (wr == 1) PG8_BAR;
    PG8_WAIT_V(2); PG8_BAR;
    PG8_STAGE(PG8_SB(1, 0), cB + kstep, voffB); PG8_STAGE(PG8_SA(1, 0), cA + kstep, voffA); PG8_STAGE(PG8_SB(1, 1), cB + hstepB + kstep, voffB);
    PG8_WAIT_V(6); PG8_BAR;
    for (;;) {
        const bool has_next = S.next(ui + 1, nxt);
        const char* nA = has_next ? PG8_UA(nxt) : cA; const char* nB = has_next ? PG8_UB(nxt) : cB;
        for (int t = 0; t < nt; t += 2) {
            const bool last = (t == nt - 2);
            const char* a1 = cA + (size_t)(t + 1) * kstep;
            const char* a2 = last ? nA : cA + (size_t)(t + 2) * kstep; const char* b2 = last ? nB : cB + (size_t)(t + 2) * kstep;
            const char* a3 = a2 + kstep; const char* b3 = b2 + kstep;
            PG8_LDB(B0, 0, 0); PG8_LDB(B1, 0, 1); PG8_SCHED; PG8_LDA(At, 0, 0); PG8_STAGE(PG8_SA(1, 1), a1 + hstepA, voffA);
            PG8_WAIT_V(8); PG8_WAIT_L(0); PG8_BAR; PG8_MMA(0, 0, At, B0); PG8_MMA(0, 1, At, B1); PG8_BAR; PG8_SCHED;
            PG8_LDA(At, 0, 1); PG8_STAGE(PG8_SB(0, 0), b2, voffB); PG8_STAGE(PG8_SB(0, 1), b2 + hstepB, voffB); PG8_STAGE(PG8_SA(0, 0), a2, voffA);
            PG8_WAIT_V(8); PG8_WAIT_L(0); PG8_BAR; PG8_MMA(1, 0, At, B0); PG8_MMA(1, 1, At, B1); PG8_BAR; PG8_SCHED;
            PG8_LDB(B0, 1, 0); PG8_LDB(B1, 1, 1); PG8_SCHED; PG8_LDA(At, 1, 0); PG8_STAGE(PG8_SA(0, 1), a2 + hstepA, voffA);
            PG8_WAIT_V(8); PG8_WAIT_L(0); PG8_BAR; PG8_MMA(0, 0, At, B0); PG8_MMA(0, 1, At, B1); PG8_BAR; PG8_SCHED;
            PG8_LDA(At, 1, 1); PG8_STAGE(PG8_SB(1, 0), b3, voffB); PG8_STAGE(PG8_SB(1, 1), b3 + hstepB, voffB); PG8_STAGE(PG8_SA(1, 0), a3, voffA);
            PG8_WAIT_V(8); PG8_WAIT_L(0); PG8_BAR; PG8_MMA(1, 0, At, B0); PG8_MMA(1, 1, At, B1); PG8_BAR; PG8_SCHED;
        }
        if constexpr (ALIGN_EPI) { if (wr == 0) PG8_BAR; }
        E(acc, cur, wr, wc, fr, fq);
        if (!has_next) break;
#pragma unroll
        for (int a = 0; a < 2; ++a)
#pragma unroll
            for (int b = 0; b < 2; ++b)
#pragma unroll
                for (int m = 0; m < 4; ++m)
#pragma unroll
                    for (int n = 0; n < 2; ++n) acc[a][b][m][n] = (f32x4){0.f, 0.f, 0.f, 0.f};
        cur = nxt; cA = nA; cB = nB; ++ui;
        if constexpr (ALIGN_EPI) { if (wr == 1) PG8_BAR; }
    }
    PG8_WAIT_V(0);
    if constexpr (!ALIGN_EPI) { if (wr == 0) PG8_BAR; }
    PG8_BAR;
#undef PG8_UA
#undef PG8_UB
#undef PG8_SA
#undef PG8_SB
#undef PG8_STAGE
#undef PG8_LDA
#undef PG8_LDB
#undef PG8_MMA
#undef PG8_WAIT_V
#undef PG8_WAIT_L
#undef PG8_BAR
#undef PG8_SCHED
}
}

struct Args { const float* in[35]; float* out; unsigned char* ws; int ph_lo, ph_hi, coop, pad; };
enum { I_X = 0, I_MEM, I_LNIN_G, I_LNIN_B, I_WIN, I_RPB, I_CONVW, I_CONVB, I_DTB, I_ALOG, I_SSDD, I_SSDNW, I_LRE, I_LIM, I_LOGDT, I_BRE, I_BIM, I_CRE, I_CIM, I_S5D, I_GLUW, I_GLUB,
       I_WOUT, I_LNMIX_G, I_LNMIX_B, I_WQ, I_WK, I_WV, I_WO, I_LNXA_G, I_LNXA_B, I_W1, I_W2, I_LNMLP_G, I_LNMLP_B };

__device__ __forceinline__ int opq(int i) { asm volatile("" : "+s"(i)); return i; }
__device__ __forceinline__ void transpose_item(const float* W, int K, int N, bf16_t* WT, LAS float* scr, int item, int nblk, int lane, const float* rs) {
    const int kb = item / nblk, nb = item % nblk, k0 = 64 * kb, n0 = 32 * nb;
    const int nn = n0 + (lane & 31);
#pragma unroll
    for (int i = 0; i < 32; ++i) { const int kk = 2 * i + (lane >> 5); scr[kk * 33 + (lane & 31)] = (nn < N) ? W[(size_t)(k0 + kk) * N + nn] * (rs ? rs[k0 + kk] : 1.f) : 0.f; }
    LDS_WAIT();
    const int c = lane & 7;
#pragma unroll
    for (int j = 0; j < 4; ++j) { const int n = (lane >> 3) + 8 * j; const LAS float* s = scr + (8 * c) * 33 + n;
        u32x4 o; o.x = pk2(s[0 * 33], s[1 * 33]); o.y = pk2(s[2 * 33], s[3 * 33]); o.z = pk2(s[4 * 33], s[5 * 33]); o.w = pk2(s[6 * 33], s[7 * 33]);
        *(u32x4*)(WT + (size_t)(n0 + n) * K + k0 + 8 * c) = o; }
    LDS_WAIT();
}
__device__ __forceinline__ void tr_matrix(const float* W, int K, int N, int nblk, bf16_t* WT, LAS float* scr, int gw, int NGW, int lane, const float* rs = nullptr) {
    const int nitems = (K / 64) * nblk;
    for (int it = gw; it < nitems; it += NGW) transpose_item(W, K, N, WT, scr, it, nblk, lane, rs);
}
__device__ __forceinline__ void ln_row(const float* xrow, float* hrow, bf16_t* brow, const float* gam, const float* bet, int lane) {
    const f32x4* xr = (const f32x4*)xrow + lane;
    f32x4 v[4]; float s = 0.f;
#pragma unroll
    for (int j = 0; j < 4; ++j) { v[j] = xr[64 * j]; s += (v[j].x + v[j].y) + (v[j].z + v[j].w); }
    const float mean = wave_sum(s) * (1.f / D_); float s2 = 0.f;
#pragma unroll
    for (int j = 0; j < 4; ++j) { v[j] = v[j] - mean; s2 += (v[j].x * v[j].x + v[j].y * v[j].y) + (v[j].z * v[j].z + v[j].w * v[j].w); }
    const float rstd = rsqrtf(wave_sum(s2) * (1.f / D_) + LN_EPS);
    f32x4* ho = (f32x4*)hrow + lane; u32x2* bo = (u32x2*)brow + lane;
#pragma unroll
    for (int j = 0; j < 4; ++j) { const f32x4 g = ((const f32x4*)gam)[lane + 64 * j], b = ((const f32x4*)bet)[lane + 64 * j];
        const f32x4 y = v[j] * rstd * g + b; ho[64 * j] = y; u32x2 w; w.x = pk2(y.x, y.y); w.y = pk2(y.z, y.w); bo[64 * j] = w; }
}

__device__ __forceinline__ void ln_row2(const float* x0, const float* x1, float* h0, float* h1, bf16_t* b0, bf16_t* b1, const float* gam, const float* bet, int lane) {
    const f32x4* xr0 = (const f32x4*)x0 + lane; const f32x4* xr1 = (const f32x4*)x1 + lane;
    f32x4 v[4], w[4]; float s = 0.f, t = 0.f;
#pragma unroll
    for (int j = 0; j < 4; ++j) { v[j] = xr0[64 * j]; w[j] = xr1[64 * j]; }
#pragma unroll
    for (int j = 0; j < 4; ++j) { s += (v[j].x + v[j].y) + (v[j].z + v[j].w); t += (w[j].x + w[j].y) + (w[j].z + w[j].w); }
#pragma unroll
    for (int o = 1; o < 64; o <<= 1) { s += __shfl_xor(s, o); t += __shfl_xor(t, o); }
    const float m0 = s * (1.f / D_), m1 = t * (1.f / D_); float s2 = 0.f, t2 = 0.f;
#pragma unroll
    for (int j = 0; j < 4; ++j) { v[j] = v[j] - m0; w[j] = w[j] - m1; s2 += (v[j].x * v[j].x + v[j].y * v[j].y) + (v[j].z * v[j].z + v[j].w * v[j].w); t2 += (w[j].x * w[j].x + w[j].y * w[j].y) + (w[j].z * w[j].z + w[j].w * w[j].w); }
#pragma unroll
    for (int o = 1; o < 64; o <<= 1) { s2 += __shfl_xor(s2, o); t2 += __shfl_xor(t2, o); }
    const float r0 = rsqrtf(s2 * (1.f / D_) + LN_EPS), r1 = rsqrtf(t2 * (1.f / D_) + LN_EPS);
    f32x4* ho0 = (f32x4*)h0 + lane; f32x4* ho1 = (f32x4*)h1 + lane; u32x2* bo0 = (u32x2*)b0 + lane; u32x2* bo1 = (u32x2*)b1 + lane;
#pragma unroll
    for (int j = 0; j < 4; ++j) { const f32x4 g = ((const f32x4*)gam)[lane + 64 * j], b = ((const f32x4*)bet)[lane + 64 * j];
        const f32x4 y0 = v[j] * r0 * g + b, y1 = w[j] * r1 * g + b; if (h0) { ho0[64 * j] = y0; ho1[64 * j] = y1; }
        if (b0) { u32x2 p; p.x = pk2(y0.x, y0.y); p.y = pk2(y0.z, y0.w); bo0[64 * j] = p; p.x = pk2(y1.x, y1.y); p.y = pk2(y1.z, y1.w); bo1[64 * j] = p; } }
}
__device__ __forceinline__ void s5_item(const Args& a, LAS unsigned char* lds, int item, int tid) {
    const int j = item & 15, g = (item >> 4) & 15, l = item >> 8;
    LAS f32x2* Ap = (LAS f32x2*)(lds + 73728);
    LAS f32x2* Bb = (LAS f32x2*)(lds + 73728 + 17408);
    LAS f32x2* Cc = (LAS f32x2*)(lds + 73728 + 17408 + 16384);
    for (int e = tid; e < 2 * 17 * 64; e += 512) { const int p = e & 63, d = (e >> 6) % 17, dir = e / (17 * 64);
        const int gi = (l * 2 + dir) * 16 + g; const float dt = expf(gp(a.in[I_LOGDT])[gi]); const float lr = gp(a.in[I_LRE])[gi * 64 + p], li = gp(a.in[I_LIM])[gi * 64 + p];
        const float mag = expf((float)d * lr * dt); const float th = (float)d * (li * dt); Ap[e] = (f32x2){mag * cosf(th), mag * sinf(th)}; }
    for (int e = tid; e < 2 * 64 * 16; e += 512) { const int h = e & 15, p = (e >> 4) & 63, dir = e >> 10;
        const int gi = (l * 2 + dir) * 16 + g; const float dt = expf(gp(a.in[I_LOGDT])[gi]); const float lr = gp(a.in[I_LRE])[gi * 64 + p], li = gp(a.in[I_LIM])[gi * 64 + p];
        const float mag = expf(lr * dt); const float ar = mag * cosf(li * dt), ai = mag * sinf(li * dt); const float den = lr * lr + li * li;
        const float fr = ((ar - 1.f) * lr + ai * li) / den, fi = (ai * lr - (ar - 1.f) * li) / den;
        const float br = gp(a.in[I_BRE])[((size_t)gi * 64 + p) * 16 + h], bi = gp(a.in[I_BIM])[((size_t)gi * 64 + p) * 16 + h];
        Bb[e] = (f32x2){fr * br - fi * bi, fr * bi + fi * br}; }
    for (int e = tid; e < 2 * 16 * 64; e += 512) { const int p = e & 63, h = (e >> 6) & 15, dir = e >> 10;
        const int gi = (l * 2 + dir) * 16 + g; Cc[e] = (f32x2){gp(a.in[I_CRE])[((size_t)gi * 16 + h) * 64 + p], gp(a.in[I_CIM])[((size_t)gi * 16 + h) * 64 + p]}; }
    __syncthreads();
    bf16_t* TM = (bf16_t*)(lptr(a.ws) + WS_TM) + ((size_t)(l * 16 + g) * 256 + j * 16) * 512;
    for (int e = tid; e < 16 * 512; e += 512) { const int k = e & 511, ho = e >> 9; float v = 0.f;
        if (k < 256) { const int i = k >> 4, hi = k & 15;
            if (i <= j) { const int dd = j - i; float s = 0.f;
                for (int p = 0; p < 64; ++p) { const f32x2 c = Cc[(0 * 16 + ho) * 64 + p], ap = Ap[(0 * 17 + dd) * 64 + p], bb = Bb[(0 * 64 + p) * 16 + hi];
                    const float wr_ = c.x * ap.x - c.y * ap.y, wi_ = c.x * ap.y + c.y * ap.x; s += wr_ * bb.x - wi_ * bb.y; }
                v += s; }
            if (i >= j) { const int dd = i - j; float s = 0.f;
                for (int p = 0; p < 64; ++p) { const f32x2 c = Cc[(1 * 16 + ho) * 64 + p], ap = Ap[(1 * 17 + dd) * 64 + p], bb = Bb[(1 * 64 + p) * 16 + hi];
                    const float wr_ = c.x * ap.x - c.y * ap.y, wi_ = c.x * ap.y + c.y * ap.x; s += wr_ * bb.x - wi_ * bb.y; }
                v += s; }
            if (i == j && hi == ho) v += gp(a.in[I_S5D])[l * 256 + g * 16 + ho];
        } else { const int dir = (k >= 384), p = ((k - 256) & 127) >> 1, ri = k & 1; const int dd = dir ? 16 - j : j + 1;
            const f32x2 c = Cc[(dir * 16 + ho) * 64 + p], ap = Ap[(dir * 17 + dd) * 64 + p];
            v = ri ? -(c.x * ap.y + c.y * ap.x) : (c.x * ap.x - c.y * ap.y); }
        TM[(size_t)ho * 512 + k] = (bf16_t)f2bf(v); }
    bf16_t* SM = (bf16_t*)(lptr(a.ws) + WS_SM) + ((size_t)(l * 16 + g) * 256 + j * 16) * 256;
    for (int e = tid; e < 16 * 256; e += 512) { const int k = e & 255, nn = e >> 8, n = j * 16 + nn; const int dir = n >> 7, p = (n & 127) >> 1, ri = n & 1, i = k >> 4, hi = k & 15;
        const int dd = dir ? i : 15 - i; const f32x2 ap = Ap[(dir * 17 + dd) * 64 + p], bb = Bb[(dir * 64 + p) * 16 + hi];
        const float v = ri ? (ap.x * bb.y + ap.y * bb.x) : (ap.x * bb.x - ap.y * bb.y);
        SM[(size_t)nn * 256 + k] = (bf16_t)f2bf(v); }
    if (j == 0 && tid < 128) { const int dir = tid >> 6, p = tid & 63; ((f32x2*)(lptr(a.ws) + WS_MISC))[((l * 2 + dir) * 16 + g) * 64 + p] = Ap[(dir * 17 + 16) * 64 + p]; }
    __syncthreads();
}

__device__ __forceinline__ void prologue(const Args& a, LAS unsigned char* lds, int G) {
    const int tid = ltid(), lane = tid & 63, wave = tid >> 6;
    const int gw = lbid() * 8 + wave, NGW = G * 8;
    LAS float* scr = (LAS float*)(lds + wave * 8448);
    for (int l = 0; l < 2; ++l) {
        unsigned char* wb = lptr(a.ws) + WS_W + l * LWB;
        tr_matrix(gp(a.in[I_WIN]) + (size_t)l * D_ * NP, D_, NP, NPP / 32, (bf16_t*)(wb + OW_IN), scr, gw, NGW, lane, l == 1 ? gp(a.in[I_LNMLP_G]) : nullptr);
        tr_matrix(gp(a.in[I_WOUT]) + (size_t)l * D_ * D_, D_, D_, 32, (bf16_t*)(wb + OW_OUT), scr, gw, NGW, lane);
        tr_matrix(gp(a.in[I_WQ]) + (size_t)l * D_ * D_, D_, D_, 32, (bf16_t*)(wb + OW_Q), scr, gw, NGW, lane, gp(a.in[I_LNMIX_G]) + l * D_);
        tr_matrix(gp(a.in[I_WK]) + (size_t)l * D_ * D_, D_, D_, 32, (bf16_t*)(wb + OW_K), scr, gw, NGW, lane);
        tr_matrix(gp(a.in[I_WV]) + (size_t)l * D_ * D_, D_, D_, 32, (bf16_t*)(wb + OW_V), scr, gw, NGW, lane);
        tr_matrix(gp(a.in[I_WO]) + (size_t)l * D_ * D_, D_, D_, 32, (bf16_t*)(wb + OW_O), scr, gw, NGW, lane);
        tr_matrix(gp(a.in[I_W1]) + (size_t)l * D_ * FF_, D_, FF_, 128, (bf16_t*)(wb + OW_1), scr, gw, NGW, lane, gp(a.in[I_LNXA_G]) + l * D_);
        tr_matrix(gp(a.in[I_W2]) + (size_t)l * FF_ * D_, FF_, D_, 32, (bf16_t*)(wb + OW_2), scr, gw, NGW, lane);
        tr_matrix(gp(a.in[I_GLUW]) + (size_t)l * 256 * 256, 256, 256, 8, (bf16_t*)(wb + OW_GLU), scr, gw, NGW, lane);
    }
    { const int gt = lbid() * 512 + tid, NT = G * 512; const f32x4* src = (const f32x4*)gp(a.in[I_MEM]); u32x2* dst = (u32x2*)(lptr(a.ws) + WS_MEMB);
      for (int i = gt; i < B_ * MEMT * D_ / 4; i += NT) { const f32x4 v = src[i]; u32x2 w; w.x = pk2(v.x, v.y); w.y = pk2(v.z, v.w); dst[i] = w; } }
    __syncthreads();
    for (int it = lbid(); it < 512; it += G) s5_item(a, lds, it, tid);
    { const float* X = gp(a.in[I_X]); float* H = lptr(a.out); bf16_t* HBp = (bf16_t*)(lptr(a.ws) + WS_HB);
      for (int m = gw; m < M_ / 2; m += NGW) { const size_t r0 = (size_t)m * D_, r1 = (size_t)(m + M_ / 2) * D_;
          ln_row2(X + r0, X + r1, (float*)nullptr, (float*)nullptr, HBp + r0, HBp + r1, gp(a.in[I_LNIN_G]), gp(a.in[I_LNIN_B]), lane); } }
}


__device__ __forceinline__ float* cs_ptr(unsigned char* ws, int l, int set) {
    float* base = (float*)(ws + WS_MISC + MISC_CS) + (size_t)l * 16384;
    return base + (set == 0 ? 0 : set == 1 ? 2048 : 10240);
}
__device__ __forceinline__ void colsum_set(const bf16_t* WT, int N, const float* gam, const float* bet, float* CS, int gw, int NGW, int lane) {
    for (int n = gw; n < N; n += NGW) { const bf16_t* r = WT + (size_t)n * D_; float s = 0.f, c = 0.f;
#pragma unroll
        for (int j = 0; j < 2; ++j) { const int k = (lane + 64 * j) * 8; const u32x4 v = *(const u32x4*)(r + k);
            const f32x4 g0 = *(const f32x4*)(gam + k), g1 = *(const f32x4*)(gam + k + 4), b0 = *(const f32x4*)(bet + k), b1 = *(const f32x4*)(bet + k + 4);
            const float w[8] = {bflo(v.x), bfhi(v.x), bflo(v.y), bfhi(v.y), bflo(v.z), bfhi(v.z), bflo(v.w), bfhi(v.w)};
            s += ((w[0] + w[1]) + (w[2] + w[3])) + ((w[4] + w[5]) + (w[6] + w[7]));
            c += w[0] * (b0[0] / g0[0]) + w[1] * (b0[1] / g0[1]) + w[2] * (b0[2] / g0[2]) + w[3] * (b0[3] / g0[3]) + w[4] * (b1[0] / g1[0]) + w[5] * (b1[1] / g1[1]) + w[6] * (b1[2] / g1[2]) + w[7] * (b1[3] / g1[3]); }
        s = wave_sum(s); c = wave_sum(c);
        if (lane == 0) { CS[n] = s; CS[N + n] = c; } }
}
__device__ __forceinline__ void colsum_phase(const Args& a, int G) {
    const int tid = ltid(), lane = tid & 63, gw = lbid() * 8 + (tid >> 6), NGW = G * 8;
    unsigned char* ws = lptr(a.ws);
    for (int l = 0; l < 2; ++l) { unsigned char* wb = ws + WS_W + (size_t)l * LWB;
        colsum_set((const bf16_t*)(wb + OW_Q), D_, gp(a.in[I_LNMIX_G]) + l * D_, gp(a.in[I_LNMIX_B]) + l * D_, cs_ptr(ws, l, 0), gw, NGW, lane);
        colsum_set((const bf16_t*)(wb + OW_1), FF_, gp(a.in[I_LNXA_G]) + l * D_, gp(a.in[I_LNXA_B]) + l * D_, cs_ptr(ws, l, 1), gw, NGW, lane);
        if (l == 1) colsum_set((const bf16_t*)(wb + OW_IN), NPP, gp(a.in[I_LNMLP_G]), gp(a.in[I_LNMLP_B]), cs_ptr(ws, l, 2), gw, NGW, lane); }
}
__device__ __forceinline__ void na_phase(const bf16_t* PROJ, bf16_t* MIXED, const float* rpb, int G) {
    const int tid = ltid();
    for (int it = lbid(); it < 512; it += G) {
        const int h = it & 3, rg = (it >> 2) & 15, b = it >> 6;
        const int r = rg * 8 + (tid >> 6), c = tid & 63;
        const size_t row = (size_t)b * T_ + r * 64 + c;
        float q[64], o[64];
        { const u32x4* qp = (const u32x4*)(PROJ + row * NP + PQ + h * 64);
#pragma unroll
          for (int i = 0; i < 8; ++i) { const u32x4 v = qp[i]; q[8 * i + 0] = bflo(v.x) * 0.125f; q[8 * i + 1] = bfhi(v.x) * 0.125f; q[8 * i + 2] = bflo(v.y) * 0.125f; q[8 * i + 3] = bfhi(v.y) * 0.125f;
              q[8 * i + 4] = bflo(v.z) * 0.125f; q[8 * i + 5] = bfhi(v.z) * 0.125f; q[8 * i + 6] = bflo(v.w) * 0.125f; q[8 * i + 7] = bfhi(v.w) * 0.125f; } }
#pragma unroll
        for (int d = 0; d < 64; ++d) o[d] = 0.f;
        const int r0 = min(max(r - 4, 0), 120), c0 = min(max(c - 8, 0), 48);
        float mx = -1e30f, lsum = 0.f;
        const float* rp = rpb + h * 15 * 31;
#pragma unroll 1
        for (int kk = 0; kk < 128; ++kk) {
            const int kr = kk >> 4, kc = kk & 15;
            const int krow = r0 + kr;
            const bf16_t* kptr = PROJ + ((size_t)b * T_ + krow * 64 + c0 + kc) * NP + PK + h * 64;
            const u32x4* kp = (const u32x4*)kptr; float acc = 0.f;
#pragma unroll
            for (int i = 0; i < 8; ++i) { const u32x4 v = kp[i];
                acc += q[8 * i + 0] * bflo(v.x) + q[8 * i + 1] * bfhi(v.x) + q[8 * i + 2] * bflo(v.y) + q[8 * i + 3] * bfhi(v.y)
                     + q[8 * i + 4] * bflo(v.z) + q[8 * i + 5] * bfhi(v.z) + q[8 * i + 6] * bflo(v.w) + q[8 * i + 7] * bfhi(v.w); }
            int dc = c0 + kc - c; dc = min(max(dc, -15), 15);
            const float sc = acc + rp[(krow - r + 7) * 31 + dc + 15];
            if (sc > mx) { const float al = __expf(mx - sc); mx = sc; lsum *= al;
#pragma unroll
                for (int d = 0; d < 64; ++d) o[d] *= al; }
            const float p = __expf(sc - mx); lsum += p; const u32x4* vp = (const u32x4*)(kptr + (PV - PK));
#pragma unroll
            for (int i = 0; i < 8; ++i) { const u32x4 v = vp[i];
                o[8 * i + 0] += p * bflo(v.x); o[8 * i + 1] += p * bfhi(v.x); o[8 * i + 2] += p * bflo(v.y); o[8 * i + 3] += p * bfhi(v.y);
                o[8 * i + 4] += p * bflo(v.z); o[8 * i + 5] += p * bfhi(v.z); o[8 * i + 6] += p * bflo(v.w); o[8 * i + 7] += p * bfhi(v.w); }
        }
        const float inv = 1.f / lsum; u32x4* op = (u32x4*)(MIXED + row * D_ + h * 64);
#pragma unroll
        for (int i = 0; i < 8; ++i) { u32x4 w; w.x = pk2(o[8 * i] * inv, o[8 * i + 1] * inv); w.y = pk2(o[8 * i + 2] * inv, o[8 * i + 3] * inv); w.z = pk2(o[8 * i + 4] * inv, o[8 * i + 5] * inv); w.w = pk2(o[8 * i + 6] * inv, o[8 * i + 7] * inv); op[i] = w; }
    }
}

__device__ __forceinline__ void conv_phase(const bf16_t* PROJ, bf16_t* CONV, const float* cw, const float* cb, int G) {
    const int gt = lbid() * 512 + ltid(), NT = G * 512;
    for (int idx = gt; idx < (M_ / 8) * 96; idx += NT) { const int rb = idx / 96, ch = (idx - rb * 96) * 8, row0 = rb * 8, t0 = row0 & (T_ - 1);
        u32x4 x[12];
#pragma unroll
        for (int i = 0; i < 12; ++i) { const int tt = t0 + i - 2; x[i] = (tt >= 0 && tt < T_) ? *(const u32x4*)(PROJ + (size_t)(row0 + i - 2) * NP + PX + ch) : (u32x4){0u, 0u, 0u, 0u}; }
        float w[5][8], bias[8];
#pragma unroll
        for (int jj = 0; jj < 5; ++jj) { const f32x4 w0 = *(const f32x4*)(cw + jj * 768 + ch), w1 = *(const f32x4*)(cw + jj * 768 + ch + 4);
            w[jj][0] = w0[0]; w[jj][1] = w0[1]; w[jj][2] = w0[2]; w[jj][3] = w0[3]; w[jj][4] = w1[0]; w[jj][5] = w1[1]; w[jj][6] = w1[2]; w[jj][7] = w1[3]; }
        { const f32x4 b0 = *(const f32x4*)(cb + ch), b1 = *(const f32x4*)(cb + ch + 4); bias[0] = b0[0]; bias[1] = b0[1]; bias[2] = b0[2]; bias[3] = b0[3]; bias[4] = b1[0]; bias[5] = b1[1]; bias[6] = b1[2]; bias[7] = b1[3]; }
#pragma unroll
        for (int o = 0; o < 8; ++o) { float acc[8];
#pragma unroll
            for (int e = 0; e < 8; ++e) acc[e] = bias[e];
#pragma unroll
            for (int jj = 0; jj < 5; ++jj) { const u32x4 v = x[o + jj];
                acc[0] += w[jj][0] * bflo(v.x); acc[1] += w[jj][1] * bfhi(v.x); acc[2] += w[jj][2] * bflo(v.y); acc[3] += w[jj][3] * bfhi(v.y);
                acc[4] += w[jj][4] * bflo(v.z); acc[5] += w[jj][5] * bfhi(v.z); acc[6] += w[jj][6] * bflo(v.w); acc[7] += w[jj][7] * bfhi(v.w); }
            u32x4 r; r.x = pk2(silu_f(acc[0]), silu_f(acc[1])); r.y = pk2(silu_f(acc[2]), silu_f(acc[3])); r.z = pk2(silu_f(acc[4]), silu_f(acc[5])); r.w = pk2(silu_f(acc[6]), silu_f(acc[7]));
            *(u32x4*)(CONV + (size_t)(row0 + o) * 768 + ch) = r; } }
}
__device__ __forceinline__ void s5_gather_phase(const bf16_t* PROJ, bf16_t* UX, int G) {
    const int gt = lbid() * 512 + ltid(), NT = G * 512;
    for (int idx = gt; idx < M_ * 32; idx += NT) { const int row = idx >> 5, part = idx & 31, g = part >> 1, hf = part & 1, b = row >> 13, t = row & (T_ - 1), c = t >> 4, i = t & 15;
        const u32x4 v = *(const u32x4*)(PROJ + (size_t)row * NP + PU + g * 16 + hf * 8);
        *(u32x4*)(UX + ((size_t)g * 4096 + b * 512 + c) * 512 + i * 16 + hf * 8) = v; }
}

__device__ __forceinline__ float softplus_f(float x) { return x > 20.f ? x : log1pf(expf(x)); }

__device__ __forceinline__ void ssd_passA(const Args& a, int l, LAS unsigned char* lds, int G) {
    const bf16_t* PROJ = (const bf16_t*)(lptr(a.ws) + WS_PROJ); const bf16_t* CONV = (const bf16_t*)(lptr(a.ws) + WS_CONV);
    float* ST = (float*)(lptr(a.ws) + WS_ST); float* CD = (float*)(lptr(a.ws) + WS_MISC + 65536);
    const int tid = ltid(), sub = tid & 255, dir = tid >> 8, p = sub >> 2, nq = sub & 3;
    LAS float* dts = (LAS float*)lds; LAS float* dAs = dts + 256;
    for (int it = lbid(); it < 4096; it += G) {
        const int hd = it & 7, c = (it >> 3) & 63, b = it >> 9, g = hd >> 2;
        if (sub < 128) { const int s = sub; const size_t row = (size_t)b * T_ + c * 128 + s;
            const float raw = bf2f(PROJ[row * NP + PDT + dir * 8 + hd]); const float dt = softplus_f(raw + gp(a.in[I_DTB])[(l * 2 + dir) * 8 + hd]);
            const float av = -expf(gp(a.in[I_ALOG])[(l * 2 + dir) * 8 + hd]); dts[dir * 128 + s] = dt; dAs[dir * 128 + s] = expf(dt * av); }
        __syncthreads();
        float h[16];
#pragma unroll
        for (int j = 0; j < 16; ++j) h[j] = 0.f;
        float cdp = 1.f;
        for (int ss = 0; ss < 128; ++ss) { const int s = dir ? 127 - ss : ss; const size_t row = (size_t)b * T_ + c * 128 + s;
            const float dA = dAs[dir * 128 + s], dtv = dts[dir * 128 + s];
            const float xv = bf2f(CONV[row * 768 + hd * 64 + p]) * dtv;
            const u32x4* bp = (const u32x4*)(CONV + row * 768 + 512 + g * 64 + nq * 16); const u32x4 b0 = bp[0], b1 = bp[1];
            const unsigned bw[8] = {b0.x, b0.y, b0.z, b0.w, b1.x, b1.y, b1.z, b1.w};
#pragma unroll
            for (int j = 0; j < 8; ++j) { h[2 * j] = h[2 * j] * dA + xv * bflo(bw[j]); h[2 * j + 1] = h[2 * j + 1] * dA + xv * bfhi(bw[j]); }
            cdp *= dA; }
        float* sp = ST + ((((size_t)(b * 64 + c) * 8 + hd) * 2 + dir) * 64 + p) * 64 + nq * 16;
#pragma unroll
        for (int j = 0; j < 4; ++j) ((f32x4*)sp)[j] = (f32x4){h[4 * j], h[4 * j + 1], h[4 * j + 2], h[4 * j + 3]};
        if (sub == 0) CD[((b * 64 + c) * 8 + hd) * 2 + dir] = cdp;
        __syncthreads();
    }
}
__device__ __forceinline__ void ssd_scan(const Args& a, int G) {
    float* ST = (float*)(lptr(a.ws) + WS_ST); const float* CD = (const float*)(lptr(a.ws) + WS_MISC + 65536);
    const int gt = lbid() * 512 + ltid(), NT = G * 512;
    for (int e = gt; e < 8 * 8 * 2 * 4096; e += NT) { const int pn = e & 4095, dir = (e >> 12) & 1, hd = (e >> 13) & 7, b = e >> 16;
        float H = 0.f;
#pragma unroll 8
        for (int cc = 0; cc < 64; ++cc) { const int c = dir ? 63 - cc : cc; const size_t idx = (((size_t)(b * 64 + c) * 8 + hd) * 2 + dir);
            const float tmp = ST[idx * 4096 + pn]; ST[idx * 4096 + pn] = H; H = H * CD[idx] + tmp; } }
}
__device__ __forceinline__ void ssd_passC(const Args& a, int l, LAS unsigned char* lds, int G) {
    const bf16_t* PROJ = (const bf16_t*)(lptr(a.ws) + WS_PROJ); const bf16_t* CONV = (const bf16_t*)(lptr(a.ws) + WS_CONV); bf16_t* MIXED = (bf16_t*)(lptr(a.ws) + WS_MIXED);
    const float* ST = (const float*)(lptr(a.ws) + WS_ST);
    const int tid = ltid(), sub = tid & 255, half = tid >> 8, p = sub >> 2, nq = sub & 3;
    LAS float* dts = (LAS float*)lds + half * 512; LAS float* dAs = dts + 256;
    LAS float* yl = (LAS float*)(lds + 8192) + half * 8192;
    for (int it = lbid(); it < 2048; it += G) {
        const int hp = it & 3, c = (it >> 2) & 63, b = it >> 8, hd = hp * 2 + half, g = hd >> 2;
        { const int dir = sub >> 7, s = sub & 127; const size_t row = (size_t)b * T_ + c * 128 + s;
          const float raw = bf2f(PROJ[row * NP + PDT + dir * 8 + hd]); const float dt = softplus_f(raw + gp(a.in[I_DTB])[(l * 2 + dir) * 8 + hd]);
          const float av = -expf(gp(a.in[I_ALOG])[(l * 2 + dir) * 8 + hd]); dts[dir * 128 + s] = dt; dAs[dir * 128 + s] = expf(dt * av); }
        __syncthreads();
#pragma unroll 1
        for (int dir = 0; dir < 2; ++dir) {
            float h[16];
            const float* sp = ST + ((((size_t)(b * 64 + c) * 8 + hd) * 2 + dir) * 64 + p) * 64 + nq * 16;
#pragma unroll
            for (int j = 0; j < 4; ++j) { const f32x4 v = ((const f32x4*)sp)[j]; h[4 * j] = v.x; h[4 * j + 1] = v.y; h[4 * j + 2] = v.z; h[4 * j + 3] = v.w; }
#pragma unroll 2
            for (int ss = 0; ss < 128; ++ss) { const int s = dir ? 127 - ss : ss; const size_t row = (size_t)b * T_ + c * 128 + s;
                const float dA = dAs[dir * 128 + s], dtv = dts[dir * 128 + s];
                const float xv = bf2f(CONV[row * 768 + hd * 64 + p]) * dtv;
                const u32x4* bp = (const u32x4*)(CONV + row * 768 + 512 + g * 64 + nq * 16); const u32x4 b0 = bp[0], b1 = bp[1];
                const u32x4* cp = (const u32x4*)(CONV + row * 768 + 640 + g * 64 + nq * 16); const u32x4 c0 = cp[0], c1 = cp[1];
                const unsigned bw[8] = {b0.x, b0.y, b0.z, b0.w, b1.x, b1.y, b1.z, b1.w}; const unsigned cw[8] = {c0.x, c0.y, c0.z, c0.w, c1.x, c1.y, c1.z, c1.w};
                float y = 0.f;
#pragma unroll
                for (int j = 0; j < 8; ++j) { h[2 * j] = h[2 * j] * dA + xv * bflo(bw[j]); h[2 * j + 1] = h[2 * j + 1] * dA + xv * bfhi(bw[j]);
                    y += h[2 * j] * bflo(cw[j]) + h[2 * j + 1] * bfhi(cw[j]); }
                y += __shfl_xor(y, 1); y += __shfl_xor(y, 2);
                if (nq == 0) { if (dir == 0) yl[s * 64 + p] = y; else yl[s * 64 + p] += y; } }
        }
        __syncthreads();
        const float dsk = gp(a.in[I_SSDD])[l * 8 + hd];
        for (int e = sub; e < 128 * 64; e += 256) { const int s = e >> 6, pp = e & 63; const size_t row = (size_t)b * T_ + c * 128 + s;
            const float xs = bf2f(CONV[row * 768 + hd * 64 + pp]), z = bf2f(PROJ[row * NP + PZ + hd * 64 + pp]);
            const float yv = (yl[e] + dsk * xs) * silu_f(z);
            MIXED[row * D_ + 256 + hd * 64 + pp] = (bf16_t)f2bf(yv); }
        __syncthreads();
    }
}
__device__ __forceinline__ void ssd_norm(const Args& a, int l, int G) {
    bf16_t* MIXED = (bf16_t*)(lptr(a.ws) + WS_MIXED); const float* nw = gp(a.in[I_SSDNW]) + l * 512;
    const int tid = ltid(), lane = tid & 63, gw = lbid() * 8 + (tid >> 6), NGW = G * 8;
    for (int m = gw; m < M_; m += NGW) { u32x4* p = (u32x4*)(MIXED + (size_t)m * D_ + 256) + lane; const u32x4 v = *p;
        float x[8] = {bflo(v.x), bfhi(v.x), bflo(v.y), bfhi(v.y), bflo(v.z), bfhi(v.z), bflo(v.w), bfhi(v.w)}; float s = 0.f;
#pragma unroll
        for (int e = 0; e < 8; ++e) s += x[e] * x[e];
        const float r = rsqrtf(wave_sum(s) * (1.f / 512.f) + LN_EPS); const f32x4 w0 = ((const f32x4*)nw)[2 * lane], w1 = ((const f32x4*)nw)[2 * lane + 1];
        u32x4 o; o.x = pk2(x[0] * r * w0.x, x[1] * r * w0.y); o.y = pk2(x[2] * r * w0.z, x[3] * r * w0.w); o.z = pk2(x[4] * r * w1.x, x[5] * r * w1.y); o.w = pk2(x[6] * r * w1.z, x[7] * r * w1.w);
        *p = o; }
}
__device__ __forceinline__ void s5_scan(const Args& a, int l, int G) {
    const int tid = ltid(); if (tid >= 64) return;
    const int p = tid; const bf16_t* S5S = (const bf16_t*)(lptr(a.ws) + WS_S5S); bf16_t* UX = (bf16_t*)(lptr(a.ws) + WS_UX);
    for (int it = lbid(); it < 256; it += G) { const int g = it & 15, b = (it >> 4) & 7, dir = it >> 7;
        const f32x2 A16 = ((const f32x2*)(lptr(a.ws) + WS_MISC))[((l * 2 + dir) * 16 + g) * 64 + p];
        float xr = 0.f, xi = 0.f;
#pragma unroll 1
        for (int cb = 0; cb < 512; cb += 16) { f32x2 s[16];
#pragma unroll
            for (int k = 0; k < 16; ++k) { const int cc = cb + k, c = dir ? 511 - cc : cc; const size_t row = (size_t)g * 4096 + b * 512 + c; const unsigned sv = *(const unsigned*)(S5S + row * 256 + dir * 128 + 2 * p); s[k] = (f32x2){bflo(sv), bfhi(sv)}; }
#pragma unroll
            for (int k = 0; k < 16; ++k) { const int cc = cb + k, c = dir ? 511 - cc : cc; const size_t row = (size_t)g * 4096 + b * 512 + c;
                *(unsigned*)(UX + row * 512 + 256 + dir * 128 + 2 * p) = pk2(xr, xi);
                const float nr = A16.x * xr - A16.y * xi + s[k].x, ni = A16.x * xi + A16.y * xr + s[k].y; xr = nr; xi = ni; } } }
}

#define MFMA16(A, B, C) __builtin_amdgcn_mfma_f32_16x16x32_bf16(A, B, C, 0, 0, 0)
constexpr int SSD_WAVE_LDS = 19456, SSD_XS = 66, SSD_MS = 72;
__device__ __forceinline__ bf16x8 ld_frag_strided(const LAS bf16_t* T, int LS, int s0, int x) {
    bf16x8 f;
#pragma unroll
    for (int j = 0; j < 8; ++j) f[j] = (short)T[(s0 + j) * LS + x];
    return f;
}
__device__ __forceinline__ void ssd_tables(const Args& a, int l, const bf16_t* PROJ, size_t row0, int hd, int dir, int lane, float& dt, float& cum, float& tot) {
    const float raw = bf2f(PROJ[(row0 + lane) * NP + PDT + dir * 8 + hd]);
    dt = softplus_f(raw + gp(a.in[I_DTB])[(l * 2 + dir) * 8 + hd]);
    const float av = -expf(gp(a.in[I_ALOG])[(l * 2 + dir) * 8 + hd]);
    const float e = dt * av; float ps = e;
#pragma unroll
    for (int o = 1; o < 64; o <<= 1) { const float t = __shfl_up(ps, o); if (lane >= o) ps += t; }
    tot = __shfl(ps, 63);
    cum = dir ? (tot - ps + e) : ps;
}
__device__ __forceinline__ void ssd_passA2(const Args& a, int l, LAS unsigned char* lds, int G) {
    const bf16_t* PROJ = (const bf16_t*)(lptr(a.ws) + WS_PROJ); const bf16_t* CONV = (const bf16_t*)(lptr(a.ws) + WS_CONV);
    bf16_t* ST = (bf16_t*)(lptr(a.ws) + WS_ST); float* CD = (float*)(lptr(a.ws) + WS_MISC + 65536);
    const int tid = ltid(), lane = tid & 63, wave = tid >> 6, fr = lane & 15, fq = lane >> 4, hd = wave, g4 = hd >> 2;
    LAS bf16_t* Xl = (LAS bf16_t*)(lds + wave * SSD_WAVE_LDS); LAS bf16_t* Bl = Xl + 64 * SSD_XS; LAS float* tab = (LAS float*)(lds + wave * SSD_WAVE_LDS + 17664);
    for (int it = lbid(); it < 8 * 128 * 2; it += G) { const int dir = it & 1, c = (it >> 1) & 127, b = it >> 8;
        const size_t row0 = (size_t)b * T_ + c * 64;
        u32x4 xv[8], bv[8];
#pragma unroll
        for (int i = 0; i < 8; ++i) { const int q = lane + 64 * i, s = q >> 3, pc = (q & 7) * 8;
            xv[i] = *(const u32x4*)(CONV + (row0 + s) * 768 + hd * 64 + pc); bv[i] = *(const u32x4*)(CONV + (row0 + s) * 768 + 512 + g4 * 64 + pc); }
        float dt, cum, tot; ssd_tables(a, l, PROJ, row0, hd, dir, lane, dt, cum, tot);
        tab[lane] = dt * __expf(tot - cum);
        LDS_WAIT();
#pragma unroll
        for (int i = 0; i < 8; ++i) { const int q = lane + 64 * i, s = q >> 3, pc = (q & 7) * 8; const float w = tab[s];
            const u32x4 v = xv[i]; LAS unsigned* d = (LAS unsigned*)(Xl + s * SSD_XS + pc);
            d[0] = pk2(bflo(v.x) * w, bfhi(v.x) * w); d[1] = pk2(bflo(v.y) * w, bfhi(v.y) * w); d[2] = pk2(bflo(v.z) * w, bfhi(v.z) * w); d[3] = pk2(bflo(v.w) * w, bfhi(v.w) * w);
            const u32x4 vb = bv[i]; LAS unsigned* db = (LAS unsigned*)(Bl + s * SSD_XS + pc);
            db[0] = vb.x; db[1] = vb.y; db[2] = vb.z; db[3] = vb.w; }
        LDS_WAIT();
        f32x4 acc[4][4];
#pragma unroll
        for (int mi = 0; mi < 4; ++mi)
#pragma unroll
            for (int nj = 0; nj < 4; ++nj) acc[mi][nj] = (f32x4){0.f, 0.f, 0.f, 0.f};
#pragma unroll
        for (int ks = 0; ks < 2; ++ks) { bf16x8 af[4], bg[4];
#pragma unroll
            for (int mi = 0; mi < 4; ++mi) af[mi] = ld_frag_strided(Bl, SSD_XS, 32 * ks + 8 * fq, 16 * mi + fr);
#pragma unroll
            for (int nj = 0; nj < 4; ++nj) bg[nj] = ld_frag_strided(Xl, SSD_XS, 32 * ks + 8 * fq, 16 * nj + fr);
#pragma unroll
            for (int mi = 0; mi < 4; ++mi)
#pragma unroll
                for (int nj = 0; nj < 4; ++nj) acc[mi][nj] = MFMA16(af[mi], bg[nj], acc[mi][nj]); }
        const size_t idx = ((size_t)(b * 128 + c) * 8 + hd) * 2 + dir; bf16_t* sp = ST + idx * 4096;
#pragma unroll
        for (int mi = 0; mi < 4; ++mi)
#pragma unroll
            for (int nj = 0; nj < 4; ++nj) { u32x2 w; w.x = pk2(acc[mi][nj][0], acc[mi][nj][1]); w.y = pk2(acc[mi][nj][2], acc[mi][nj][3]); *(u32x2*)(sp + (16 * nj + fr) * 64 + 16 * mi + 4 * fq) = w; }
        if (lane == 0) CD[idx] = __expf(tot);
        LDS_WAIT();
    }
}
__device__ __forceinline__ void ssd_scan2(const Args& a, int G) {
    unsigned* ST32 = (unsigned*)(lptr(a.ws) + WS_ST); const float* CD = (const float*)(lptr(a.ws) + WS_MISC + 65536);
    const int gt = lbid() * 512 + ltid(), NT = G * 512;
    for (int e = gt; e < 8 * 8 * 2 * 2048; e += NT) { const int pn2 = e & 2047, dir = (e >> 11) & 1, hd = (e >> 12) & 7, b = e >> 15;
        float H0 = 0.f, H1 = 0.f;
#pragma unroll 1
        for (int cb = 0; cb < 128; cb += 16) { unsigned v[16]; float cd[16];
#pragma unroll
            for (int k = 0; k < 16; ++k) { const int cc = cb + k, c = dir ? 127 - cc : cc; const size_t idx = ((size_t)(b * 128 + c) * 8 + hd) * 2 + dir; v[k] = ST32[idx * 2048 + pn2]; cd[k] = CD[idx]; }
#pragma unroll
            for (int k = 0; k < 16; ++k) { const int cc = cb + k, c = dir ? 127 - cc : cc; const size_t idx = ((size_t)(b * 128 + c) * 8 + hd) * 2 + dir;
                ST32[idx * 2048 + pn2] = pk2(H0, H1); H0 = H0 * cd[k] + bflo(v[k]); H1 = H1 * cd[k] + bfhi(v[k]); } } }
}
__device__ __forceinline__ void ssd_passC2(const Args& a, int l, LAS unsigned char* lds, int G) {
    const bf16_t* PROJ = (const bf16_t*)(lptr(a.ws) + WS_PROJ); const bf16_t* CONV = (const bf16_t*)(lptr(a.ws) + WS_CONV); bf16_t* MIXED = (bf16_t*)(lptr(a.ws) + WS_MIXED);
    const bf16_t* ST = (const bf16_t*)(lptr(a.ws) + WS_ST);
    const int tid = ltid(), lane = tid & 63, wave = tid >> 6, hd = wave, g4 = hd >> 2;
    LAS bf16_t* Xl = (LAS bf16_t*)(lds + wave * SSD_WAVE_LDS); LAS bf16_t* Ml = (LAS bf16_t*)(lds + wave * SSD_WAVE_LDS + 8448); LAS float* tab = (LAS float*)(lds + wave * SSD_WAVE_LDS + 17664);
    LAS float* ssq = (LAS float*)(lds + 8 * SSD_WAVE_LDS);
    const float dsk = gp(a.in[I_SSDD])[l * 8 + hd];
    for (int it = lbid(); it < 8 * 128; it += G) { const int c = it & 127, b = it >> 7;
        const size_t row0 = (size_t)b * T_ + c * 64;
        f32x4 Y[4][4];
#pragma unroll
        for (int mi = 0; mi < 4; ++mi)
#pragma unroll
            for (int nj = 0; nj < 4; ++nj) Y[mi][nj] = (f32x4){0.f, 0.f, 0.f, 0.f};
        bf16x8 cfr[4][2];
        { int ln_ = lane; asm volatile("" : "+v"(ln_)); const int fr = ln_ & 15, fq = ln_ >> 4;
          u32x4 xv[8]; bf16x8 h0[4][2], h1[4][2];
#pragma unroll
          for (int i = 0; i < 8; ++i) { const int q = ln_ + 64 * i, s = q >> 3, pc = (q & 7) * 8; xv[i] = *(const u32x4*)(CONV + (row0 + s) * 768 + hd * 64 + pc); }
          const bf16_t* hp = ST + (((size_t)(b * 128 + c) * 8 + hd) * 2) * 4096;
#pragma unroll
          for (int t4 = 0; t4 < 4; ++t4) { const bf16_t* cp = CONV + (row0 + 16 * t4 + fr) * 768 + 640 + g4 * 64 + 8 * fq; cfr[t4][0] = *(const bf16x8*)cp; cfr[t4][1] = *(const bf16x8*)(cp + 32);
              const bf16_t* ap = hp + (16 * t4 + fr) * 64 + 8 * fq; h0[t4][0] = *(const bf16x8*)ap; h0[t4][1] = *(const bf16x8*)(ap + 32); h1[t4][0] = *(const bf16x8*)(ap + 4096); h1[t4][1] = *(const bf16x8*)(ap + 4096 + 32); }
          { float dt, cum, tot; ssd_tables(a, l, PROJ, row0, hd, 0, lane, dt, cum, tot); tab[lane] = dt; tab[64 + lane] = cum;
            ssd_tables(a, l, PROJ, row0, hd, 1, lane, dt, cum, tot); tab[128 + lane] = dt; tab[192 + lane] = cum; }
#pragma unroll
          for (int i = 0; i < 8; ++i) { const int q = ln_ + 64 * i, s = q >> 3, pc = (q & 7) * 8; LAS unsigned* d = (LAS unsigned*)(Xl + s * SSD_XS + pc);
              d[0] = xv[i].x; d[1] = xv[i].y; d[2] = xv[i].z; d[3] = xv[i].w; }
          LDS_WAIT();
#pragma unroll
          for (int nj = 0; nj < 4; ++nj) { const float sc0 = __expf(tab[64 + 16 * nj + fr]), sc1 = __expf(tab[192 + 16 * nj + fr]);
#pragma unroll
              for (int mi = 0; mi < 4; ++mi) { f32x4 t = MFMA16(h0[mi][0], cfr[nj][0], ((f32x4){0.f, 0.f, 0.f, 0.f})); t = MFMA16(h0[mi][1], cfr[nj][1], t);
                  f32x4 u = MFMA16(h1[mi][0], cfr[nj][0], ((f32x4){0.f, 0.f, 0.f, 0.f})); u = MFMA16(h1[mi][1], cfr[nj][1], u);
                  Y[mi][nj] += t * sc0 + u * sc1; } } }
        f32x4 Gt[4][4];
#pragma unroll
        for (int mi = 0; mi < 4; ++mi)
#pragma unroll
            for (int nj = 0; nj < 4; ++nj) Gt[mi][nj] = (f32x4){0.f, 0.f, 0.f, 0.f};
        { int ln_ = lane; asm volatile("" : "+v"(ln_)); const int fr = ln_ & 15, fq = ln_ >> 4;
          bf16x8 bfr[4][2];
#pragma unroll
          for (int mi = 0; mi < 4; ++mi) { const bf16_t* bp = CONV + (row0 + 16 * mi + fr) * 768 + 512 + g4 * 64 + 8 * fq; bfr[mi][0] = *(const bf16x8*)bp; bfr[mi][1] = *(const bf16x8*)(bp + 32); }
#pragma unroll
          for (int ks = 0; ks < 2; ++ks)
#pragma unroll
            for (int mi = 0; mi < 4; ++mi)
#pragma unroll
                for (int nj = 0; nj < 4; ++nj) Gt[mi][nj] = MFMA16(bfr[mi][ks], cfr[nj][ks], Gt[mi][nj]); }
        u32x2 ez[4][4];
#pragma unroll
        for (int dir = 0; dir < 2; ++dir) { int ln_ = lane; asm volatile("" : "+v"(ln_)); const int fr = ln_ & 15, fq = ln_ >> 4;
            if (dir == 1) {
#pragma unroll
                for (int nj = 0; nj < 4; ++nj) { const size_t row = row0 + 16 * nj + fr;
#pragma unroll
                    for (int mi = 0; mi < 4; ++mi) { const int p0 = 16 * mi + 4 * fq; ez[mi][nj] = *(const u32x2*)(PROJ + row * NP + PZ + hd * 64 + p0); } } }
#pragma unroll
            for (int nj = 0; nj < 4; ++nj) { const int lq = 16 * nj + fr; const float cl = tab[dir * 128 + 64 + lq];
#pragma unroll
                for (int mi = 0; mi < 4; ++mi) { const f32x4 cs = *(const LAS f32x4*)(tab + dir * 128 + 64 + 16 * mi + 4 * fq), ds = *(const LAS f32x4*)(tab + dir * 128 + 16 * mi + 4 * fq);
                    float v[4];
#pragma unroll
                    for (int r = 0; r < 4; ++r) { const int s = 16 * mi + 4 * fq + r; const bool valid = dir ? (s >= lq) : (s <= lq);
                        v[r] = valid ? Gt[mi][nj][r] * __expf(cl - cs[r]) * ds[r] : 0.f; }
                    u32x2 w; w.x = pk2(v[0], v[1]); w.y = pk2(v[2], v[3]); *(LAS u32x2*)(Ml + lq * SSD_MS + 16 * mi + 4 * fq) = w; } }
            asm volatile("s_waitcnt lgkmcnt(0)" ::: );
#pragma unroll
            for (int ks = 0; ks < 2; ++ks) { bf16x8 af[4], bg[4];
#pragma unroll
                for (int mi = 0; mi < 4; ++mi) af[mi] = ld_frag_strided(Xl, SSD_XS, 32 * ks + 8 * fq, 16 * mi + fr);
#pragma unroll
                for (int nj = 0; nj < 4; ++nj) bg[nj] = *(const LAS bf16x8*)(Ml + (16 * nj + fr) * SSD_MS + 32 * ks + 8 * fq);
#pragma unroll
                for (int mi = 0; mi < 4; ++mi)
#pragma unroll
                    for (int nj = 0; nj < 4; ++nj) Y[mi][nj] = MFMA16(af[mi], bg[nj], Y[mi][nj]); }
            asm volatile("s_waitcnt lgkmcnt(0)" ::: );
        }
        float part[4];
        { int ln_ = lane; asm volatile("" : "+v"(ln_)); const int fr = ln_ & 15, fq = ln_ >> 4;
#pragma unroll
        for (int nj = 0; nj < 4; ++nj) { float ps = 0.f;
#pragma unroll
            for (int mi = 0; mi < 4; ++mi) { const LAS unsigned* xp = (const LAS unsigned*)(Xl + (16 * nj + fr) * SSD_XS + 16 * mi + 4 * fq); u32x2 xs; xs.x = xp[0]; xs.y = xp[1]; const u32x2 zz = ez[mi][nj];
                f32x4 y = Y[mi][nj];
                y[0] = (y[0] + dsk * bflo(xs.x)) * silu_f(bflo(zz.x)); y[1] = (y[1] + dsk * bfhi(xs.x)) * silu_f(bfhi(zz.x));
                y[2] = (y[2] + dsk * bflo(xs.y)) * silu_f(bflo(zz.y)); y[3] = (y[3] + dsk * bfhi(xs.y)) * silu_f(bfhi(zz.y));
                Y[mi][nj] = y; ps += (y[0] * y[0] + y[1] * y[1]) + (y[2] * y[2] + y[3] * y[3]); }
            ps += __shfl_xor(ps, 16); ps += __shfl_xor(ps, 32); part[nj] = ps; }
        if (fq == 0) {
#pragma unroll
            for (int nj = 0; nj < 4; ++nj) ssq[wave * 64 + 16 * nj + fr] = part[nj]; } }
        __syncthreads();
        const float* nw = gp(a.in[I_SSDNW]) + l * 512 + hd * 64;
        { int ln_ = lane; asm volatile("" : "+v"(ln_)); const int fr = ln_ & 15, fq = ln_ >> 4;
#pragma unroll
        for (int nj = 0; nj < 4; ++nj) { const int lq = 16 * nj + fr; float tot = 0.f;
#pragma unroll
            for (int w = 0; w < 8; ++w) tot += ssq[w * 64 + lq];
            const float rs = rsqrtf(tot * (1.f / 512.f) + LN_EPS); const size_t row = row0 + lq;
#pragma unroll
            for (int mi = 0; mi < 4; ++mi) { const int p0 = 16 * mi + 4 * fq; const f32x4 wv = *(const f32x4*)(nw + p0); const f32x4 y = Y[mi][nj];
                u32x2 w; w.x = pk2(y[0] * rs * wv[0], y[1] * rs * wv[1]); w.y = pk2(y[2] * rs * wv[2], y[3] * rs * wv[3]);
                *(u32x2*)(MIXED + row * D_ + 256 + hd * 64 + p0) = w; } } }
        __syncthreads();
    }
}

__device__ __forceinline__ void na_phase2(const bf16_t* PROJ, bf16_t* MIXED, const float* rpb, LAS unsigned char* lds, int G) {
    const int tid = ltid(), lane = tid & 63, wave = __builtin_amdgcn_readfirstlane(tid >> 6), j = wave & 3;
    LAS bf16_t* Vl = (LAS bf16_t*)(lds + wave * SSD_WAVE_LDS);
    LAS float* rpl = (LAS float*)(lds + wave * SSD_WAVE_LDS + 8448);
    const int t_lo = j < 2 ? 0 : j - 1, t_hi = j == 0 ? 1 : (j == 3 ? 3 : j + 1);
    const bool pr0 = t_lo <= 1, pr1 = t_hi >= 2;
    const int fr = lane & 15, fq = lane >> 4;
    int bix[4][4];
    { const int c = 16 * j + fr, c0 = min(max(c - 8, 0), 48);
#pragma unroll
      for (int kt = 0; kt < 4; ++kt)
#pragma unroll
          for (int e = 0; e < 4; ++e) { const int kc = 16 * kt + 4 * fq + e; bix[kt][e] = (kc >= c0 && kc < c0 + 16) ? min(max(kc - c, -15), 15) + 15 : -1; } }
    unsigned koff[4], voff[8];
#pragma unroll
    for (int kt = 0; kt < 4; ++kt) koff[kt] = (unsigned)((16 * kt + fr) * NP + PK + 8 * fq) * 2u;
#pragma unroll
    for (int i = 0; i < 8; ++i) { const int q = lane + 64 * i; voff[i] = (unsigned)((q >> 3) * NP + PV + (q & 7) * 8) * 2u; }
    constexpr float L2E = 1.44269504089f;
    const int per_ = (8 * 128 * 2 + G - 1) / G, it0_ = lbid() * per_, it1_ = min(it0_ + per_, 8 * 128 * 2);
    for (int it = it0_; it < it1_; ++it) {
        const int r = it & 127, hp = (it >> 7) & 1, b = it >> 8, h = hp * 2 + (wave >> 2);
        const int r0 = min(max(r - 4, 0), 120);
        const size_t rowq0 = (size_t)b * T_ + r * 64;
        { const float* rph = rpb + h * 15 * 31;
#pragma unroll
          for (int i = 0; i < 8; ++i) { const int e = lane + 64 * i; if (e < 465) rpl[e] = rph[e] * L2E; } }
        bf16x8 qf[2];
        { const bf16_t* qp = PROJ + (rowq0 + 16 * j + fr) * NP + PQ + h * 64 + 8 * fq; qf[0] = *(const bf16x8*)qp; qf[1] = *(const bf16x8*)(qp + 32); }
        f32x4 O[4];
#pragma unroll
        for (int mi = 0; mi < 4; ++mi) O[mi] = (f32x4){0.f, 0.f, 0.f, 0.f};
        float mx = -1e30f, lsum = 0.f;
        bf16x8 kn[4][2]; u32x4 vn[8];
        const char* kbase = (const char*)(PROJ + ((size_t)b * T_ + r0 * 64) * NP + h * 64);
#pragma unroll
        for (int kt = 0; kt < 4; ++kt) if (kt >= t_lo && kt <= t_hi) { kn[kt][0] = *(const bf16x8*)(kbase + koff[kt]); kn[kt][1] = *(const bf16x8*)(kbase + koff[kt] + 64); }
#pragma unroll
        for (int i = 0; i < 8; ++i) if (i < 4 ? pr0 : pr1) vn[i] = *(const u32x4*)(kbase + voff[i]);
#pragma unroll 1
        for (int kr = 0; kr < 8; ++kr) {
            const int krow = r0 + kr;
            int ln_ = lane; asm volatile("" : "+v"(ln_)); const int fr = ln_ & 15, fq = ln_ >> 4;
#pragma unroll
            for (int i = 0; i < 8; ++i) if (i < 4 ? pr0 : pr1) { const int q = ln_ + 64 * i, key = q >> 3, dc = (q & 7) * 8; LAS unsigned* d = (LAS unsigned*)(Vl + key * SSD_XS + dc);
                d[0] = vn[i].x; d[1] = vn[i].y; d[2] = vn[i].z; d[3] = vn[i].w; }
            f32x4 S[4];
            const LAS float* rpr = rpl + (krow - r + 7) * 31;
#pragma unroll
            for (int kt = 0; kt < 4; ++kt) if (kt >= t_lo && kt <= t_hi) { f32x4 t = MFMA16(kn[kt][0], qf[0], ((f32x4){0.f, 0.f, 0.f, 0.f})); S[kt] = MFMA16(kn[kt][1], qf[1], t); }
            kbase += (size_t)64 * NP * 2;
            if (kr < 7) {
#pragma unroll
                for (int kt = 0; kt < 4; ++kt) if (kt >= t_lo && kt <= t_hi) { kn[kt][0] = *(const bf16x8*)(kbase + koff[kt]); kn[kt][1] = *(const bf16x8*)(kbase + koff[kt] + 64); }
#pragma unroll
                for (int i = 0; i < 8; ++i) if (i < 4 ? pr0 : pr1) vn[i] = *(const u32x4*)(kbase + voff[i]); }
            float gm = -1e30f;
#pragma unroll
            for (int kt = 0; kt < 4; ++kt) {
                if (kt >= t_lo && kt <= t_hi) { f32x4 t = S[kt];
#pragma unroll
                    for (int e = 0; e < 4; ++e) { const int bi = bix[kt][e]; const float s = bi >= 0 ? t[e] * (0.125f * L2E) + rpr[bi] : -1e30f; t[e] = s; gm = fmaxf(gm, s); }
                    S[kt] = t; }
                else S[kt] = (f32x4){-1e30f, -1e30f, -1e30f, -1e30f}; }
            gm = fmaxf(gm, __shfl_xor(gm, 16)); gm = fmaxf(gm, __shfl_xor(gm, 32));
            const float mnew = fmaxf(mx, gm), al = __builtin_amdgcn_exp2f(mx - mnew); mx = mnew; lsum *= al;
#pragma unroll
            for (int mi = 0; mi < 4; ++mi) O[mi] = O[mi] * al;
#pragma unroll
            for (int kt = 0; kt < 4; ++kt) {
                if (kt >= t_lo && kt <= t_hi) {
#pragma unroll
                    for (int e = 0; e < 4; ++e) { const float p = __builtin_amdgcn_exp2f(S[kt][e] - mnew); S[kt][e] = p; lsum += p; } }
                else S[kt] = (f32x4){0.f, 0.f, 0.f, 0.f}; }
#pragma unroll
            for (int pr = 0; pr < 2; ++pr) if (pr == 0 ? pr0 : pr1) {
                const unsigned w0 = pk2hw(S[2 * pr][0], S[2 * pr][1]), w1 = pk2hw(S[2 * pr][2], S[2 * pr][3]), w2 = pk2hw(S[2 * pr + 1][0], S[2 * pr + 1][1]), w3 = pk2hw(S[2 * pr + 1][2], S[2 * pr + 1][3]);
                const u32x4 w = {w0, w1, w2, w3}; const bf16x8 pf = __builtin_bit_cast(bf16x8, w);
#pragma unroll
                for (int mi = 0; mi < 4; ++mi) { bf16x8 af;
#pragma unroll
                    for (int jj = 0; jj < 4; ++jj) { af[jj] = (short)Vl[(32 * pr + 4 * fq + jj) * SSD_XS + 16 * mi + fr]; af[4 + jj] = (short)Vl[(32 * pr + 16 + 4 * fq + jj) * SSD_XS + 16 * mi + fr]; }
                    O[mi] = MFMA16(af, pf, O[mi]); } }
        }
        { lsum += __shfl_xor(lsum, 16); lsum += __shfl_xor(lsum, 32); const float inv = 1.f / lsum;
          bf16_t* op = MIXED + (rowq0 + 16 * j + fr) * D_ + h * 64 + 4 * fq;
#pragma unroll
          for (int mi = 0; mi < 4; ++mi) { u32x2 w; w.x = pk2hw(O[mi][0] * inv, O[mi][1] * inv); w.y = pk2hw(O[mi][2] * inv, O[mi][3] * inv); *(u32x2*)(op + 16 * mi) = w; } }
    }
}
__device__ __forceinline__ void ln_phase(const Args& a, const float* gam, const float* bet, int G) {
    const int tid = ltid(), lane = tid & 63, gw = lbid() * 8 + (tid >> 6), NGW = G * 8;
    float* H = lptr(a.out); bf16_t* HB = (bf16_t*)(lptr(a.ws) + WS_HB);
    for (int m = gw; m < M_ / 2; m += NGW) { const size_t r0 = (size_t)m * D_, r1 = (size_t)(m + M_ / 2) * D_;
        ln_row2(H + r0, H + r1, H + r0, H + r1, (bf16_t*)nullptr, (bf16_t*)nullptr, gam, bet, lane); }
}
__device__ __forceinline__ void xsoftmax_phase(const Args& a, int G) {
    const float* S = (const float*)(lptr(a.ws) + WS_S); bf16_t* P = (bf16_t*)(lptr(a.ws) + WS_QB);
    const int tid = ltid(), lane = tid & 63, gw = lbid() * 8 + (tid >> 6), NGW = G * 8;
    for (int m = gw; m < M_; m += NGW) {
#pragma unroll
        for (int j = 0; j < 4; ++j) { const f32x4 v = ((const f32x4*)(S + (size_t)m * D_ + j * 256))[lane];
            const float mx = wave_max(fmaxf(fmaxf(v.x, v.y), fmaxf(v.z, v.w)));
            const float e0 = __expf(v.x - mx), e1 = __expf(v.y - mx), e2 = __expf(v.z - mx), e3 = __expf(v.w - mx);
            const float inv = 1.f / wave_sum((e0 + e1) + (e2 + e3));
            u32x2 w; w.x = pk2(e0 * inv, e1 * inv); w.y = pk2(e2 * inv, e3 * inv); ((u32x2*)(P + (size_t)m * D_ + j * 256))[lane] = w; } }
}

#define XB_TMO      128
#define XB_XCNT(j)  (256  + 64 * (j))
#define XB_XSUB(j)  (1280 + 64 * (j))
#define XB_XGEN(j)  (2304 + 64 * (j))
#define XB_TOP      3328
#define XB_TOPGEN   3392
#define XCD_BAR_WORDS 3456
#define XB_SPIN_CAP (1u << 18)

__device__ __forceinline__ unsigned xb_ld(unsigned* p)              { return __hip_atomic_load(p, __ATOMIC_RELAXED, __HIP_MEMORY_SCOPE_AGENT); }
__device__ __forceinline__ unsigned xb_add(unsigned* p, unsigned v) { return __hip_atomic_fetch_add(p, v, __ATOMIC_RELAXED, __HIP_MEMORY_SCOPE_AGENT); }
__device__ __forceinline__ unsigned xb_xcc_id() { return (unsigned)__builtin_amdgcn_s_getreg((3 << 11) | 20) & 0xFu; }
#define XB_SPIN(cond, bar) do { unsigned _sp = 0; while (cond) { __builtin_amdgcn_s_sleep(1); \
    if ((++_sp & 255u) == 0u) { if (xb_ld(&(bar)[XB_TMO])) break; if (_sp > XB_SPIN_CAP) { atomicAdd(&(bar)[XB_TMO], 1u); break; } } } } while (0)

struct XcdBarrier {
    unsigned* bar; unsigned x;
    volatile LAS unsigned* st;
};

__device__ __forceinline__ XcdBarrier xcd_barrier_post(unsigned* bar, volatile LAS unsigned* st) {
    XcdBarrier b; b.bar = bar; b.x = xb_xcc_id(); b.st = st;
    if (threadIdx.x == 0) (void)xb_add(&bar[XB_XCNT(b.x)], 1u);
    return b;
}
__device__ __forceinline__ void xcd_barrier_complete(unsigned* bar, unsigned x, unsigned& nloc, unsigned& nx) {
    const unsigned G = gridDim.x * gridDim.y * gridDim.z;
    unsigned sum, cnt, mine, sp = 0u;
    for (;;) {
        sum = 0u; cnt = 0u; mine = 0u;
#pragma unroll
        for (unsigned j = 0; j < 16; ++j) { const unsigned c = xb_ld(&bar[XB_XCNT(j)]); sum += c; cnt += (c > 0u) ? 1u : 0u; mine = (j == x) ? c : mine; }
        if (sum == G) break;
        __builtin_amdgcn_s_sleep(1);
        if ((++sp & 255u) == 0u) { if (xb_ld(&bar[XB_TMO])) break; if (sp > XB_SPIN_CAP) { atomicAdd(&bar[XB_TMO], 1u); break; } }
    }
    nloc = mine > 0u ? mine : 1u; nx = cnt > 0u ? cnt : 1u;
}

__device__ __forceinline__ void xcd_barrier(const XcdBarrier& b) {
    asm volatile("s_waitcnt vmcnt(0)" ::: "memory");
    __syncthreads();
    if (threadIdx.x == 0) {
        unsigned* bar = b.bar;
        __builtin_amdgcn_s_waitcnt(0);
        unsigned nloc = b.st[0], nx = b.st[1];
        if (nloc == 0u) { xcd_barrier_complete(bar, b.x, nloc, nx); b.st[0] = nloc; b.st[1] = nx; }
        const unsigned old = xb_add(&bar[XB_XSUB(b.x)], 1u);
        const unsigned gen = old / nloc;
        if (old + 1u == (gen + 1u) * nloc) {
            __builtin_amdgcn_fence(__ATOMIC_RELEASE, "agent");
            asm volatile("s_waitcnt vmcnt(0)" ::: "memory");
            const unsigned og = xb_add(&bar[XB_TOP], 1u);
            const unsigned tg = og / nx;
            if (og + 1u == (tg + 1u) * nx) xb_add(&bar[XB_TOPGEN], 1u);
            else XB_SPIN(xb_ld(&bar[XB_TOPGEN]) == tg, bar);
            __builtin_amdgcn_fence(__ATOMIC_ACQUIRE, "agent");
            xb_add(&bar[XB_XGEN(b.x)], 1u);
            asm volatile("s_waitcnt vmcnt(0)" ::: "memory");
        } else {
            XB_SPIN(xb_ld(&bar[XB_XGEN(b.x)]) == gen, bar);
            __builtin_amdgcn_fence(__ATOMIC_ACQUIRE, "agent");
            asm volatile("s_waitcnt vmcnt(0)" ::: "memory");
        }
    }
    __syncthreads();
}

__device__ __forceinline__ const LAS float* stage_gb(LAS unsigned char* lds, const float* gam, const float* bet) {
    LAS float* gl = (LAS float*)(lds + 139264); const int t = ltid();
    *(LAS f32x4*)(gl + 4 * t) = (t < 256) ? ((const f32x4*)gam)[t] : ((const f32x4*)bet)[t - 256];
    __syncthreads(); return gl;
}
#ifndef ONLY_S
#define ONLY_S -1
#endif
#define PHX(x) (ONLY_S == -1 || ONLY_S == (x))
__global__ void __launch_bounds__(512, 2) fwd(Args a) {
    extern __shared__ __attribute__((aligned(16))) unsigned char lds_raw[];
    LAS unsigned char* lds = (LAS unsigned char*)lds_raw;
    volatile LAS unsigned* bst = (volatile LAS unsigned*)(lds + 157696);
    if (threadIdx.x < 16) bst[threadIdx.x] = 0u;
    __syncthreads();
    XcdBarrier xbar; xbar.bar = (unsigned*)(a.ws + 4096); xbar.x = 0; xbar.st = bst;
    if (a.coop) xbar = xcd_barrier_post((unsigned*)(a.ws + 4096), bst);
    for (int ph = a.ph_lo; ph < a.ph_hi; ++ph) {
    int G = gridDim.x; asm volatile("" : "+s"(G)); const int bx = lbid();
    bf16_t* HB = (bf16_t*)(lptr(a.ws) + WS_HB); bf16_t* PROJ = (bf16_t*)(lptr(a.ws) + WS_PROJ); bf16_t* MIXED = (bf16_t*)(lptr(a.ws) + WS_MIXED); bf16_t* CONV = (bf16_t*)(lptr(a.ws) + WS_CONV);
    bf16_t* UX = (bf16_t*)(lptr(a.ws) + WS_UX); bf16_t* MEMB = (bf16_t*)(lptr(a.ws) + WS_MEMB); bf16_t* KM = (bf16_t*)(lptr(a.ws) + WS_KM); bf16_t* VMT = (bf16_t*)(lptr(a.ws) + WS_VMT);
    bf16_t* QB = (bf16_t*)(lptr(a.ws) + WS_QB); bf16_t* OB = (bf16_t*)(lptr(a.ws) + WS_OB); bf16_t* HID = (bf16_t*)(lptr(a.ws) + WS_HID);
    float* SL0 = (float*)(lptr(a.ws) + WS_SL); float* SL1 = SL0 + (size_t)M_ * 8;
        if (ph == 0) { if (PHX(100)) prologue(a, lds, G); }
        else {
            const int l = (ph - 1) / 17, s = (ph - 1) % 17;
            unsigned char* wb = lptr(a.ws) + WS_W + (size_t)l * LWB;
            pg8::Sched S;
            if (s == 0 && PHX(0)) {
                if (l == 0) {
                    { pg8::Gemm g{MEMB, (const bf16_t*)(lptr(a.ws) + WS_W + OW_K), D_, D_, D_, 0, 0, LWB / 2, 0}; S.init(8, 4, 2, 1, G, bx);
                      pg8::EpiStore<0> E{KM, D_, (size_t)B_ * MEMT * D_, 0, 1 << 30, 1.f}; pg8::gemm_phase(lds, g, S, E); }
                    { pg8::Gemm g{(const bf16_t*)(lptr(a.ws) + WS_W + OW_V), MEMB, D_, D_, D_, LWB / 2, 0, 0, (size_t)MEMT * D_}; S.init(4, 1, 2, 8, G, (bx + G / 2) % G);
                      pg8::EpiStore<0> E{VMT, MEMT, (size_t)B_ * D_ * MEMT, (size_t)D_ * MEMT, 1 << 30, 1.f}; pg8::gemm_phase(lds, g, S, E); }
                }
                pg8::Gemm g{HB, (const bf16_t*)(wb + OW_IN), D_, D_, D_, 0, 0, 0, 0}; S.init(M_ / 256, NPP / 256, 1, 1, G, bx);
                if (l == 0) { pg8::EpiStore<0> E{PROJ, NP, 0, 0, NP, 1.f}; pg8::gemm_phase(lds, g, S, E); }
                else { float* cs = cs_ptr(lptr(a.ws), 1, 2); pg8::EpiStoreLN<0> E{PROJ, NP, NP, 1.f, SL0  , cs, cs + NPP}; pg8::gemm_phase(lds, g, S, E); }
            } else if (s == 1 && PHX(1)) {
                if (l == 0) colsum_phase(a, G);
                na_phase2(PROJ, MIXED, gp(a.in[I_RPB]) + l * 4 * 15 * 31, lds, G);
#ifndef NO_CONV
                conv_phase(PROJ, CONV, gp(a.in[I_CONVW]) + l * 5 * 768, gp(a.in[I_CONVB]) + l * 768, G);
#endif
                s5_gather_phase(PROJ, UX, G);
            } else if (s == 2 && PHX(2)) {
                ssd_passA2(a, l, lds, G);
                __syncthreads();
                pg8::Gemm g{UX, (const bf16_t*)(lptr(a.ws) + WS_SM) + (size_t)l * 16 * 256 * 256, 512, 256, 256, (size_t)4096 * 512, 0, (size_t)256 * 256, 0}; S.init(16, 1, 16, 1, G, bx);
                pg8::EpiStore<0> E{(bf16_t*)(lptr(a.ws) + WS_S5S), 256, (size_t)4096 * 256, 0, 1 << 30, 1.f}; pg8::gemm_phase(lds, g, S, E);
            } else if (s == 3 && PHX(3)) {
                ssd_scan2(a, G);
                s5_scan(a, l, G);
            } else if (s == 4 && PHX(4)) {
#ifndef NO_PC
                ssd_passC2(a, l, lds, G);
#endif
                pg8::Gemm g{UX, (const bf16_t*)(lptr(a.ws) + WS_TM) + (size_t)l * 16 * 256 * 512, 512, 512, 512, (size_t)4096 * 512, 0, (size_t)256 * 512, 0}; S.init(16, 1, 16, 1, G, bx);
#ifndef NO_G4
                pg8::EpiS5Y E{MIXED}; pg8::gemm_phase(lds, g, S, E);
#endif
            } else if (s == 5 && PHX(5)) {
                pg8::Gemm g{MIXED + 768, (const bf16_t*)(wb + OW_GLU), D_, 256, 256, 0, 0, 0, 0}; S.init(M_ / 256, 1, 1, 1, G, bx);
                pg8::EpiGLU E{MIXED, gp(a.in[I_GLUB]) + l * 256}; pg8::gemm_phase(lds, g, S, E);
            } else if (s == 6 && PHX(6)) {
                pg8::Gemm g{MIXED, (const bf16_t*)(wb + OW_OUT), D_, D_, D_, 0, 0, 0, 0}; S.init(M_ / 256, 4, 1, 1, G, bx);
                if (l == 0) { pg8::EpiResidLN<true, false> E{lptr(a.out), HB, SL1, SL0, nullptr, nullptr, (LAS float*)(lds + 131072), ALPHA}; pg8::gemm_phase(lds, g, S, E); }
                else { const LAS float* gl = stage_gb(lds, gp(a.in[I_LNMLP_G]), gp(a.in[I_LNMLP_B])); pg8::EpiResidLN<false, false> E{lptr(a.out), HB, SL0, SL1, gl, nullptr, (LAS float*)(lds + 131072), ALPHA}; pg8::gemm_phase(lds, g, S, E); }
            } else if (s == 7 && PHX(7)) {
            } else if (s == 8 && PHX(8)) {
                pg8::Gemm g{HB, (const bf16_t*)(wb + OW_Q), D_, D_, D_, 0, 0, 0, 0}; S.init(M_ / 256, 4, 1, 1, G, bx);
                float* cs = cs_ptr(lptr(a.ws), l, 0); pg8::EpiStoreLN<0> E{QB, D_, 1 << 30, 0.0625f, l == 0 ? SL0 : SL1, cs, cs + D_}; pg8::gemm_phase(lds, g, S, E);
            } else if (s == 9 && PHX(9)) {
                pg8::Gemm g{QB, KM + (size_t)l * B_ * MEMT * D_, D_, D_, 256, (size_t)T_ * D_, 256, (size_t)MEMT * D_, 256}; S.init(T_ / 256, 1, 8, 4, G, bx);
                pg8::EpiSoftmax E{(bf16_t*)(lptr(a.ws) + WS_S), D_, (size_t)T_ * D_, 256, (LAS float*)(lds + 131072)}; pg8::gemm_phase(lds, g, S, E);
                __builtin_amdgcn_fence(__ATOMIC_ACQUIRE, "agent"); asm volatile("s_waitcnt vmcnt(0)" ::: "memory"); __syncthreads();
                {
                pg8::Gemm g{(const bf16_t*)(lptr(a.ws) + WS_S), VMT + (size_t)l * B_ * D_ * MEMT, D_, MEMT, 256, (size_t)T_ * D_, 256, (size_t)D_ * MEMT, (size_t)256 * MEMT}; S.init(T_ / 256, 1, 8, 4, G, bx);
                pg8::EpiStore<0> E{OB, D_, (size_t)T_ * D_, 256, 1 << 30, 1.f}; pg8::gemm_phase(lds, g, S, E); }
            } else if (s == 10 && PHX(10)) {
            } else if (s == 11 && PHX(11)) {
            } else if (s == 12 && PHX(12)) {
                pg8::Gemm g{OB, (const bf16_t*)(wb + OW_O), D_, D_, D_, 0, 0, 0, 0}; S.init(M_ / 256, 4, 1, 1, G, bx);
                const LAS float* gl = stage_gb(lds, gp(a.in[I_LNMIX_G]) + l * D_, gp(a.in[I_LNMIX_B]) + l * D_); pg8::EpiResidLN<false, false> E{lptr(a.out), HB, l == 0 ? SL0 : SL1, l == 0 ? SL1 : SL0, gl, nullptr, (LAS float*)(lds + 131072), ALPHA}; pg8::gemm_phase(lds, g, S, E);
            } else if (s == 13 && PHX(13)) {
            } else if (s == 14 && PHX(14)) {
                pg8::Gemm g{HB, (const bf16_t*)(wb + OW_1), D_, D_, D_, 0, 0, 0, 0}; S.init(M_ / 256, FF_ / 256, 1, 1, G, bx);
                float* cs = cs_ptr(lptr(a.ws), l, 1); pg8::EpiStoreLN<1> E{HID, FF_, 1 << 30, 1.f, l == 0 ? SL1 : SL0, cs, cs + FF_}; pg8::gemm_phase(lds, g, S, E);
            } else if (s == 15 && PHX(15)) {
                pg8::Gemm g{HID, (const bf16_t*)(wb + OW_2), FF_, FF_, FF_, 0, 0, 0, 0}; S.init(M_ / 256, 4, 1, 1, G, bx);
                const LAS float* gl = stage_gb(lds, gp(a.in[I_LNXA_G]) + l * D_, gp(a.in[I_LNXA_B]) + l * D_); if (l == 0) { pg8::EpiResidLN<false, false> E{lptr(a.out), HB, SL1, SL0, gl, nullptr, (LAS float*)(lds + 131072), ALPHA}; pg8::gemm_phase(lds, g, S, E); }
                else { pg8::EpiResidLN<false, true> E{lptr(a.out), HB, SL0, SL1, gl, nullptr, (LAS float*)(lds + 131072), ALPHA}; pg8::gemm_phase(lds, g, S, E); }
            } else if (PHX(16)) {
                if (l == 1) ln_phase(a, gp(a.in[I_LNMLP_G]) + l * D_, gp(a.in[I_LNMLP_B]) + l * D_, G);
            }
        }
        if (ph + 1 < a.ph_hi) { const int s_ = (ph - 1) % 17; const bool empty_ = ph > 0 && (s_ == 7 || s_ == 10 || s_ == 11 || s_ == 13 || (s_ == 16 && ph < 18)); if (a.coop && !empty_) { if (a.ph_hi < 0) cg::this_grid().sync();   xcd_barrier(xbar); } }
    }
}

constexpr int NPHASES = 1 + 2 * 17;
#ifndef MULTI_LAUNCH
#define MULTI_LAUNCH 0
#endif

extern "C" void kernel_launch(void* const* d_in, const int* in_sizes, int n_in, void* d_out, int out_size, void* d_ws, size_t ws_size, hipStream_t stream) {
    static int grid = 0;
    if (grid == 0) {
        if (n_in != 35 || out_size != M_ * D_ || ws_size < WS_END) { fprintf(stderr, "kernel_launch: unexpected sizes n_in %d out %d ws %zu\n", n_in, out_size, ws_size); grid = -1; return; }
        int dev = 0, cus = 0, per_cu = 0;
        hipGetDevice(&dev); hipDeviceGetAttribute(&cus, hipDeviceAttributeMultiprocessorCount, dev);
        if (hipFuncSetAttribute((const void*)fwd, hipFuncAttributeMaxDynamicSharedMemorySize, LDS_BYTES) != hipSuccess) { fprintf(stderr, "kernel_launch: hipFuncSetAttribute failed\n"); grid = -1; return; }
        if (hipOccupancyMaxActiveBlocksPerMultiprocessor(&per_cu, (const void*)fwd, 512, LDS_BYTES) != hipSuccess || per_cu < 1) { fprintf(stderr, "kernel_launch: occupancy query says %d\n", per_cu); per_cu = 1; }
        (void)hipGetLastError();
        grid = cus * per_cu;
    }
    if (grid < 0) return;
    (void)hipMemsetAsync(d_ws, 0, 65536, stream);
    Args a{};
    for (int i = 0; i < 35; ++i) a.in[i] = (const float*)d_in[i];
    a.out = (float*)d_out; a.ws = (unsigned char*)d_ws;
#if MULTI_LAUNCH
    for (int ph = 0; ph < NPHASES; ++ph) { a.ph_lo = ph; a.ph_hi = ph + 1; a.coop = 0; hipLaunchKernelGGL(fwd, dim3(grid), dim3(512), LDS_BYTES, stream, a); }
#else
    a.ph_lo = 0; a.ph_hi = NPHASES; a.coop = 1;
    void* args[] = {&a};
    hipError_t e = hipLaunchCooperativeKernel((const void*)fwd, dim3(grid), dim3(512), args, LDS_BYTES, stream);
    if (e != hipSuccess) fprintf(stderr, "cooperative launch failed: %s (grid %d)\n", hipGetErrorString(e), grid);
#endif
}
```
